# Optimizing an MI355X kernel written in HIP

```python
import math
import jax, jax.numpy as jnp
from jax import lax
import numpy as np

D_MODEL = 1024
BATCH = 8
SEQ = 2048
DEPTH = 2
DEC_BATCH = 128
DEC_SEQ = 4
PAST_LEN = 16384
PAGE_SIZE = 128

N_AB = (DEPTH + 1) // 2
N_C = DEPTH // 2
CHUNK = 64
EPS = 1e-6
D_FF = 2816

HGRN_HEADS = 4
HGRN_HEAD_DIM = 128
HGRN_WIDTH = HGRN_HEADS * HGRN_HEAD_DIM

SSM_HEADS = 8
SSM_HEAD_DIM = 64
SSM_INNER = SSM_HEADS * SSM_HEAD_DIM
SSM_GROUPS = 2
SSM_STATE = 128
CONV_W = 4
CONV_DIM = SSM_INNER + 2 * SSM_GROUPS * SSM_STATE

AB_PROJ = 4 * HGRN_WIDTH + SSM_INNER + CONV_DIM + SSM_HEADS
AB_SPLITS = (HGRN_WIDTH, 2 * HGRN_WIDTH, 3 * HGRN_WIDTH, 4 * HGRN_WIDTH,
             4 * HGRN_WIDTH + SSM_INNER, 4 * HGRN_WIDTH + SSM_INNER + CONV_DIM)
AB_WIDTH = HGRN_WIDTH + SSM_INNER

GLA_HEADS = 4
GLA_HEAD_K = 128
GLA_HEAD_V = 256
GLA_KEY = GLA_HEADS * GLA_HEAD_K
GLA_VAL = GLA_HEADS * GLA_HEAD_V
GK_RANK = 16
GK_NORMALIZER = 16.0
GLA_PROJ = 2 * GLA_KEY + 2 * GLA_VAL + GK_RANK
GLA_SPLITS = (GLA_KEY, 2 * GLA_KEY, 2 * GLA_KEY + GLA_VAL, 2 * GLA_KEY + 2 * GLA_VAL)

kernel_name = "hgrn2_mamba2_gla_macaron_step"


def rmsnorm(x, w):
    xf = x.astype(jnp.float32)
    y = xf * lax.rsqrt(jnp.mean(xf * xf, axis=-1, keepdims=True) + EPS)
    return (y * w.astype(jnp.float32)).astype(x.dtype)


def swiglu(x, w_in, w_out):
    gate, up = jnp.split(x @ w_in, 2, axis=-1)
    return (jax.nn.silu(gate) * up) @ w_out


def chunk_size(length):
    return math.gcd(length, CHUNK)


def chunked_gated_linear_attention(q, k, v, log_f, s0):
    B, L, H, K = q.shape
    V = v.shape[-1]
    C = chunk_size(L)
    n = L // C

    def blocks(t):
        return t.astype(jnp.float32).reshape(B, n, C, H, t.shape[-1])

    qc, kc, vc, gc = blocks(q), blocks(k), blocks(v), blocks(log_f)
    g = jnp.cumsum(gc, axis=2)
    g_last = g[:, :, -1:]
    q_dec = qc * jnp.exp(g)
    k_inv = kc * jnp.exp(-g)
    k_end = kc * jnp.exp(g_last - g)
    causal = jnp.tril(jnp.ones((C, C), bool))
    scores = jnp.where(causal, jnp.einsum('bnihk,bnjhk->bnhij', q_dec, k_inv), 0.0)
    o_intra = jnp.einsum('bnhij,bnjhv->bnihv', scores, vc)

    def step(s, inp):
        q_d, k_e, v_c, decay = inp
        o_inter = jnp.einsum('bihk,bhkv->bihv', q_d, s)
        s = decay[..., None] * s + jnp.einsum('bjhk,bjhv->bhkv', k_e, v_c)
        return s, o_inter

    xs = (jnp.moveaxis(q_dec, 1, 0), jnp.moveaxis(k_end, 1, 0), jnp.moveaxis(vc, 1, 0),
          jnp.moveaxis(jnp.exp(g_last[:, :, 0]), 1, 0))
    s_final, o_inter = lax.scan(step, s0.astype(jnp.float32), xs)
    o = o_intra + jnp.moveaxis(o_inter, 0, 1)
    return o.reshape(B, L, H, V), s_final


def chunked_ssd(x, dt, a, b, c, s0):
    B, L, H, P = x.shape
    G, N = b.shape[-2], b.shape[-1]
    R = H // G
    C = chunk_size(L)
    n = L // C
    f32 = jnp.float32
    xc = x.astype(f32).reshape(B, n, C, G, R, P)
    dtc = dt.astype(f32).reshape(B, n, C, G, R)
    bc = b.astype(f32).reshape(B, n, C, G, N)
    cc = c.astype(f32).reshape(B, n, C, G, N)
    cum = jnp.cumsum(dtc * a.astype(f32).reshape(G, R), axis=2)
    causal = jnp.tril(jnp.ones((C, C), bool))[:, :, None, None]
    seg = cum[:, :, :, None] - cum[:, :, None, :]
    decay = jnp.exp(jnp.where(causal, seg, -jnp.inf))
    xdt = xc * dtc[..., None]
    cb = jnp.einsum('bnigs,bnjgs->bnijg', cc, bc)
    y_intra = jnp.einsum('bnijgr,bnjgrp->bnigrp', cb[..., None] * decay, xdt)
    x_end = xdt * jnp.exp(cum[:, :, -1:] - cum)[..., None]
    chunk_decay = jnp.exp(cum[:, :, -1])

    def step(s, inp):
        c_i, cdec_i, b_i, xe_i, dec_i = inp
        y_inter = jnp.einsum('bigs,bigr,bgrps->bigrp', c_i, cdec_i, s)
        s = dec_i[..., None, None] * s + jnp.einsum('bjgrp,bjgs->bgrps', xe_i, b_i)
        return s, y_inter

    xs = (jnp.moveaxis(cc, 1, 0), jnp.moveaxis(jnp.exp(cum), 1, 0), jnp.moveaxis(bc, 1, 0),
          jnp.moveaxis(x_end, 1, 0), jnp.moveaxis(chunk_decay, 1, 0))
    s_final, y_inter = lax.scan(step, s0.astype(f32).reshape(B, G, R, P, N), xs)
    y = y_intra + jnp.moveaxis(y_inter, 0, 1)
    return y.reshape(B, L, H, P), s_final.reshape(B, H, P, N)


def hgrn2_mixer(q_raw, f_raw, i_raw, g_raw, lb, state, norm_w):
    B, L, _ = q_raw.shape

    def heads(t):
        return t.reshape(B, L, HGRN_HEADS, HGRN_HEAD_DIM)

    f = lb + (1.0 - lb) * jax.nn.sigmoid(f_raw.astype(jnp.float32))
    q = jax.nn.silu(q_raw)
    o, s_new = chunked_gated_linear_attention(heads(q), heads(1.0 - f), heads(i_raw), heads(jnp.log(f)), state)
    o = rmsnorm(o, norm_w).reshape(B, L, HGRN_WIDTH) * jax.nn.silu(g_raw.astype(jnp.float32))
    return o.astype(q_raw.dtype), s_new


def mamba2_mixer(z, xbc, dt_raw, conv_buf, ssm_state, conv_w, conv_b, dt_bias, a_log, d_skip, norm_w):
    B, L, _ = xbc.shape
    padded = jnp.concatenate([conv_buf.astype(xbc.dtype), xbc], axis=1)
    conv = conv_b + sum(padded[:, k:k + L] * conv_w[k] for k in range(CONV_W))
    new_buf = padded[:, -(CONV_W - 1):]
    xbc_act = jax.nn.silu(conv)
    xs, bs, cs = jnp.split(xbc_act, [SSM_INNER, SSM_INNER + SSM_GROUPS * SSM_STATE], axis=-1)
    dt = jax.nn.softplus(dt_raw.astype(jnp.float32) + dt_bias.astype(jnp.float32))
    a = -jnp.exp(a_log.astype(jnp.float32))
    xh = xs.reshape(B, L, SSM_HEADS, SSM_HEAD_DIM)
    y, s_new = chunked_ssd(xh, dt, a,
                           bs.reshape(B, L, SSM_GROUPS, SSM_STATE),
                           cs.reshape(B, L, SSM_GROUPS, SSM_STATE), ssm_state)
    y = y + d_skip.astype(jnp.float32)[:, None] * xh.astype(jnp.float32)
    y = y.reshape(B, L, SSM_INNER) * jax.nn.silu(z.astype(jnp.float32))
    y = rmsnorm(y.reshape(B, L, SSM_GROUPS, SSM_INNER // SSM_GROUPS),
                norm_w.reshape(SSM_GROUPS, SSM_INNER // SSM_GROUPS)).reshape(B, L, SSM_INNER)
    return y.astype(xbc.dtype), new_buf, s_new


def gla_mixer(proj, state, w_gk, b_gk, norm_w):
    B, L, _ = proj.shape
    q, k, v, g, gk_low = jnp.split(proj, GLA_SPLITS, axis=-1)
    log_f = jax.nn.log_sigmoid((gk_low @ w_gk + b_gk).astype(jnp.float32)) / GK_NORMALIZER
    hk = lambda t: t.reshape(B, L, GLA_HEADS, GLA_HEAD_K)
    o, s_new = chunked_gated_linear_attention(hk(q * GLA_HEAD_K ** -0.5), hk(k),
                                              v.reshape(B, L, GLA_HEADS, GLA_HEAD_V), hk(log_f), state)
    o = rmsnorm(o, norm_w).reshape(B, L, GLA_VAL) * jax.nn.silu(g.astype(jnp.float32))
    return o.astype(proj.dtype), s_new


def trunk(x, s_hgrn, s_ssm, s_conv, s_gla, p):
    dtype = x.dtype
    new_hgrn, new_ssm, new_conv, new_gla = [], [], [], []
    lb_all = jnp.cumsum(jax.nn.softmax(p["hgrn_lb_logits"].astype(jnp.float32), axis=0), axis=0)
    for layer in range(DEPTH):
        j = layer // 2
        x = x + 0.5 * swiglu(rmsnorm(x, p["norm_ffn1"][layer]), p["ffn1_w_in"][layer], p["ffn1_w_out"][layer])
        h = rmsnorm(x, p["norm_mix"][layer])
        if layer % 2 == 0:
            proj = h @ p["ab_w_in"][j]
            q_raw, f_raw, i_raw, g_raw, z, xbc, dt_raw = jnp.split(proj, AB_SPLITS, axis=-1)
            o_a, s_a = hgrn2_mixer(q_raw, f_raw, i_raw, g_raw, lb_all[j], s_hgrn[j], p["hgrn_norm"][j])
            o_b, buf_b, s_b = mamba2_mixer(z, xbc, dt_raw, s_conv[j], s_ssm[j], p["ssm_conv_w"][j],
                                           p["ssm_conv_b"][j], p["ssm_dt_bias"][j], p["ssm_a_log"][j],
                                           p["ssm_d"][j], p["ssm_norm"][j])
            x = x + jnp.concatenate([o_a, o_b], axis=-1) @ p["ab_w_out"][j]
            new_hgrn.append(s_a.astype(dtype))
            new_ssm.append(s_b.astype(dtype))
            new_conv.append(buf_b.astype(dtype))
        else:
            proj = h @ p["gla_w_in"][j]
            o_c, s_c = gla_mixer(proj, s_gla[j], p["gla_w_gk"][j], p["gla_b_gk"][j], p["gla_norm"][j])
            x = x + o_c @ p["gla_w_out"][j]
            new_gla.append(s_c.astype(dtype))
        x = x + 0.5 * swiglu(rmsnorm(x, p["norm_ffn2"][layer]), p["ffn2_w_in"][layer], p["ffn2_w_out"][layer])
    y = rmsnorm(x, p["norm_final"])
    return y, jnp.stack(new_hgrn), jnp.stack(new_ssm), jnp.stack(new_conv), jnp.stack(new_gla)


def setup_inputs(seed: int = 0) -> dict:
    key = jax.random.key(seed)
    keys = list(jax.random.split(key, 29))

    def normal(i, shape, scale):
        return jax.random.normal(keys[i], shape, jnp.float32) * scale

    def gain(i, shape):
        return 1.0 + normal(i, shape, 0.02)

    dt0 = jnp.exp(jax.random.uniform(keys[20], (N_AB, SSM_HEADS), jnp.float32,
                                     minval=math.log(1e-3), maxval=math.log(1e-1)))
    return {
        "x_prompt": normal(0, (BATCH, SEQ, D_MODEL), 1.0),
        "x_sample": normal(1, (DEC_BATCH, DEC_SEQ, D_MODEL), 1.0),
        "state_hgrn": normal(2, (N_AB, DEC_BATCH, HGRN_HEADS, HGRN_HEAD_DIM, HGRN_HEAD_DIM), 0.5),
        "state_ssm": normal(3, (N_AB, DEC_BATCH, SSM_HEADS, SSM_HEAD_DIM, SSM_STATE), 0.5),
        "state_conv": normal(4, (N_AB, DEC_BATCH, CONV_W - 1, CONV_DIM), 1.0),
        "state_gla": normal(5, (N_C, DEC_BATCH, GLA_HEADS, GLA_HEAD_K, GLA_HEAD_V), 1.0),
        "norm_ffn1": gain(6, (DEPTH, D_MODEL)),
        "norm_mix": gain(7, (DEPTH, D_MODEL)),
        "norm_ffn2": gain(8, (DEPTH, D_MODEL)),
        "norm_final": gain(9, (D_MODEL,)),
        "ffn1_w_in": normal(10, (DEPTH, D_MODEL, 2 * D_FF), D_MODEL ** -0.5),
        "ffn1_w_out": normal(11, (DEPTH, D_FF, D_MODEL), D_FF ** -0.5),
        "ffn2_w_in": normal(12, (DEPTH, D_MODEL, 2 * D_FF), D_MODEL ** -0.5),
        "ffn2_w_out": normal(13, (DEPTH, D_FF, D_MODEL), D_FF ** -0.5),
        "ab_w_in": normal(14, (N_AB, D_MODEL, AB_PROJ), D_MODEL ** -0.5),
        "ab_w_out": normal(15, (N_AB, AB_WIDTH, D_MODEL), AB_WIDTH ** -0.5),
        "hgrn_lb_logits": normal(16, (N_AB + 1, HGRN_WIDTH), 0.1),
        "hgrn_norm": gain(17, (N_AB, HGRN_HEAD_DIM)),
        "ssm_conv_w": normal(18, (N_AB, CONV_W, CONV_DIM), CONV_W ** -0.5),
        "ssm_conv_b": normal(19, (N_AB, CONV_DIM), 0.02),
        "ssm_dt_bias": dt0 + jnp.log(-jnp.expm1(-dt0)),
        "ssm_a_log": jnp.log(jax.random.uniform(keys[21], (N_AB, SSM_HEADS), jnp.float32, minval=1.0, maxval=16.0)),
        "ssm_d": gain(22, (N_AB, SSM_HEADS)),
        "ssm_norm": gain(23, (N_AB, SSM_INNER)),
        "gla_w_in": normal(24, (N_C, D_MODEL, GLA_PROJ), D_MODEL ** -0.5),
        "gla_w_gk": normal(25, (N_C, GK_RANK, GLA_KEY), GK_RANK ** -0.5),
        "gla_b_gk": normal(26, (N_C, GLA_KEY), 0.1),
        "gla_norm": gain(27, (N_C, GLA_HEAD_V)),
        "gla_w_out": normal(28, (N_C, GLA_VAL, D_MODEL), GLA_VAL ** -0.5),
    }


def reference(x_prompt, x_sample, state_hgrn, state_ssm, state_conv, state_gla,
              norm_ffn1, norm_mix, norm_ffn2, norm_final,
              ffn1_w_in, ffn1_w_out, ffn2_w_in, ffn2_w_out,
              ab_w_in, ab_w_out, hgrn_lb_logits, hgrn_norm,
              ssm_conv_w, ssm_conv_b, ssm_dt_bias, ssm_a_log, ssm_d, ssm_norm,
              gla_w_in, gla_w_gk, gla_b_gk, gla_norm, gla_w_out):
    p = dict(norm_ffn1=norm_ffn1, norm_mix=norm_mix, norm_ffn2=norm_ffn2, norm_final=norm_final,
             ffn1_w_in=ffn1_w_in, ffn1_w_out=ffn1_w_out, ffn2_w_in=ffn2_w_in, ffn2_w_out=ffn2_w_out,
             ab_w_in=ab_w_in, ab_w_out=ab_w_out, hgrn_lb_logits=hgrn_lb_logits, hgrn_norm=hgrn_norm,
             ssm_conv_w=ssm_conv_w, ssm_conv_b=ssm_conv_b, ssm_dt_bias=ssm_dt_bias, ssm_a_log=ssm_a_log,
             ssm_d=ssm_d, ssm_norm=ssm_norm, gla_w_in=gla_w_in, gla_w_gk=gla_w_gk, gla_b_gk=gla_b_gk,
             gla_norm=gla_norm, gla_w_out=gla_w_out)
    b = x_prompt.shape[0]
    dt = x_prompt.dtype
    zh = jnp.zeros((N_AB, b, HGRN_HEADS, HGRN_HEAD_DIM, HGRN_HEAD_DIM), dt)
    zs = jnp.zeros((N_AB, b, SSM_HEADS, SSM_HEAD_DIM, SSM_STATE), dt)
    zc = jnp.zeros((N_AB, b, CONV_W - 1, CONV_DIM), dt)
    zg = jnp.zeros((N_C, b, GLA_HEADS, GLA_HEAD_K, GLA_HEAD_V), dt)
    y_prompt, hgrn_p, ssm_p, conv_p, gla_p = trunk(x_prompt, zh, zs, zc, zg, p)
    y_sample, hgrn_s, ssm_s, conv_s, gla_s = trunk(x_sample, state_hgrn, state_ssm, state_conv, state_gla, p)
    return (y_prompt, y_sample, hgrn_p, hgrn_s, ssm_p, ssm_s, conv_p, conv_s, gla_p, gla_s)
```

```cpp
#include <hip/hip_runtime.h>
#include <hip/hip_cooperative_groups.h>
#include <cstdio>
#include <cstdint>
namespace cg = cooperative_groups;
namespace pg8 {
#define PG8_LAS __attribute__((address_space(3)))
typedef unsigned short bf16_t;
typedef short bf16x8 __attribute__((ext_vector_type(8)));
typedef float f32x4 __attribute__((ext_vector_type(4)));
typedef unsigned u32x4 __attribute__((ext_vector_type(4)));
constexpr int BM = 256, BK = 64, HALF = 128, HTB = HALF * BK * 2  , STAGE_BYTES = 8 * HTB, NXCD = 8, WGM = 8;

__host__ __device__ __forceinline__ int lds_byte(int r, int c) { const int st = (r >> 4) * 2 + (c >> 5), rr = r & 15, cc = c & 31, ob = rr * 64 + cc * 2; return st * 1024 + (ob ^ (((ob >> 9) & 1) << 5)); }
__host__ __device__ __forceinline__ void stage_rc(int b, int& R, int& C) { const int st = b / 1024, sb = b % 1024, swz = sb ^ (((sb >> 9) & 1) << 5); R = (st >> 1) * 16 + swz / 64; C = (st & 1) * 32 + (swz % 64) / 2; }
__host__ __device__ __forceinline__ int perm32(int rho) { const int n = rho >> 4, i = rho & 15; return 8 * (i >> 2) + 4 * n + (i & 3); }

struct Unit { int pm, pn; };
struct Gemm { const bf16_t* A; const bf16_t* Bt; int M, N, K; };

struct StaticOrder {
    int nM, nN, nwg, G, c;
    __host__ __device__ void init(int M, int N, int G_, int c_) { nM = M / BM; nN = N / BM; nwg = nM * nN; G = G_; c = c_; }
    __host__ __device__ bool next(int i, Unit& u) const {
        const long L = (long)i * G + c; if (L >= nwg) return false;
        int wgid = (int)L; { const int q = nwg / NXCD, r = nwg % NXCD, xcd = wgid % NXCD, off = wgid / NXCD; wgid = (xcd < r ? xcd * (q + 1) : r * (q + 1) + (xcd - r) * q) + off; }
        const int nig = WGM * nN, gid = wgid / nig, fm = gid * WGM, gsz = (nM - fm) < WGM ? (nM - fm) : WGM;
        u.pm = fm + ((wgid % nig) % gsz); u.pn = (wgid % nig) / gsz; return true;
    }
    __device__ __forceinline__ void a_ready(const Unit&) const {}
    __device__ __forceinline__ void done(const Unit&) const {}
};

__device__ __forceinline__ unsigned cvt_pk_bf16(float lo, float hi) { unsigned r; asm volatile("v_cvt_pk_bf16_f32 %0, %1, %2" : "=v"(r) : "v"(lo), "v"(hi)); return r; }
template <class Epi, class Sched, bool ALIGN_EPI = false, bool SP2 = false>
__device__ __forceinline__ void gemm_phase(PG8_LAS unsigned char* lds, const Gemm g, const Sched& S, const Epi& E) {
    const int tid = threadIdx.x, wid = __builtin_amdgcn_readfirstlane(tid >> 6), lane = tid & 63, wr = wid >> 2, wc = wid & 3, fr = lane & 15, fq = lane >> 4;
    const int K = g.K, nt = K / BK;
    unsigned voffA[2], voffB[2];
#pragma unroll
    for (int i = 0; i < 2; ++i) { int R, C; stage_rc(tid * 16 + i * 8192, R, C); const int Rb = Epi::PERM ? ((R & ~31) + perm32(R & 31)) : R;
        voffA[i] = (unsigned)(R * K + C) * 2u; voffB[i] = (unsigned)(Rb * K + C) * 2u; }
    const size_t kstep = (size_t)(BK * 2);
    const size_t hstep = (size_t)HALF * K * 2;
    const size_t tstep = 2 * hstep;
    const unsigned ldsw = (unsigned)wid * 1024u;
    const int aoff = lds_byte(wr * 64 + fr, fq * 8), boff = lds_byte(wc * 32 + fr, fq * 8);
#define PG8_SA(b, h) (((b) * 2 + (h)) * HTB)
#define PG8_SB(b, h) ((4 + (b) * 2 + (h)) * HTB)
#define PG8_STAGE(bufoff, gbase, voff) do { _Pragma("unroll") for (int _i = 0; _i < 2; ++_i) \
        __builtin_amdgcn_global_load_lds((const unsigned*)((const char*)(gbase) + (voff)[_i]), (PG8_LAS unsigned*)(lds + (bufoff) + ldsw + _i * 8192), 16, 0, 0); } while (0)
#define PG8_LDA(dst, b, h) do { _Pragma("unroll") for (int m = 0; m < 4; ++m) _Pragma("unroll") for (int k = 0; k < 2; ++k) dst[m][k] = *(const PG8_LAS bf16x8*)(lds + PG8_SA(b, h) + aoff + m * 2048 + k * 1024); } while (0)
#define PG8_LDB(dst, b, h) do { _Pragma("unroll") for (int n = 0; n < 2; ++n) _Pragma("unroll") for (int k = 0; k < 2; ++k) dst[n][k] = *(const PG8_LAS bf16x8*)(lds + PG8_SB(b, h) + boff + n * 2048 + k * 1024); } while (0)
#define PG8_MMA(ai, bj, At, Bt) do { __builtin_amdgcn_s_setprio(1); _Pragma("unroll") for (int m = 0; m < 4; ++m) _Pragma("unroll") for (int n = 0; n < 2; ++n) _Pragma("unroll") for (int k = 0; k < 2; ++k) \
        acc[ai][bj][m][n] = __builtin_amdgcn_mfma_f32_16x16x32_bf16(Bt[n][k], At[m][k], acc[ai][bj][m][n], 0, 0, 0); __builtin_amdgcn_s_setprio(0); } while (0)
#define PG8_WAIT_V(n) asm volatile("s_waitcnt vmcnt(" #n ")" ::: "memory")
#define PG8_WAIT_L(n) asm volatile("s_waitcnt lgkmcnt(" #n ")" ::: "memory")
#define PG8_BAR __builtin_amdgcn_s_barrier()
#define PG8_SCHED __builtin_amdgcn_sched_barrier(0)
    Unit cur, nxt; int ui = 0;
    if (!S.next(0, cur)) return;
    f32x4 acc[2][2][4][2];
#pragma unroll
    for (int a = 0; a < 2; ++a)
#pragma unroll
        for (int b = 0; b < 2; ++b)
#pragma unroll
            for (int m = 0; m < 4; ++m)
#pragma unroll
                for (int n = 0; n < 2; ++n) acc[a][b][m][n] = (f32x4){0.f, 0.f, 0.f, 0.f};
    bf16x8 At[4][2], B0[2][2], B1[2][2];
    const char* cA = (const char*)g.A + (size_t)cur.pm * tstep; const char* cB = (const char*)g.Bt + (size_t)cur.pn * tstep;
    S.a_ready(cur);
    if constexpr (SP2) {
        PG8_STAGE(PG8_SB(0, 0), cB, voffB); PG8_STAGE(PG8_SB(0, 1), cB + hstep, voffB); PG8_STAGE(PG8_SA(0, 0), cA, voffA); PG8_STAGE(PG8_SA(0, 1), cA + hstep, voffA);
        if (wr == 1) PG8_BAR;
        PG8_WAIT_V(2); PG8_BAR;
        PG8_STAGE(PG8_SB(1, 0), cB + kstep, voffB); PG8_STAGE(PG8_SA(1, 0), cA + kstep, voffA); PG8_STAGE(PG8_SB(1, 1), cB + hstep + kstep, voffB);
        PG8_WAIT_V(6); PG8_BAR;
    } else {
        PG8_STAGE(PG8_SB(0, 0), cB, voffB); PG8_STAGE(PG8_SA(0, 0), cA, voffA); PG8_STAGE(PG8_SB(0, 1), cB + hstep, voffB); PG8_STAGE(PG8_SA(0, 1), cA + hstep, voffA);
        if (wr == 1) PG8_BAR;
        PG8_WAIT_V(4); PG8_BAR;
        PG8_STAGE(PG8_SB(1, 0), cB + kstep, voffB); PG8_STAGE(PG8_SA(1, 0), cA + kstep, voffA); PG8_STAGE(PG8_SB(1, 1), cB + hstep + kstep, voffB);
        PG8_WAIT_V(6); PG8_BAR;
    }
    for (;;) {
        const bool has_next = S.next(ui + 1, nxt);
        const char* nA = has_next ? (const char*)g.A + (size_t)nxt.pm * tstep : cA; const char* nB = has_next ? (const char*)g.Bt + (size_t)nxt.pn * tstep : cB;
        for (int t = 0; t < nt; t += 2) {
            const bool last = (t == nt - 2);
            const char* a1 = cA + (size_t)(t + 1) * kstep;
            const char* a2 = last ? nA : cA + (size_t)(t + 2) * kstep; const char* b2 = last ? nB : cB + (size_t)(t + 2) * kstep;
            const char* a3 = a2 + kstep; const char* b3 = b2 + kstep;
            if (last && has_next) S.a_ready(nxt);
            if constexpr (SP2) {
            PG8_LDB(B0, 0, 0); PG8_LDB(B1, 0, 1); PG8_SCHED; PG8_LDA(At, 0, 0); PG8_STAGE(PG8_SA(1, 1), a1 + hstep, voffA);
            PG8_WAIT_V(8); PG8_WAIT_L(0); PG8_BAR; PG8_MMA(0, 0, At, B0); PG8_MMA(0, 1, At, B1); PG8_BAR; PG8_SCHED;
            PG8_LDA(At, 0, 1); PG8_STAGE(PG8_SB(0, 0), b2, voffB); PG8_STAGE(PG8_SB(0, 1), b2 + hstep, voffB); PG8_STAGE(PG8_SA(0, 0), a2, voffA);
            PG8_WAIT_V(8); PG8_WAIT_L(0); PG8_BAR; PG8_MMA(1, 0, At, B0); PG8_MMA(1, 1, At, B1); PG8_BAR; PG8_SCHED;
            PG8_LDB(B0, 1, 0); PG8_LDB(B1, 1, 1); PG8_SCHED; PG8_LDA(At, 1, 0); PG8_STAGE(PG8_SA(0, 1), a2 + hstep, voffA);
            PG8_WAIT_V(8); PG8_WAIT_L(0); PG8_BAR; PG8_MMA(0, 0, At, B0); PG8_MMA(0, 1, At, B1); PG8_BAR; PG8_SCHED;
            PG8_LDA(At, 1, 1); PG8_STAGE(PG8_SB(1, 0), b3, voffB); PG8_STAGE(PG8_SB(1, 1), b3 + hstep, voffB); PG8_STAGE(PG8_SA(1, 0), a3, voffA);
            PG8_WAIT_V(8); PG8_WAIT_L(0); PG8_BAR; PG8_MMA(1, 0, At, B0); PG8_MMA(1, 1, At, B1); PG8_BAR; PG8_SCHED;
            } else {
            PG8_LDB(B0, 0, 0); PG8_SCHED; PG8_LDA(At, 0, 0); PG8_STAGE(PG8_SA(1, 1), a1 + hstep, voffA);
            PG8_WAIT_L(8); PG8_BAR; PG8_WAIT_L(0); PG8_MMA(0, 0, At, B0); PG8_BAR; PG8_SCHED;
            PG8_LDB(B1, 0, 1); PG8_STAGE(PG8_SB(0, 0), b2, voffB);
            PG8_BAR; PG8_WAIT_L(0); PG8_MMA(0, 1, At, B1); PG8_BAR;
            PG8_LDA(At, 0, 1); PG8_STAGE(PG8_SA(0, 0), a2, voffA);
            PG8_BAR; PG8_WAIT_L(0); PG8_MMA(1, 0, At, B0); PG8_BAR; PG8_SCHED;
            PG8_STAGE(PG8_SB(0, 1), b2 + hstep, voffB);
            PG8_WAIT_V(6); PG8_BAR; PG8_MMA(1, 1, At, B1); PG8_BAR;
            PG8_LDB(B0, 1, 0); PG8_SCHED; PG8_LDA(At, 1, 0); PG8_STAGE(PG8_SA(0, 1), a2 + hstep, voffA);
            PG8_WAIT_L(8); PG8_BAR; PG8_WAIT_L(0); PG8_MMA(0, 0, At, B0); PG8_BAR; PG8_SCHED;
            PG8_LDB(B1, 1, 1); PG8_STAGE(PG8_SB(1, 0), b3, voffB);
            PG8_BAR; PG8_WAIT_L(0); PG8_MMA(0, 1, At, B1); PG8_BAR;
            PG8_LDA(At, 1, 1); PG8_STAGE(PG8_SA(1, 0), a3, voffA);
            PG8_BAR; PG8_WAIT_L(0); PG8_MMA(1, 0, At, B0); PG8_BAR; PG8_SCHED;
            PG8_STAGE(PG8_SB(1, 1), b3 + hstep, voffB);
            PG8_WAIT_V(6); PG8_BAR; PG8_MMA(1, 1, At, B1); PG8_BAR;
            }
        }
        if constexpr (ALIGN_EPI) { if (wr == 0) PG8_BAR; }
        if constexpr (!Epi::AFTER_DRAIN) { E(acc, cur, wr, wc, fr, fq); S.done(cur); }
        if (!has_next) break;
#pragma unroll
        for (int a = 0; a < 2; ++a)
#pragma unroll
            for (int b = 0; b < 2; ++b)
#pragma unroll
                for (int m = 0; m < 4; ++m)
#pragma unroll
                    for (int n = 0; n < 2; ++n) acc[a][b][m][n] = (f32x4){0.f, 0.f, 0.f, 0.f};
        cur = nxt; cA = nA; cB = nB; ++ui;
        if constexpr (ALIGN_EPI) { if (wr == 1) PG8_BAR; }
    }
    PG8_WAIT_V(0);
    if constexpr (!ALIGN_EPI) { if (wr == 0) PG8_BAR; }
    PG8_BAR;
    if constexpr (Epi::AFTER_DRAIN) { E.fused(acc, cur, wr, wc, fr, fq, lds, wid, lane); S.done(cur); }
#undef PG8_SA
#undef PG8_SB
#undef PG8_STAGE
#undef PG8_LDA
#undef PG8_LDB
#undef PG8_MMA
#undef PG8_WAIT_V
#undef PG8_WAIT_L
#undef PG8_BAR
#undef PG8_SCHED
}
}

#define LAS __attribute__((address_space(3)))
typedef unsigned short bf16;
typedef unsigned v4u __attribute__((ext_vector_type(4)));
typedef unsigned v2u __attribute__((ext_vector_type(2)));
typedef float f32x4 __attribute__((ext_vector_type(4)));

constexpr int T = 16896, TP = 16384, D = 1024, DFF = 2816, NFI = 5632;
constexpr int NAB = 3592, NAB_PAD = 3840, PA = 3584;
constexpr int NGL = 3088, NGL_PAD = 3328, PG = 3072;
constexpr float EPS = 1e-6f;
constexpr int NWAVES = 8;
constexpr int LDS_BYTES = 147456;

constexpr size_t O_HP = 17301504, O_HS = 17825792, O_SP = 26214400, O_SS = 26738688, O_CP = 35127296, O_CS = 35151872, O_GP = 35545088, O_GS = 36593664;

constexpr size_t MiB = 1u << 20;
constexpr size_t SZ_WFI = (size_t)NFI * D * 2, SZ_WFO = (size_t)D * DFF * 2;
constexpr size_t WS_CTL = 0;
constexpr size_t WS_WFI = 1 * MiB;
constexpr size_t WS_WFO = WS_WFI + 4 * SZ_WFI;
constexpr size_t WS_WAI = WS_WFO + 4 * SZ_WFO;
constexpr size_t WS_WAO = WS_WAI + (size_t)NAB_PAD * D * 2;
constexpr size_t WS_WGI = WS_WAO + (size_t)D * D * 2;
constexpr size_t WS_WGO = WS_WGI + (size_t)NGL_PAD * D * 2;
constexpr size_t WS_XB  = WS_WGO + (size_t)D * D * 2;
constexpr size_t WS_SSQ = WS_XB + (size_t)T * D * 2;
constexpr size_t WS_BIG = WS_SSQ + (size_t)T * 16 * 4;
constexpr size_t WS_ACT = WS_BIG;
constexpr size_t WS_PROJ = WS_BIG;
constexpr size_t WS_LF = WS_PROJ + (size_t)T * PA * 2;
constexpr size_t WS_DT = WS_LF + (size_t)T * 512 * 4;
constexpr size_t WS_GK = WS_DT + (size_t)T * 8 * 4;
constexpr size_t WS_OG = WS_GK + (size_t)T * 16 * 4;
constexpr size_t WS_END = WS_OG + (size_t)T * D * 2;

enum { PH_PREP = 0, PH_L0F1I, PH_L0F1O, PH_ABI, PH_MIX0, PH_POST0, PH_ABO, PH_L0F2I, PH_L0F2O,
       PH_L1F1I, PH_L1F1O, PH_GLI, PH_MIX1, PH_POST1, PH_GLO, PH_L1F2I, PH_L1F2O, PH_FINAL, N_PH };

struct Args { const float* in[29]; float* out; unsigned char* ws; int ph_lo, ph_hi; };

__device__ __forceinline__ float bf2f(bf16 b) { return __uint_as_float(((unsigned)b) << 16); }
typedef float f32x2_t __attribute__((ext_vector_type(2))); typedef __bf16 bf16x2_t __attribute__((ext_vector_type(2)));
__device__ __forceinline__ unsigned pk2(float lo, float hi) { const bf16x2_t v = __builtin_convertvector((f32x2_t){lo, hi}, bf16x2_t); return __builtin_bit_cast(unsigned, v); }
__device__ __forceinline__ f32x2_t silu_mul_pk(f32x2_t g, f32x2_t u) {
    const f32x2_t t = g * (-1.4426950408889634f);
    f32x2_t e; e.x = __builtin_amdgcn_exp2f(t.x); e.y = __builtin_amdgcn_exp2f(t.y);
    const f32x2_t d = e + 1.0f;
    f32x2_t r; r.x = __builtin_amdgcn_rcpf(d.x); r.y = __builtin_amdgcn_rcpf(d.y);
    return (g * r) * u;
}
__device__ __forceinline__ unsigned pk2v(f32x2_t v) { const bf16x2_t b = __builtin_convertvector(v, bf16x2_t); return __builtin_bit_cast(unsigned, b); }
__device__ __forceinline__ float silu_f(float x) { return x * __builtin_amdgcn_rcpf(1.f + __expf(-x)); }
__device__ __forceinline__ float sigmoid_f(float x) { return __builtin_amdgcn_rcpf(1.f + __expf(-x)); }
__device__ __forceinline__ float softplus_f(float x) { return fmaxf(x, 0.f) + log1pf(__expf(-fabsf(x))); }
__device__ __forceinline__ float wave_sum(float v) {
#pragma unroll
    for (int o = 1; o < 64; o <<= 1) v += __shfl_xor(v, o);
    return v;
}
#define LDS_WAIT() asm volatile("s_waitcnt lgkmcnt(0)" ::: "memory")

enum { ACT_NONE = 0, ACT_RAW, ACT_SILU, ACT_QSCALE, ACT_FGATE, ACT_DT, ACT_GK };
constexpr unsigned long long ACTS_AB = 0x2ull | (0x2ull << 4) | (0x4ull << 8) | (0x4ull << 12) | (0x1ull << 16) | (0x1ull << 20) | (0x2ull << 24) | (0x2ull << 28) | (0x2ull << 32) | (0x2ull << 36)
               | (0x1ull << 40) | (0x1ull << 44) | (0x1ull << 48) | (0x1ull << 52) | (0x5ull << 56);
constexpr unsigned long long ACTS_GL = 0x3ull | (0x3ull << 4) | (0x1ull << 8) | (0x1ull << 12) | (0x1ull << 16) | (0x1ull << 20) | (0x1ull << 24) | (0x1ull << 28) | (0x2ull << 32) | (0x2ull << 36)
               | (0x2ull << 40) | (0x2ull << 44) | (0x6ull << 48);
template <int mode  ,
          int sub   >
struct Epi {
    static constexpr bool PERM = true, AFTER_DRAIN = false;
    unsigned char* ws; float* out;
    const float* res_p; const float* res_s;
    const float* lbl; const float* dtb;
    mutable int cpm = -1; mutable float crs[2][4] = {{0.f, 0.f, 0.f, 0.f}, {0.f, 0.f, 0.f, 0.f}};
    __device__ __forceinline__ void operator()(const pg8::f32x4 (&acc)[2][2][4][2], const pg8::Unit& u, int wr, int wc, int fr, int fq) const {
        const int rbase = u.pm * 256 + wr * 64 + fr;
        const int cl = wc * 32 + 8 * fq;
        const float* ssq_in = (const float*)(ws + WS_SSQ);
        bf16* obf = (bf16*)(ws + WS_BIG);
        if (mode == 1) {
            float* xr = out; bf16* xb = (bf16*)(ws + WS_XB); float* ssq_out = (float*)(ws + WS_SSQ);
            const float scale = (sub == 1) ? 1.f : 0.5f;
            const int c00 = u.pn * 256 + cl;
            f32x4 rb[2][4];
            {
                const int row = rbase;
                const float* rp = (row < TP) ? res_p + (size_t)row * D : res_s + (size_t)(row - TP) * D;
                rb[0][0] = *(const f32x4*)(rp + c00); rb[0][1] = *(const f32x4*)(rp + c00 + 4); rb[0][2] = *(const f32x4*)(rp + c00 + 128); rb[0][3] = *(const f32x4*)(rp + c00 + 132);
            }
#pragma unroll
            for (int gi = 0; gi < 8; ++gi) {
                const int ai = gi >> 2, m = gi & 3;
                const int row = rbase + ai * 128 + m * 16;
                if (gi + 1 < 8) {
                    const int rown = rbase + ((gi + 1) >> 2) * 128 + ((gi + 1) & 3) * 16;
                    const float* rp = (rown < TP) ? res_p + (size_t)rown * D : res_s + (size_t)(rown - TP) * D;
                    rb[(gi + 1) & 1][0] = *(const f32x4*)(rp + c00); rb[(gi + 1) & 1][1] = *(const f32x4*)(rp + c00 + 4);
                    rb[(gi + 1) & 1][2] = *(const f32x4*)(rp + c00 + 128); rb[(gi + 1) & 1][3] = *(const f32x4*)(rp + c00 + 132);
                }
                float ss = 0.f;
#pragma unroll
                for (int bj = 0; bj < 2; ++bj) {
                    const int c0 = c00 + bj * 128;
                    const f32x4 x0 = rb[gi & 1][2 * bj] + acc[ai][bj][m][0] * scale, x1 = rb[gi & 1][2 * bj + 1] + acc[ai][bj][m][1] * scale;
                    *(f32x4*)(xr + (size_t)row * D + c0) = x0; *(f32x4*)(xr + (size_t)row * D + c0 + 4) = x1;
                    if (sub != 2) {
                        v4u w; w.x = pk2(x0[0], x0[1]); w.y = pk2(x0[2], x0[3]); w.z = pk2(x1[0], x1[1]); w.w = pk2(x1[2], x1[3]);
                        *(v4u*)(xb + (size_t)row * D + c0) = w; }
                    ss += (x0[0] * x0[0] + x0[1] * x0[1]) + (x0[2] * x0[2] + x0[3] * x0[3]) + (x1[0] * x1[0] + x1[1] * x1[1]) + (x1[2] * x1[2] + x1[3] * x1[3]);
                }
                ss += __shfl_xor(ss, 16); ss += __shfl_xor(ss, 32);
                if (fq == 0) ssq_out[(size_t)row * 16 + u.pn * 4 + wc] = ss;
                asm volatile("" ::: "memory");
            }
            return;
        }
        if (u.pm != cpm) {
            cpm = u.pm;
#pragma unroll
            for (int ai = 0; ai < 2; ++ai)
#pragma unroll
                for (int m = 0; m < 4; ++m) {
                    const int row = rbase + ai * 128 + m * 16;
                    const f32x4 p = *(const f32x4*)(ssq_in + (size_t)row * 16 + 4 * fq);
                    float s = (p[0] + p[1]) + (p[2] + p[3]); s += __shfl_xor(s, 16); s += __shfl_xor(s, 32);
                    crs[ai][m] = rsqrtf(s * (1.f / 1024.f) + EPS);
                }
        }
        float rstd[2][4];
#pragma unroll
        for (int ai = 0; ai < 2; ++ai)
#pragma unroll
            for (int m = 0; m < 4; ++m) rstd[ai][m] = crs[ai][m];
        if (mode == 0) {
            const int hc = u.pn * 128 + cl;
#pragma unroll
            for (int ai = 0; ai < 2; ++ai)
#pragma unroll
                for (int m = 0; m < 4; ++m) {
                    const int row = rbase + ai * 128 + m * 16; const float rs = rstd[ai][m];
                    const f32x4 g0 = acc[ai][0][m][0] * rs, g1 = acc[ai][0][m][1] * rs, u0 = acc[ai][1][m][0] * rs, u1 = acc[ai][1][m][1] * rs;
                    v4u w;
                    w.x = pk2v(silu_mul_pk((f32x2_t){g0[0], g0[1]}, (f32x2_t){u0[0], u0[1]})); w.y = pk2v(silu_mul_pk((f32x2_t){g0[2], g0[3]}, (f32x2_t){u0[2], u0[3]}));
                    w.z = pk2v(silu_mul_pk((f32x2_t){g1[0], g1[1]}, (f32x2_t){u1[0], u1[1]})); w.w = pk2v(silu_mul_pk((f32x2_t){g1[2], g1[3]}, (f32x2_t){u1[2], u1[3]}));
                    if (u.pm >= 64) {
                        unsigned long long* p8 = (unsigned long long*)(obf + (size_t)row * DFF + hc);
                        __hip_atomic_store(p8, (unsigned long long)w.x | ((unsigned long long)w.y << 32), __ATOMIC_RELAXED, __HIP_MEMORY_SCOPE_AGENT);
                        __hip_atomic_store(p8 + 1, (unsigned long long)w.z | ((unsigned long long)w.w << 32), __ATOMIC_RELAXED, __HIP_MEMORY_SCOPE_AGENT);
                    } else *(v4u*)(obf + (size_t)row * DFF + hc) = w;
                    asm volatile("" ::: "memory");
                }
            return;
        }
        const unsigned long long acts = sub ? ACTS_GL : ACTS_AB;
        const int ldo = sub ? PG : PA;
        const int code = (int)((acts >> (4 * u.pn)) & 15ull);
        if (code == ACT_NONE) return;
        if (code == ACT_DT) {
            if (cl == 0) {
                float* aux = (float*)(ws + WS_DT);
#pragma unroll
                for (int ai = 0; ai < 2; ++ai)
#pragma unroll
                    for (int m = 0; m < 4; ++m) {
                        const int row = rbase + ai * 128 + m * 16; const float rs = rstd[ai][m];
                        const f32x4 a0 = acc[ai][0][m][0] * rs, a1 = acc[ai][0][m][1] * rs; f32x4 d0, d1;
#pragma unroll
                        for (int j = 0; j < 4; ++j) { d0[j] = softplus_f(a0[j] + dtb[j]); d1[j] = softplus_f(a1[j] + dtb[4 + j]); }
                        *(f32x4*)(aux + (size_t)row * 8) = d0; *(f32x4*)(aux + (size_t)row * 8 + 4) = d1;
                    }
            }
            return;
        }
        if (code == ACT_GK) {
            if (cl < 16) {
                float* aux = (float*)(ws + WS_GK);
#pragma unroll
                for (int ai = 0; ai < 2; ++ai)
#pragma unroll
                    for (int m = 0; m < 4; ++m) {
                        const int row = rbase + ai * 128 + m * 16; const float rs = rstd[ai][m];
                        *(f32x4*)(aux + (size_t)row * 16 + cl) = acc[ai][0][m][0] * rs; *(f32x4*)(aux + (size_t)row * 16 + cl + 4) = acc[ai][0][m][1] * rs;
                    }
            }
            return;
        }
#pragma unroll
        for (int bj = 0; bj < 2; ++bj) {
            const int c0 = u.pn * 256 + bj * 128 + cl;
            float lbv[8];
            if (code == ACT_FGATE) {
#pragma unroll
                for (int j = 0; j < 8; ++j) { const float l0 = lbl[c0 - 512 + j], l1 = lbl[c0 + j]; lbv[j] = __builtin_amdgcn_rcpf(1.f + __expf(l1 - l0)); }
            }
#pragma unroll
            for (int ai = 0; ai < 2; ++ai)
#pragma unroll
                for (int m = 0; m < 4; ++m) {
                    const int row = rbase + ai * 128 + m * 16; const float rs = rstd[ai][m];
                    const f32x4 a0 = acc[ai][bj][m][0] * rs, a1 = acc[ai][bj][m][1] * rs;
                    float v[8] = {a0[0], a0[1], a0[2], a0[3], a1[0], a1[1], a1[2], a1[3]};
                    if (code == ACT_SILU) {
#pragma unroll
                        for (int j = 0; j < 8; ++j) v[j] = silu_f(v[j]);
                    } else if (code == ACT_QSCALE) {
#pragma unroll
                        for (int j = 0; j < 8; ++j) v[j] *= 0.08838834764831845f;
                    } else if (code == ACT_FGATE) {
                        float* lf = (float*)(ws + WS_LF);
                        f32x4 l0, l1;
#pragma unroll
                        for (int j = 0; j < 8; ++j) {
                            const float f = lbv[j] + (1.f - lbv[j]) * sigmoid_f(v[j]);
                            const float lg = __logf(f);
                            if (j < 4) l0[j] = lg; else l1[j - 4] = lg;
                            v[j] = 1.f - f;
                        }
                        *(f32x4*)(lf + (size_t)row * 512 + (c0 - 512)) = l0; *(f32x4*)(lf + (size_t)row * 512 + (c0 - 512) + 4) = l1;
                    }
                    if (code != ACT_FGATE) {
                        v4u w; w.x = pk2(v[0], v[1]); w.y = pk2(v[2], v[3]); w.z = pk2(v[4], v[5]); w.w = pk2(v[6], v[7]);
                        *(v4u*)(obf + (size_t)row * ldo + c0) = w; }
                    asm volatile("" ::: "memory");
                }
        }
    }
};

__device__ __forceinline__ void transpose_item(const float* __restrict__ W, int K, int N, bf16* __restrict__ WT, const float* __restrict__ scale, int mapmode,
                                               int item, int nblk, LAS float* scr, int lane) {
    const int kb = item / nblk, nb = item - kb * nblk, k0 = 64 * kb, n0 = 32 * nb;
    const int kr = lane >> 3, c4 = lane & 7;
    const bool ok = (n0 + 4 * c4) < N;
    f32x4 v[8];
#pragma unroll
    for (int i = 0; i < 8; ++i) v[i] = ok ? __builtin_nontemporal_load((const f32x4*)(W + (size_t)(k0 + kr + 8 * i) * N + n0 + 4 * c4)) : (f32x4){0.f, 0.f, 0.f, 0.f};
    if (scale) {
#pragma unroll
        for (int i = 0; i < 8; ++i) v[i] = v[i] * scale[k0 + kr + 8 * i];
    }
#pragma unroll
    for (int i = 0; i < 8; ++i) { LAS float* sp = scr + (kr + 8 * i) * 33 + 4 * c4; sp[0] = v[i][0]; sp[1] = v[i][1]; sp[2] = v[i][2]; sp[3] = v[i][3]; }
    LDS_WAIT(); asm volatile("" ::: "memory");
    int drow0 = n0;
    if (mapmode == 1) drow0 = (n0 < DFF) ? (n0 >> 7) * 256 + (n0 & 127) : ((n0 - DFF) >> 7) * 256 + 128 + ((n0 - DFF) & 127);
    const int c = lane & 7;
#pragma unroll
    for (int j = 0; j < 4; ++j) {
        const int nn = (lane >> 3) + 8 * j; const LAS float* s = scr + (8 * c) * 33 + nn;
        v4u o; o.x = pk2(s[0 * 33], s[1 * 33]); o.y = pk2(s[2 * 33], s[3 * 33]); o.z = pk2(s[4 * 33], s[5 * 33]); o.w = pk2(s[6 * 33], s[7 * 33]);
        *(v4u*)(WT + (size_t)(drow0 + nn) * K + k0 + 8 * c) = o;
    }
    LDS_WAIT(); asm volatile("" ::: "memory");
}

__device__ __forceinline__ void phase_prep(const Args& a, int z, LAS unsigned char* lds) {
    const int tid = threadIdx.x, lane = tid & 63, wave = tid >> 6;
    LAS float* scr = (LAS float*)(lds + wave * 16384);
    const int gw = blockIdx.x * NWAVES + wave, NGW = gridDim.x * NWAVES;
    unsigned char* ws = a.ws;
    constexpr int I_FI = 16 * 176, I_FO = 44 * 32, I_AI = 16 * 120, I_AO = 16 * 32, I_GI = 16 * 104, I_GO = 16 * 32;
    constexpr int NITEMS = 4 * I_FI + 4 * I_FO + I_AI + I_AO + I_GI + I_GO;
    for (int it = gw; it < NITEMS; it += NGW) {
        int r = it;
        if (r < 4 * I_FI) { const int i = r / I_FI, l = i >> 1, w2 = i & 1; r -= i * I_FI;
            transpose_item(a.in[z + (w2 ? 12 : 10)] + (size_t)l * D * NFI, D, NFI, (bf16*)(ws + WS_WFI + i * SZ_WFI), a.in[z + (w2 ? 8 : 6)] + l * D, 1, r, 176, scr, lane); continue; }
        r -= 4 * I_FI;
        if (r < 4 * I_FO) { const int i = r / I_FO, l = i >> 1, w2 = i & 1; r -= i * I_FO;
            transpose_item(a.in[z + (w2 ? 13 : 11)] + (size_t)l * DFF * D, DFF, D, (bf16*)(ws + WS_WFO + i * SZ_WFO), nullptr, 0, r, 32, scr, lane); continue; }
        r -= 4 * I_FO;
        if (r < I_AI) { transpose_item(a.in[z + (14)], D, NAB, (bf16*)(ws + WS_WAI), a.in[z + (7)], 0, r, 120, scr, lane); continue; }
        r -= I_AI;
        if (r < I_AO) { transpose_item(a.in[z + (15)], D, D, (bf16*)(ws + WS_WAO), nullptr, 0, r, 32, scr, lane); continue; }
        r -= I_AO;
        if (r < I_GI) { transpose_item(a.in[z + (24)], D, NGL, (bf16*)(ws + WS_WGI), a.in[z + (7)] + D, 0, r, 104, scr, lane); continue; }
        r -= I_GI;
        transpose_item(a.in[z + (28)], D, D, (bf16*)(ws + WS_WGO), nullptr, 0, r, 32, scr, lane);
    }
    bf16* XB = (bf16*)(ws + WS_XB); float* SSQ = (float*)(ws + WS_SSQ);
    for (int m = gw; m < T; m += NGW) {
        const float* src = (m < TP) ? a.in[z + (0)] + (size_t)m * D : a.in[z + (1)] + (size_t)(m - TP) * D;
        const f32x4* xr = (const f32x4*)src + lane;
        unsigned long long* o8 = (unsigned long long*)(XB + (size_t)m * D) + lane;
        float s = 0.f;
#pragma unroll
        for (int j = 0; j < 4; ++j) { const f32x4 v = xr[64 * j]; s += (v[0] * v[0] + v[1] * v[1]) + (v[2] * v[2] + v[3] * v[3]);
            o8[64 * j] = (unsigned long long)pk2(v[0], v[1]) | ((unsigned long long)pk2(v[2], v[3]) << 32); }
        s = wave_sum(s);
        if (lane < 16) SSQ[(size_t)m * 16 + lane] = (lane == 0) ? s : 0.f;
    }
}

constexpr int CK_QD = 0, CK_QS = 17408, CK_KI = 34816, CK_KET = 52224, CK_VT = 70656, CK_P = 75264, CK_ST = 84480, CK_SEG = 93184, CK_DEC = 95232,
              CK_OX = 95744, CK_DTS = 103936, CK_DTV = 104192, CK_GS = 104448;
constexpr int LQ = 136, LT = 72;
typedef short bf16x8_t __attribute__((ext_vector_type(8)));

__device__ __forceinline__ f32x4 mma_tile(const LAS bf16* F, int ldf, const LAS bf16* Sx, int lds_, int kc, f32x4 acc, int lane) {
    const int r = lane & 15, q = lane >> 4;
    const LAS bf16* fp = F + r * ldf + 8 * q; const LAS bf16* sp = Sx + r * lds_ + 8 * q;
    for (int k = 0; k < kc; k += 32) {
        const bf16x8_t fa = *(const LAS bf16x8_t*)(fp + k), sb = *(const LAS bf16x8_t*)(sp + k);
        acc = __builtin_amdgcn_mfma_f32_16x16x32_bf16(fa, sb, acc, 0, 0, 0);
    }
    return acc;
}

template <int TYPE>
__device__ __forceinline__ void chunk_unit(const Args& a, int z, int b, int h, int s, LAS unsigned char* lds) {
    constexpr int V = (TYPE == 0) ? 128 : (TYPE == 1) ? 64 : 256;
    constexpr int H = (TYPE == 1) ? 8 : 4;
    const int tid = threadIdx.x, lane = tid & 63, wave = tid >> 6, r = lane & 15, q = lane >> 4;
    LAS bf16* Qd = (LAS bf16*)(lds + CK_QD); LAS bf16* Qs = (TYPE == 1) ? (LAS bf16*)(lds + CK_QS) : Qd; LAS bf16* Ki = (LAS bf16*)(lds + CK_KI);
    LAS bf16* KeT = (LAS bf16*)(lds + CK_KET); LAS bf16* VT = (LAS bf16*)(lds + CK_VT); LAS bf16* P = (LAS bf16*)(lds + CK_P); LAS bf16* ST = (LAS bf16*)(lds + CK_ST);
    LAS float* SEG = (LAS float*)(lds + CK_SEG); LAS float* DEC = (LAS float*)(lds + CK_DEC); LAS float* OX = (LAS float*)(lds + CK_OX);
    LAS float* DTS = (LAS float*)(lds + CK_DTS); LAS float* DTV = (LAS float*)(lds + CK_DTV); LAS float* GS = (LAS float*)(lds + CK_GS);
    unsigned char* ws = a.ws;
    const bf16* PJ = (const bf16*)(ws + WS_PROJ);
    const float* LF = (const float*)(ws + WS_LF); const float* DT = (const float*)(ws + WS_DT); const float* GK = (const float*)(ws + WS_GK);
    bf16* OG = (bf16*)(ws + WS_OG);
    const int kl = tid & 127, seg = tid >> 7;
    const int vl = tid & 31, tq = tid >> 5;
    const int g = h >> 2;
    float a_h = 0.f, d_h = 0.f;
    if (TYPE == 1) { a_h = -__expf(a.in[z + 21][h]); d_h = a.in[z + 22][h]; }
    f32x4 sacc[2] = {(f32x4){0.f, 0.f, 0.f, 0.f}, (f32x4){0.f, 0.f, 0.f, 0.f}};
    __syncthreads();
    for (int e = tid; e < 32 * LQ / 2; e += 512) ((LAS unsigned*)ST)[e] = 0u;
    const int colbase = (TYPE == 0) ? h * 128 + s * 32 : (TYPE == 1) ? 512 + h * 64 + s * 32 : h * 256 + s * 32;
    const int tb = 16 * seg;
    constexpr int PP = (TYPE == 2) ? PG : PA;
    struct Raw { float lf[16]; unsigned q[16], k[16], v[4]; float dt; };
    const bf16* CV = (const bf16*)(ws + WS_XB);
    auto load_raw = [&](Raw& w, int n_) {
        const int row0_ = b * 2048 + n_ * 64;
#pragma unroll
        for (int i = 0; i < 16; ++i) { const size_t R = (size_t)(row0_ + tb + i);
            if (TYPE != 1) { w.lf[i] = LF[R * 512 + h * 128 + kl]; w.q[i] = PJ[R * PP + h * 128 + kl]; if (TYPE == 2) w.k[i] = PJ[R * PP + 512 + h * 128 + kl]; }
            else { w.q[i] = CV[R * 1024 + 768 + g * 128 + kl]; w.k[i] = CV[R * 1024 + 512 + g * 128 + kl]; } }
#pragma unroll
        for (int i = 0; i < 4; ++i) { const size_t R = (size_t)(row0_ + 4 * tq + i);
            w.v[i] = (TYPE == 1) ? CV[R * 1024 + h * 64 + s * 32 + vl] : PJ[R * PP + 1024 + h * V + s * 32 + vl]; }
        if (TYPE == 1) w.dt = (tid < 64) ? DT[(size_t)(row0_ + tid) * 8 + h] : 0.f;
    };
    Raw rc, rn;
    load_raw(rc, 0);
    for (int n = 0; n < 32; ++n) {
        const int row0 = b * 2048 + n * 64;
        if (n + 1 < 32) load_raw(rn, n + 1);
        float glast, goff;
        if (TYPE != 1) {
            float run = 0.f;
#pragma unroll
            for (int i = 0; i < 16; ++i) run += rc.lf[i];
            SEG[seg * 128 + kl] = run;
            __syncthreads();
            const float s0 = SEG[kl], s1 = SEG[128 + kl], s2 = SEG[256 + kl], s3 = SEG[384 + kl];
            goff = (seg > 0 ? s0 : 0.f) + (seg > 1 ? s1 : 0.f) + (seg > 2 ? s2 : 0.f);
            glast = (s0 + s1) + (s2 + s3);
        } else {
            if (tid < 64) { DTS[tid] = rc.dt * a_h; DTV[tid] = rc.dt; }
            __syncthreads();
            float off = 0.f, tot = 0.f;
            for (int t = 0; t < 64; t += 4) { const f32x4 d4 = *(const LAS f32x4*)(DTS + t); const float d = (d4[0] + d4[1]) + (d4[2] + d4[3]); tot += d; if (t < tb) off += d; }
            glast = tot; goff = off;
        }
        {
            const float eglast = __expf(glast);
            unsigned kew[8];
            float grun = goff;
#pragma unroll
            for (int i = 0; i < 16; i += 2) {
                float q0, q1, k0, k1, g0, g1;
                q0 = __uint_as_float(rc.q[i] << 16); q1 = __uint_as_float(rc.q[i + 1] << 16);
                if (TYPE == 0) { k0 = 1.f - __expf(rc.lf[i]); k1 = 1.f - __expf(rc.lf[i + 1]); }
                else { k0 = __uint_as_float(rc.k[i] << 16); k1 = __uint_as_float(rc.k[i + 1] << 16); }
                if (TYPE != 1) { grun += rc.lf[i]; g0 = grun; grun += rc.lf[i + 1]; g1 = grun; }
                else { grun += DTS[tb + i]; g0 = grun; grun += DTS[tb + i + 1]; g1 = grun; if (kl == 0) { GS[tb + i] = g0; GS[tb + i + 1] = g1; } }
                const float e0 = __expf(g0), e1 = __expf(g1);
                const int t = tb + i;
                if (TYPE == 1) {
                    const unsigned cq = pk2(q0, q1), ck = pk2(k0, k1);
                    Qs[t * LQ + kl] = (bf16)(cq & 0xffffu); Qs[(t + 1) * LQ + kl] = (bf16)(cq >> 16);
                    Ki[t * LQ + kl] = (bf16)(ck & 0xffffu); Ki[(t + 1) * LQ + kl] = (bf16)(ck >> 16);
                    kew[i >> 1] = pk2(k0 * __expf(glast - g0), k1 * __expf(glast - g1));
                } else {
                    const float i0 = __builtin_amdgcn_rcpf(e0), i1 = __builtin_amdgcn_rcpf(e1);
                    const unsigned kk = pk2(k0 * i0, k1 * i1);
                    Ki[t * LQ + kl] = (bf16)(kk & 0xffffu); Ki[(t + 1) * LQ + kl] = (bf16)(kk >> 16);
                    kew[i >> 1] = pk2(k0 * (eglast * i0), k1 * (eglast * i1));
                }
                const unsigned qq = pk2(q0 * e0, q1 * e1);
                Qd[t * LQ + kl] = (bf16)(qq & 0xffffu); Qd[(t + 1) * LQ + kl] = (bf16)(qq >> 16);
            }
            *(LAS v4u*)(KeT + kl * LT + tb) = (v4u){kew[0], kew[1], kew[2], kew[3]};
            *(LAS v4u*)(KeT + kl * LT + tb + 8) = (v4u){kew[4], kew[5], kew[6], kew[7]};
            if (seg == 0) DEC[kl] = eglast;
        }
        {
            if (TYPE != 1) {
                *(LAS v2u*)(VT + vl * LT + 4 * tq) = (v2u){rc.v[0] | (rc.v[1] << 16), rc.v[2] | (rc.v[3] << 16)};
            } else {
                float vv4[4];
#pragma unroll
                for (int i = 0; i < 4; ++i) { const float x = __uint_as_float(rc.v[i] << 16); OX[(4 * tq + i) * 32 + vl] = d_h * x; vv4[i] = x * DTV[4 * tq + i]; }
                *(LAS v2u*)(VT + vl * LT + 4 * tq) = (v2u){pk2(vv4[0], vv4[1]), pk2(vv4[2], vv4[3])};
            }
        }
        __syncthreads();
#pragma unroll
        for (int u2 = 0; u2 < 2; ++u2) {
            const int t = 2 * wave + u2, ti = t >> 2, tj = t & 3;
            v2u w = (v2u){0u, 0u};
            if (tj <= ti) {
                f32x4 acc = (f32x4){0.f, 0.f, 0.f, 0.f};
                acc = mma_tile(Ki + tj * 16 * LQ, LQ, Qs + ti * 16 * LQ, LQ, 128, acc, lane);
                const int i = 16 * ti + r, j0 = 16 * tj + 4 * q;
                float pv[4];
#pragma unroll
                for (int e = 0; e < 4; ++e) { float x = acc[e];
                    if (TYPE == 1) x *= __expf(fminf(GS[i] - GS[j0 + e], 0.f));
                    pv[e] = (j0 + e <= i) ? x : 0.f; }
                w = (v2u){pk2(pv[0], pv[1]), pk2(pv[2], pv[3])};
            }
            *(LAS v2u*)(P + (16 * ti + r) * LT + 16 * tj + 4 * q) = w;
        }
        __syncthreads();
        {
            const int ti = wave >> 1, tv = wave & 1;
            f32x4 acc = (f32x4){0.f, 0.f, 0.f, 0.f};
            acc = mma_tile(VT + tv * 16 * LT, LT, P + ti * 16 * LT, LT, (ti < 2) ? 32 : 64, acc, lane);
            acc = mma_tile(ST + tv * 16 * LQ, LQ, Qd + ti * 16 * LQ, LQ, 128, acc, lane);
            const int i = 16 * ti + r, v0 = 16 * tv + 4 * q;
            if (TYPE == 1) { const f32x4 ox = *(const LAS f32x4*)(OX + i * 32 + v0); acc = acc + ox; }
            *(v2u*)(OG + (size_t)(row0 + i) * D + colbase + v0) = (v2u){pk2(acc[0], acc[1]), pk2(acc[2], acc[3])};
        }
#pragma unroll
        for (int u2 = 0; u2 < 2; ++u2) {
            const int ti = 2 * wave + u2, vt = ti >> 3, kt = ti & 7;
            const f32x4 dc = *(const LAS f32x4*)(DEC + 16 * kt + 4 * q);
            sacc[u2] = sacc[u2] * dc;
            sacc[u2] = mma_tile(KeT + kt * 16 * LT, LT, VT + vt * 16 * LT, LT, 64, sacc[u2], lane);
        }
        __syncthreads();
#pragma unroll
        for (int u2 = 0; u2 < 2; ++u2) {
            const int ti = 2 * wave + u2, vt = ti >> 3, kt = ti & 7;
            *(LAS v2u*)(ST + (16 * vt + r) * LQ + 16 * kt + 4 * q) = (v2u){pk2(sacc[u2][0], sacc[u2][1]), pk2(sacc[u2][2], sacc[u2][3])};
        }
        rc = rn;
    }
#pragma unroll
    for (int u2 = 0; u2 < 2; ++u2) {
        const int ti = 2 * wave + u2, vt = ti >> 3, kt = ti & 7;
        const int k0 = 16 * kt + 4 * q, v = 16 * vt + r;
        if (TYPE == 1) {
            *(f32x4*)(a.out + O_SP + ((size_t)(b * 8 + h) * 64 + s * 32 + v) * 128 + k0) = sacc[u2];
        } else {
            float* dp = a.out + (TYPE == 0 ? O_HP : O_GP) + (size_t)(b * H + h) * 128 * V + s * 32 + v;
#pragma unroll
            for (int e = 0; e < 4; ++e) dp[(size_t)(k0 + e) * V] = sacc[u2][e];
        }
    }
    __syncthreads();
}

constexpr int RECA = 36352, RECP = 9216;
constexpr size_t WS_PREA = WS_END;
constexpr size_t WS_PREP_V = WS_WFI, WS_PREP_S = WS_WFO;
constexpr size_t WS_NEED = WS_PREA + (size_t)1536 * RECA;

template <int TYPE>
__device__ __forceinline__ void pre_unit(const Args& a, int z, int b, int h, int n, int rec, LAS unsigned char* lds) {
    const int tid = threadIdx.x, lane = tid & 63, wave = __builtin_amdgcn_readfirstlane(tid >> 6), r = lane & 15, q = lane >> 4;
    LAS bf16* Qd = (LAS bf16*)(lds + CK_QD); LAS bf16* Qs = (LAS bf16*)(lds + CK_QS); LAS bf16* Ki = (LAS bf16*)(lds + CK_KI);
    LAS bf16* KeT = (LAS bf16*)(lds + CK_KET); LAS bf16* P = (LAS bf16*)(lds + CK_P);
    LAS float* SEG = (LAS float*)(lds + CK_SEG); LAS float* DEC = (LAS float*)(lds + CK_DEC);
    unsigned char* ws = a.ws;
    const bf16* PJ = (const bf16*)(ws + WS_PROJ); const float* LF = (const float*)(ws + WS_LF); const bf16* CV = (const bf16*)(ws + WS_XB);
    const int kl = tid & 127, seg = tid >> 7, tb = 16 * seg;
    constexpr int PP = (TYPE == 2) ? PG : PA;
    const int row0 = b * 2048 + n * 64;
    float lf[16]; unsigned rq[16], rk[16];
#pragma unroll
    for (int i = 0; i < 16; ++i) { const size_t R = (size_t)(row0 + tb + i);
        if (TYPE == 0) { lf[i] = LF[R * 512 + h * 128 + kl]; rq[i] = PJ[R * PP + h * 128 + kl]; }
        else if (TYPE == 2) { rq[i] = PJ[R * PP + h * 128 + kl]; rk[i] = PJ[R * PP + 512 + h * 128 + kl]; } }
    if (TYPE == 2) {
        const float* GK = (const float*)(ws + WS_GK);
        float wg[16];
#pragma unroll
        for (int r2 = 0; r2 < 16; ++r2) wg[r2] = a.in[z + 25][r2 * 512 + h * 128 + kl];
        const float bg = a.in[z + 26][h * 128 + kl];
#pragma unroll
        for (int i = 0; i < 16; ++i) { const size_t R = (size_t)(row0 + tb + i);
            const f32x4 g0 = *(const f32x4*)(GK + R * 16), g1 = *(const f32x4*)(GK + R * 16 + 4), g2 = *(const f32x4*)(GK + R * 16 + 8), g3 = *(const f32x4*)(GK + R * 16 + 12);
            float x = bg;
#pragma unroll
            for (int j = 0; j < 4; ++j) x += g0[j] * wg[j] + g1[j] * wg[4 + j] + g2[j] * wg[8 + j] + g3[j] * wg[12 + j];
            lf[i] = -softplus_f(-x) * (1.f / 16.f); }
    }
    if (TYPE == 1) {
        float rb[19], rcc[19];
#pragma unroll
        for (int i = 0; i < 19; ++i) { const int tt = n * 64 + tb - 3 + i;
            if (tt >= 0) { const size_t R2 = (size_t)(b * 2048 + tt); rb[i] = bf2f(PJ[R2 * PA + 2560 + 512 + h * 128 + kl]); rcc[i] = bf2f(PJ[R2 * PA + 2560 + 768 + h * 128 + kl]); }
            else { rb[i] = 0.f; rcc[i] = 0.f; } }
        float cwB[4], cwC[4];
#pragma unroll
        for (int w = 0; w < 4; ++w) { cwB[w] = a.in[z + 18][w * 1024 + 512 + h * 128 + kl]; cwC[w] = a.in[z + 18][w * 1024 + 768 + h * 128 + kl]; }
        const float cbB = a.in[z + 19][512 + h * 128 + kl], cbC = a.in[z + 19][768 + h * 128 + kl];
#pragma unroll
        for (int i = 0; i < 16; i += 2) { float ab0 = cbB, ac0 = cbC, ab1 = cbB, ac1 = cbC;
#pragma unroll
            for (int w = 0; w < 4; ++w) { ab0 += rb[i + w] * cwB[w]; ac0 += rcc[i + w] * cwC[w]; ab1 += rb[i + 1 + w] * cwB[w]; ac1 += rcc[i + 1 + w] * cwC[w]; }
            const unsigned pb = pk2(silu_f(ab0), silu_f(ab1)), pc = pk2(silu_f(ac0), silu_f(ac1));
            rk[i] = pb & 0xffffu; rk[i + 1] = pb >> 16; rq[i] = pc & 0xffffu; rq[i + 1] = pc >> 16; }
        {
            const int xc = h * 256 + (tid & 255), t0x = 32 * (tid >> 8);
            bf16* CVw = (bf16*)(ws + WS_XB);
            float cwX[4];
#pragma unroll
            for (int w = 0; w < 4; ++w) cwX[w] = a.in[z + 18][w * 1024 + xc];
            const float cbX = a.in[z + 19][xc];
            float w3[3];
#pragma unroll
            for (int j = 0; j < 3; ++j) { const int tt = n * 64 + t0x - 3 + j; w3[j] = (tt >= 0) ? bf2f(PJ[(size_t)(b * 2048 + tt) * PA + 2560 + xc]) : 0.f; }
            for (int t8 = 0; t8 < 32; t8 += 8) {
                float nw[8];
#pragma unroll
                for (int j = 0; j < 8; ++j) nw[j] = bf2f(PJ[(size_t)(row0 + t0x + t8 + j) * PA + 2560 + xc]);
#pragma unroll
                for (int j = 0; j < 8; ++j) { const float ax = cbX + w3[0] * cwX[0] + w3[1] * cwX[1] + w3[2] * cwX[2] + nw[j] * cwX[3];
                    CVw[(size_t)(row0 + t0x + t8 + j) * 1024 + xc] = (bf16)(pk2(silu_f(ax), 0.f) & 0xffffu);
                    w3[0] = w3[1]; w3[1] = w3[2]; w3[2] = nw[j]; }
            }
        }
    }
    if (TYPE != 1) {
        float run = 0.f;
#pragma unroll
        for (int i = 0; i < 16; ++i) run += lf[i];
        SEG[seg * 128 + kl] = run;
        __syncthreads();
        const float s0 = SEG[kl], s1 = SEG[128 + kl], s2 = SEG[256 + kl], s3 = SEG[384 + kl];
        const float goff = (seg > 0 ? s0 : 0.f) + (seg > 1 ? s1 : 0.f) + (seg > 2 ? s2 : 0.f);
        const float glast = (s0 + s1) + (s2 + s3), eglast = __expf(glast);
        unsigned kew[8]; float grun = goff;
#pragma unroll
        for (int i = 0; i < 16; i += 2) {
            const float q0 = __uint_as_float(rq[i] << 16), q1 = __uint_as_float(rq[i + 1] << 16);
            float k0, k1;
            if (TYPE == 0) { k0 = 1.f - __expf(lf[i]); k1 = 1.f - __expf(lf[i + 1]); } else { k0 = __uint_as_float(rk[i] << 16); k1 = __uint_as_float(rk[i + 1] << 16); }
            grun += lf[i]; const float g0 = grun; grun += lf[i + 1]; const float g1 = grun;
            const float e0 = __expf(g0), e1 = __expf(g1), i0 = __builtin_amdgcn_rcpf(e0), i1 = __builtin_amdgcn_rcpf(e1);
            const int t = tb + i;
            const unsigned kk = pk2(k0 * i0, k1 * i1), qq = pk2(q0 * e0, q1 * e1);
            Ki[t * LQ + kl] = (bf16)(kk & 0xffffu); Ki[(t + 1) * LQ + kl] = (bf16)(kk >> 16);
            Qd[t * LQ + kl] = (bf16)(qq & 0xffffu); Qd[(t + 1) * LQ + kl] = (bf16)(qq >> 16);
            kew[i >> 1] = pk2(k0 * (eglast * i0), k1 * (eglast * i1));
        }
        *(LAS v4u*)(KeT + kl * LT + tb) = (v4u){kew[0], kew[1], kew[2], kew[3]};
        *(LAS v4u*)(KeT + kl * LT + tb + 8) = (v4u){kew[4], kew[5], kew[6], kew[7]};
        if (seg == 0) DEC[kl] = eglast;
    } else {
        unsigned kew[8];
#pragma unroll
        for (int i = 0; i < 16; i += 2) { const int t = tb + i;
            Qs[t * LQ + kl] = (bf16)rq[i]; Qs[(t + 1) * LQ + kl] = (bf16)rq[i + 1];
            Ki[t * LQ + kl] = (bf16)rk[i]; Ki[(t + 1) * LQ + kl] = (bf16)rk[i + 1];
            kew[i >> 1] = rk[i] | (rk[i + 1] << 16); }
        *(LAS v4u*)(KeT + kl * LT + tb) = (v4u){kew[0], kew[1], kew[2], kew[3]};
        *(LAS v4u*)(KeT + kl * LT + tb + 8) = (v4u){kew[4], kew[5], kew[6], kew[7]};
    }
    __syncthreads();
    {
        LAS bf16* Qx = (TYPE == 1) ? Qs : Qd;
#pragma unroll
        for (int u2 = 0; u2 < 2; ++u2) {
            const int t = 2 * wave + u2, ti = t >> 2, tj = t & 3;
            v2u w = (v2u){0u, 0u};
            if (tj <= ti) {
                f32x4 acc = (f32x4){0.f, 0.f, 0.f, 0.f};
                acc = mma_tile(Ki + tj * 16 * LQ, LQ, Qx + ti * 16 * LQ, LQ, 128, acc, lane);
                const int i = 16 * ti + r, j0 = 16 * tj + 4 * q;
                float pv[4];
#pragma unroll
                for (int e = 0; e < 4; ++e) pv[e] = (TYPE == 1 || j0 + e <= i) ? acc[e] : 0.f;
                w = (v2u){pk2(pv[0], pv[1]), pk2(pv[2], pv[3])};
            }
            *(LAS v2u*)(P + (16 * ti + r) * LT + 16 * tj + 4 * q) = w;
        }
    }
    __syncthreads();
    {
        unsigned char* ra = ws + WS_PREA + (size_t)rec * RECA;
        unsigned char* rp = ws + ((TYPE == 1) ? WS_PREP_S : WS_PREP_V) + (size_t)((TYPE == 1) ? rec - 1024 : rec) * RECP;
        const LAS unsigned char* s0 = lds + ((TYPE == 1) ? CK_QS : CK_QD);
        for (int p = tid; p < 1088; p += 512) *(v4u*)(ra + 16 * p) = *(const LAS v4u*)(s0 + 16 * p);
        for (int p = tid; p < 1152; p += 512) *(v4u*)(ra + 17408 + 16 * p) = *(const LAS v4u*)(lds + CK_KET + 16 * p);
        if (TYPE != 1 && tid < 32) *(v4u*)(ra + 35840 + 16 * tid) = *(const LAS v4u*)(lds + CK_DEC + 16 * tid);
        for (int p = tid; p < 576; p += 512) *(v4u*)(rp + 16 * p) = *(const LAS v4u*)(lds + CK_P + 16 * p);
    }
    __syncthreads();
}

constexpr int S2_QD = 0, S2_KET = 17408, S2_DEC = 35840, S2_P = 36352, S2_VT = 45568, S2_ST = 50176, S2_VT2 = 58880, S2_OX = 63488, S2_GS = 71680, S2_EG = 72192, S2_DTV = 72704, S2_GL = 73216;
template <int TYPE>
__device__ __forceinline__ void seq2_unit(const Args& a, int z, int b, int h, int s, LAS unsigned char* lds) {
    constexpr int V = (TYPE == 0) ? 128 : (TYPE == 1) ? 64 : 256;
    constexpr int H = (TYPE == 1) ? 8 : 4;
    const int tid = threadIdx.x, lane = tid & 63, wave = __builtin_amdgcn_readfirstlane(tid >> 6), r = lane & 15, q = lane >> 4;
    LAS bf16* Qd = (LAS bf16*)(lds + S2_QD); LAS bf16* KeT = (LAS bf16*)(lds + S2_KET); LAS float* DEC = (LAS float*)(lds + S2_DEC);
    LAS bf16* P = (LAS bf16*)(lds + S2_P); LAS bf16* VT = (LAS bf16*)(lds + S2_VT); LAS bf16* ST = (LAS bf16*)(lds + S2_ST); LAS bf16* VT2 = (LAS bf16*)(lds + S2_VT2);
    LAS float* OX = (LAS float*)(lds + S2_OX); LAS float* GS = (LAS float*)(lds + S2_GS); LAS float* EG = (LAS float*)(lds + S2_EG); LAS float* DTV = (LAS float*)(lds + S2_DTV);
    LAS float* GL = (LAS float*)(lds + S2_GL);
    unsigned char* ws = a.ws;
    const bf16* PJ = (const bf16*)(ws + WS_PROJ); const float* DT = (const float*)(ws + WS_DT); const bf16* CV = (const bf16*)(ws + WS_XB);
    bf16* OG = (bf16*)(ws + WS_OG);
    const int vl = tid & 31, tq = tid >> 5;
    constexpr int PP = (TYPE == 2) ? PG : PA;
    float a_h = 0.f, d_h = 0.f;
    if (TYPE == 1) { a_h = -__expf(a.in[z + 21][h]); d_h = a.in[z + 22][h]; }
    const int rec0 = (TYPE == 1) ? 1024 + (b * 2 + (h >> 2)) * 32 : (b * 4 + h) * 32;
    const unsigned char* ra0 = ws + WS_PREA + (size_t)rec0 * RECA;
    const unsigned char* rp0 = ws + ((TYPE == 1) ? WS_PREP_S + (size_t)(rec0 - 1024) * RECP : WS_PREP_V + (size_t)rec0 * RECP);
    constexpr int NA = (TYPE == 1) ? 2240 : 2272;
    struct Pre { v4u a[5]; v4u p[2]; unsigned v[4]; float dt; };
    auto load_pre = [&](Pre& w, int n_) {
        const unsigned char* ra = ra0 + (size_t)n_ * RECA; const unsigned char* rp = rp0 + (size_t)n_ * RECP;
#pragma unroll
        for (int j = 0; j < 5; ++j) { const int p = tid + 512 * j; if (p < NA) w.a[j] = *(const v4u*)(ra + 16 * p); }
        w.p[0] = *(const v4u*)(rp + 16 * tid); if (tid < 64) w.p[1] = *(const v4u*)(rp + 16 * (tid + 512));
        const int row0_ = b * 2048 + n_ * 64;
#pragma unroll
        for (int i = 0; i < 4; ++i) { const size_t R = (size_t)(row0_ + 4 * tq + i);
            w.v[i] = (TYPE == 1) ? CV[R * 1024 + h * 64 + s * 32 + vl] : PJ[R * PP + 1024 + h * V + s * 32 + vl]; }
        if (TYPE == 1) w.dt = (tid < 64) ? DT[(size_t)(row0_ + tid) * 8 + h] : 0.f;
    };
    f32x4 sacc[2] = {(f32x4){0.f, 0.f, 0.f, 0.f}, (f32x4){0.f, 0.f, 0.f, 0.f}};
    __syncthreads();
    for (int e = tid; e < 32 * LQ / 2; e += 512) ((LAS unsigned*)ST)[e] = 0u;
    const int colbase = (TYPE == 0) ? h * 128 + s * 32 : (TYPE == 1) ? 512 + h * 64 + s * 32 : h * 256 + s * 32;
    Pre rc, rn;
    load_pre(rc, 0);
    float dt1 = 0.f, dt2 = 0.f;
    auto scan_into = [&](float dtv, int buf) {
        float x = dtv * a_h;
#pragma unroll
        for (int o = 1; o < 64; o <<= 1) { const float y = __shfl_up(x, o); if (lane >= o) x += y; }
        GS[64 * buf + lane] = x; EG[64 * buf + lane] = __expf(x); DTV[64 * buf + lane] = dtv; if (lane == 63) GL[buf] = x;
    };
    if (TYPE == 1) {
        if (wave == 0) { scan_into(rc.dt, 0); dt1 = DT[(size_t)(b * 2048 + 64 + lane) * 8 + h]; }
        __syncthreads();
    }
    for (int n = 0; n < 32; ++n) {
        const int row0 = b * 2048 + n * 64;
        const int sb = n & 1;
        if (n + 1 < 32) load_pre(rn, n + 1);
        if (TYPE == 1 && wave == 0 && n + 2 < 32) dt2 = DT[(size_t)(b * 2048 + (n + 2) * 64 + lane) * 8 + h];
#pragma unroll
        for (int j = 0; j < 5; ++j) { const int p = tid + 512 * j; if (p < NA) *(LAS v4u*)(lds + 16 * p) = rc.a[j]; }
        if (TYPE != 1) {
            *(LAS v4u*)(lds + S2_P + 16 * tid) = rc.p[0]; if (tid < 64) *(LAS v4u*)(lds + S2_P + 16 * (tid + 512)) = rc.p[1];
            *(LAS v2u*)(VT + vl * LT + 4 * tq) = (v2u){rc.v[0] | (rc.v[1] << 16), rc.v[2] | (rc.v[3] << 16)};
        } else {
            const LAS float* GSb = GS + 64 * sb; const LAS float* DTVb = DTV + 64 * sb;
            const float glast = GL[sb];
#pragma unroll
            for (int jj = 0; jj < 2; ++jj) {
                const int p = tid + 512 * jj;
                if (jj == 0 || tid < 64) {
                    const int i = p / 9, c8 = p - 9 * i; v4u c = rc.p[jj];
                    if (c8 < 8) {
                        const int j0 = 8 * c8; const unsigned cw[4] = {c.x, c.y, c.z, c.w}; unsigned o[4];
                        const float gi = GSb[i];
#pragma unroll
                        for (int e = 0; e < 4; ++e) { const int j = j0 + 2 * e;
                            const float x0 = (j <= i) ? __uint_as_float(cw[e] << 16) * __expf(gi - GSb[j]) : 0.f;
                            const float x1 = (j + 1 <= i) ? __uint_as_float(cw[e] & 0xffff0000u) * __expf(gi - GSb[j + 1]) : 0.f;
                            o[e] = pk2(x0, x1); }
                        c = (v4u){o[0], o[1], o[2], o[3]};
                    }
                    *(LAS v4u*)(lds + S2_P + 16 * p) = c;
                }
            }
            {
                float v1[4], v2[4];
#pragma unroll
                for (int i = 0; i < 4; ++i) { const int t = 4 * tq + i; const float x = __uint_as_float(rc.v[i] << 16); OX[t * 32 + vl] = d_h * x; v1[i] = x * DTVb[t]; v2[i] = v1[i] * __expf(glast - GSb[t]); }
                *(LAS v2u*)(VT + vl * LT + 4 * tq) = (v2u){pk2(v1[0], v1[1]), pk2(v1[2], v1[3])};
                *(LAS v2u*)(VT2 + vl * LT + 4 * tq) = (v2u){pk2(v2[0], v2[1]), pk2(v2[2], v2[3])};
            }
        }
        __syncthreads();
        if (TYPE == 1 && wave == 0 && n + 1 < 32) scan_into(dt1, sb ^ 1);
        {
            const int ti = wave >> 1, tv = wave & 1;
            f32x4 acc = (f32x4){0.f, 0.f, 0.f, 0.f}, acc2 = (f32x4){0.f, 0.f, 0.f, 0.f};
            acc = mma_tile(VT + tv * 16 * LT, LT, P + ti * 16 * LT, LT, (ti < 2) ? 32 : 64, acc, lane);
            acc2 = mma_tile(ST + tv * 16 * LQ, LQ, Qd + ti * 16 * LQ, LQ, 128, acc2, lane);
            const int i = 16 * ti + r, v0 = 16 * tv + 4 * q;
            if (TYPE == 1) { const f32x4 ox = *(const LAS f32x4*)(OX + i * 32 + v0); acc = acc + acc2 * EG[64 * sb + i] + ox; } else acc = acc + acc2;
            *(v2u*)(OG + (size_t)(row0 + i) * D + colbase + v0) = (v2u){pk2(acc[0], acc[1]), pk2(acc[2], acc[3])};
        }
#pragma unroll
        for (int u2 = 0; u2 < 2; ++u2) {
            const int ti = 2 * wave + u2, vt = ti >> 3, kt = ti & 7;
            if (TYPE == 1) { const float dc = __expf(GL[sb]); sacc[u2] = sacc[u2] * dc; }
            else { const f32x4 dc = *(const LAS f32x4*)(DEC + 16 * kt + 4 * q); sacc[u2] = sacc[u2] * dc; }
            sacc[u2] = mma_tile(KeT + kt * 16 * LT, LT, ((TYPE == 1) ? VT2 : VT) + vt * 16 * LT, LT, 64, sacc[u2], lane);
        }
        __syncthreads();
#pragma unroll
        for (int u2 = 0; u2 < 2; ++u2) {
            const int ti = 2 * wave + u2, vt = ti >> 3, kt = ti & 7;
            *(LAS v2u*)(ST + (16 * vt + r) * LQ + 16 * kt + 4 * q) = (v2u){pk2(sacc[u2][0], sacc[u2][1]), pk2(sacc[u2][2], sacc[u2][3])};
        }
        rc = rn; dt1 = dt2;
    }
#pragma unroll
    for (int u2 = 0; u2 < 2; ++u2) {
        const int ti = 2 * wave + u2, vt = ti >> 3, kt = ti & 7;
        const int k0 = 16 * kt + 4 * q, v = 16 * vt + r;
        if (TYPE == 1) {
            *(f32x4*)(a.out + O_SP + ((size_t)(b * 8 + h) * 64 + s * 32 + v) * 128 + k0) = sacc[u2];
        } else {
            float* dp = a.out + (TYPE == 0 ? O_HP : O_GP) + (size_t)(b * H + h) * 128 * V + s * 32 + v;
#pragma unroll
            for (int e = 0; e < 4; ++e) dp[(size_t)(k0 + e) * V] = sacc[u2][e];
        }
    }
    __syncthreads();
}

template <int TYPE>
__device__ __forceinline__ void samp_unit(const Args& a, int z, int sx, int h, int s, LAS float* W, int lane) {
    constexpr int V = (TYPE == 0) ? 128 : (TYPE == 1) ? 64 : 256;
    constexpr int H = (TYPE == 1) ? 8 : 4;
    const int v = lane & 31, kh = lane >> 5;
    const int row0 = TP + sx * 4;
    unsigned char* ws = a.ws;
    const bf16* PJ = (const bf16*)(ws + WS_PROJ);
    const float* LF = (const float*)(ws + WS_LF); const float* DT = (const float*)(ws + WS_DT); const float* GK = (const float*)(ws + WS_GK);
    bf16* OG = (bf16*)(ws + WS_OG);
    LAS float* Wq = W; LAS float* Wk = W + 512; LAS float* Wf = W + 1024;
    float S[64];
    if (TYPE == 1) {
        const float* sp = a.in[z + 3] + ((size_t)(sx * 8 + h) * 64 + s * 32 + v) * 128 + 64 * kh;
#pragma unroll
        for (int j = 0; j < 16; ++j) { const f32x4 x = *(const f32x4*)(sp + 4 * j); S[4 * j] = x[0]; S[4 * j + 1] = x[1]; S[4 * j + 2] = x[2]; S[4 * j + 3] = x[3]; }
    } else {
        const float* sp = a.in[z + (TYPE == 0 ? 2 : 5)] + (size_t)(sx * H + h) * 128 * V + (size_t)(64 * kh) * V + s * 32 + v;
#pragma unroll
        for (int i = 0; i < 64; ++i) S[i] = sp[(size_t)i * V];
    }
    float vt[4], xsk[4] = {0.f, 0.f, 0.f, 0.f};
    if (TYPE == 0) {
#pragma unroll
        for (int t = 0; t < 4; ++t) { const size_t R = (size_t)(row0 + t);
#pragma unroll
            for (int c = 0; c < 2; ++c) { const int kk = lane + 64 * c; const float f = __expf(LF[R * 512 + h * 128 + kk]);
                Wq[t * 128 + kk] = bf2f(PJ[R * PA + h * 128 + kk]); Wk[t * 128 + kk] = 1.f - f; Wf[t * 128 + kk] = f; }
            vt[t] = bf2f(PJ[R * PA + 1024 + h * 128 + s * 32 + v]); }
    } else if (TYPE == 2) {
#pragma unroll
        for (int c = 0; c < 2; ++c) { const int kk = lane + 64 * c;
            float wg[16];
#pragma unroll
            for (int r = 0; r < 16; ++r) wg[r] = a.in[z + 25][r * 512 + h * 128 + kk];
            const float bg = a.in[z + 26][h * 128 + kk];
#pragma unroll
            for (int t = 0; t < 4; ++t) { const size_t R = (size_t)(row0 + t); float x = bg;
#pragma unroll
                for (int r = 0; r < 16; ++r) x += GK[R * 16 + r] * wg[r];
                Wf[t * 128 + kk] = __expf(-softplus_f(-x) * (1.f / 16.f));
                Wq[t * 128 + kk] = bf2f(PJ[R * PG + h * 128 + kk]); Wk[t * 128 + kk] = bf2f(PJ[R * PG + 512 + h * 128 + kk]); } }
#pragma unroll
        for (int t = 0; t < 4; ++t) vt[t] = bf2f(PJ[(size_t)(row0 + t) * PG + 1024 + h * 256 + s * 32 + v]);
    } else {
        const int g = h >> 2;
        const float* cst = a.in[z + 4] + (size_t)sx * 3 * 1024;
        const float a_h = -__expf(a.in[z + 21][h]), d_h = a.in[z + 22][h];
        float dtv[4];
#pragma unroll
        for (int t = 0; t < 4; ++t) dtv[t] = DT[(size_t)(row0 + t) * 8 + h];
#pragma unroll
        for (int c = 0; c < 2; ++c) { const int kk = lane + 64 * c;
#pragma unroll
            for (int bc = 0; bc < 2; ++bc) { const int ch = (bc ? 768 : 512) + g * 128 + kk;
                float raw[7];
#pragma unroll
                for (int j = 0; j < 7; ++j) raw[j] = (j < 3) ? cst[j * 1024 + ch] : bf2f(PJ[(size_t)(row0 + j - 3) * PA + 2560 + ch]);
                const float cb = a.in[z + 19][ch];
#pragma unroll
                for (int t = 0; t < 4; ++t) { float acc = cb;
#pragma unroll
                    for (int w = 0; w < 4; ++w) acc += raw[t + w] * a.in[z + 18][w * 1024 + ch];
                    (bc ? Wq : Wk)[t * 128 + kk] = silu_f(acc); } }
#pragma unroll
            for (int t = 0; t < 4; ++t) Wf[t * 128 + kk] = __expf(dtv[t] * a_h); }
        { const int ch = h * 64 + s * 32 + v; float raw[7];
#pragma unroll
            for (int j = 0; j < 7; ++j) raw[j] = (j < 3) ? cst[j * 1024 + ch] : bf2f(PJ[(size_t)(row0 + j - 3) * PA + 2560 + ch]);
            const float cb = a.in[z + 19][ch];
#pragma unroll
            for (int t = 0; t < 4; ++t) { float acc = cb;
#pragma unroll
                for (int w = 0; w < 4; ++w) acc += raw[t + w] * a.in[z + 18][w * 1024 + ch];
                const float x = silu_f(acc); vt[t] = x * dtv[t]; xsk[t] = d_h * x; } }
    }
    asm volatile("s_waitcnt lgkmcnt(0)" ::: "memory"); __builtin_amdgcn_wave_barrier();
    const int colbase = (TYPE == 0) ? h * 128 + s * 32 : (TYPE == 1) ? 512 + h * 64 + s * 32 : h * 256 + s * 32;
#pragma unroll
    for (int t = 0; t < 4; ++t) {
        float p = 0.f;
#pragma unroll
        for (int j = 0; j < 16; ++j) {
            const f32x4 q4 = *(const LAS f32x4*)(Wq + t * 128 + 64 * kh + 4 * j), k4 = *(const LAS f32x4*)(Wk + t * 128 + 64 * kh + 4 * j), f4 = *(const LAS f32x4*)(Wf + t * 128 + 64 * kh + 4 * j);
#pragma unroll
            for (int e = 0; e < 4; ++e) { S[4 * j + e] = f4[e] * S[4 * j + e] + k4[e] * vt[t]; p += q4[e] * S[4 * j + e]; }
        }
        p += __shfl_xor(p, 32);
        p += xsk[t];
        const float pn = __shfl_down(p, 1);
        if (lane < 32 && (lane & 1) == 0) *(unsigned*)(OG + (size_t)(row0 + t) * D + colbase + v) = pk2(p, pn);
    }
    asm volatile("s_waitcnt lgkmcnt(0)" ::: "memory"); __builtin_amdgcn_wave_barrier();
    if (TYPE == 1) {
        float* dp = a.out + O_SS + ((size_t)(sx * 8 + h) * 64 + s * 32 + v) * 128 + 64 * kh;
#pragma unroll
        for (int j = 0; j < 16; ++j) *(f32x4*)(dp + 4 * j) = (f32x4){S[4 * j], S[4 * j + 1], S[4 * j + 2], S[4 * j + 3]};
    } else {
        float* dp = a.out + (TYPE == 0 ? O_HS : O_GS) + (size_t)(sx * H + h) * 128 * V + (size_t)(64 * kh) * V + s * 32 + v;
#pragma unroll
        for (int i = 0; i < 64; ++i) dp[(size_t)i * V] = S[i];
    }
}

__device__ __forceinline__ void phase_ssd_conv(const Args& a, int z) {
    const int c = 2 * threadIdx.x;
    const bf16* PJ = (const bf16*)(a.ws + WS_PROJ); bf16* CV = (bf16*)(a.ws + WS_XB);
    float cw0[4], cw1[4];
#pragma unroll
    for (int w = 0; w < 4; ++w) { cw0[w] = a.in[z + 18][w * 1024 + c]; cw1[w] = a.in[z + 18][w * 1024 + c + 1]; }
    const float cb0 = a.in[z + 19][c], cb1 = a.in[z + 19][c + 1];
    for (int strip = blockIdx.x; strip < 256; strip += gridDim.x) {
        const int b = strip >> 5, t0 = (strip & 31) * 64;
        unsigned w3[3];
#pragma unroll
        for (int j = 0; j < 3; ++j) { const int t = t0 - 3 + j; w3[j] = (t >= 0) ? *(const unsigned*)(PJ + (size_t)(b * 2048 + t) * PA + 2560 + c) : 0u; }
        for (int tt = 0; tt < 64; tt += 8) {
            unsigned nw[8];
#pragma unroll
            for (int j = 0; j < 8; ++j) nw[j] = *(const unsigned*)(PJ + (size_t)(b * 2048 + t0 + tt + j) * PA + 2560 + c);
#pragma unroll
            for (int j = 0; j < 8; ++j) {
                const unsigned r0 = w3[0], r1 = w3[1], r2 = w3[2], r3 = nw[j];
                const float a0 = cb0 + __uint_as_float(r0 << 16) * cw0[0] + __uint_as_float(r1 << 16) * cw0[1] + __uint_as_float(r2 << 16) * cw0[2] + __uint_as_float(r3 << 16) * cw0[3];
                const float a1 = cb1 + __uint_as_float(r0 & 0xffff0000u) * cw1[0] + __uint_as_float(r1 & 0xffff0000u) * cw1[1] + __uint_as_float(r2 & 0xffff0000u) * cw1[2] + __uint_as_float(r3 & 0xffff0000u) * cw1[3];
                *(unsigned*)(CV + (size_t)(b * 2048 + t0 + tt + j) * 1024 + c) = pk2(silu_f(a0), silu_f(a1));
                w3[0] = r1; w3[1] = r2; w3[2] = r3;
            }
        }
    }
}

__device__ __forceinline__ void phase_gla_lf(const Args& a, int z) {
    const int c = threadIdx.x;
    float wg[16];
#pragma unroll
    for (int r = 0; r < 16; ++r) wg[r] = a.in[z + 25][r * 512 + c];
    const float bg = a.in[z + 26][c];
    const float* GK = (const float*)(a.ws + WS_GK); float* LF = (float*)(a.ws + WS_LF);
    for (int R = blockIdx.x; R < T; R += gridDim.x) {
        const f32x4 g0 = *(const f32x4*)(GK + (size_t)R * 16), g1 = *(const f32x4*)(GK + (size_t)R * 16 + 4), g2 = *(const f32x4*)(GK + (size_t)R * 16 + 8), g3 = *(const f32x4*)(GK + (size_t)R * 16 + 12);
        float x = bg;
#pragma unroll
        for (int j = 0; j < 4; ++j) x += g0[j] * wg[j] + g1[j] * wg[4 + j] + g2[j] * wg[8 + j] + g3[j] * wg[12 + j];
        LF[(size_t)R * 512 + c] = -softplus_f(-x) * (1.f / 16.f);
    }
}

template <int TYPE>
__device__ __forceinline__ void samp_unit_v(const Args& a, int z, int sx, int h, int s, LAS float* W, int lane) {
    constexpr int V = (TYPE == 0) ? 128 : 256;
    constexpr int PP = (TYPE == 0) ? PA : PG;
    const int v4 = lane & 7, kg = lane >> 3;
    const int row0 = TP + sx * 4;
    unsigned char* ws = a.ws;
    const bf16* PJ = (const bf16*)(ws + WS_PROJ);
    const float* LF = (const float*)(ws + WS_LF); const float* GK = (const float*)(ws + WS_GK);
    bf16* OG = (bf16*)(ws + WS_OG);
    LAS float* Wq = W; LAS float* Wk = W + 512; LAS float* Wf = W + 1024;
    f32x4 S[16];
    const float* sp = a.in[z + (TYPE == 0 ? 2 : 5)] + (size_t)(sx * 4 + h) * 128 * V + (size_t)(16 * kg) * V + s * 32 + 4 * v4;
#pragma unroll
    for (int i = 0; i < 16; ++i) S[i] = *(const f32x4*)(sp + (size_t)i * V);
    f32x4 vt[4];
    if (TYPE == 0) {
#pragma unroll
        for (int t = 0; t < 4; ++t) { const size_t R = (size_t)(row0 + t);
#pragma unroll
            for (int c = 0; c < 2; ++c) { const int kk = lane + 64 * c; const float f = __expf(LF[R * 512 + h * 128 + kk]);
                Wq[t * 128 + kk] = bf2f(PJ[R * PA + h * 128 + kk]); Wk[t * 128 + kk] = 1.f - f; Wf[t * 128 + kk] = f; } }
    } else {
#pragma unroll
        for (int c = 0; c < 2; ++c) { const int kk = lane + 64 * c;
            float wg[16];
#pragma unroll
            for (int r = 0; r < 16; ++r) wg[r] = a.in[z + 25][r * 512 + h * 128 + kk];
            const float bg = a.in[z + 26][h * 128 + kk];
#pragma unroll
            for (int t = 0; t < 4; ++t) { const size_t R = (size_t)(row0 + t); float x = bg;
#pragma unroll
                for (int r = 0; r < 16; ++r) x += GK[R * 16 + r] * wg[r];
                Wf[t * 128 + kk] = __expf(-softplus_f(-x) * (1.f / 16.f));
                Wq[t * 128 + kk] = bf2f(PJ[R * PG + h * 128 + kk]); Wk[t * 128 + kk] = bf2f(PJ[R * PG + 512 + h * 128 + kk]); } }
    }
#pragma unroll
    for (int t = 0; t < 4; ++t) { const v2u w = *(const v2u*)(PJ + (size_t)(row0 + t) * PP + 1024 + h * V + s * 32 + 4 * v4);
        vt[t] = (f32x4){__uint_as_float(w.x << 16), __uint_as_float(w.x & 0xffff0000u), __uint_as_float(w.y << 16), __uint_as_float(w.y & 0xffff0000u)}; }
    asm volatile("s_waitcnt lgkmcnt(0)" ::: "memory"); __builtin_amdgcn_wave_barrier();
    const int colbase = (TYPE == 0) ? h * 128 + s * 32 : h * 256 + s * 32;
#pragma unroll
    for (int t = 0; t < 4; ++t) {
        f32x4 p = (f32x4){0.f, 0.f, 0.f, 0.f};
#pragma unroll
        for (int j = 0; j < 4; ++j) {
            const f32x4 q4 = *(const LAS f32x4*)(Wq + t * 128 + 16 * kg + 4 * j), k4 = *(const LAS f32x4*)(Wk + t * 128 + 16 * kg + 4 * j), f4 = *(const LAS f32x4*)(Wf + t * 128 + 16 * kg + 4 * j);
#pragma unroll
            for (int e = 0; e < 4; ++e) { S[4 * j + e] = S[4 * j + e] * f4[e] + vt[t] * k4[e]; p = p + S[4 * j + e] * q4[e]; }
        }
#pragma unroll
        for (int e = 0; e < 4; ++e) { float x = p[e]; x += __shfl_xor(x, 8); x += __shfl_xor(x, 16); x += __shfl_xor(x, 32); p[e] = x; }
        if (lane < 8) *(v2u*)(OG + (size_t)(row0 + t) * D + colbase + 4 * v4) = (v2u){pk2(p[0], p[1]), pk2(p[2], p[3])};
    }
    asm volatile("s_waitcnt lgkmcnt(0)" ::: "memory"); __builtin_amdgcn_wave_barrier();
    float* dp = a.out + (TYPE == 0 ? O_HS : O_GS) + (size_t)(sx * 4 + h) * 128 * V + (size_t)(16 * kg) * V + s * 32 + 4 * v4;
#pragma unroll
    for (int i = 0; i < 16; ++i) *(f32x4*)(dp + (size_t)i * V) = S[i];
}

__device__ __forceinline__ void phase_mix_pre0(const Args& a, int z, LAS unsigned char* lds) {
    for (int u = blockIdx.x; u < 1536; u += gridDim.x) {
        if (u < 1024) pre_unit<0>(a, z, u >> 7, (u >> 5) & 3, u & 31, u, lds);
        else { const int v = u - 1024; pre_unit<1>(a, z, v >> 6, (v >> 5) & 1, v & 31, u, lds); }
    }
}
__device__ __forceinline__ void phase_mix_pre1(const Args& a, int z, LAS unsigned char* lds) {
    for (int u = blockIdx.x; u < 1024; u += gridDim.x) pre_unit<2>(a, z, u >> 7, (u >> 5) & 3, u & 31, u, lds);
}
__device__ __forceinline__ void phase_mix0(const Args& a, int z, LAS unsigned char* lds) {
    const bool flip = (((int)blockIdx.x >> 3) & 1) != 0;
    for (int st = 0; st < 2; ++st) {
        if ((st == 0) != flip) {
            for (int u = blockIdx.x; u < 128; u += gridDim.x) seq2_unit<0>(a, z, u >> 4, (u >> 2) & 3, u & 3, lds);
            for (int u = blockIdx.x; u < 256; u += gridDim.x) if (u >= 128) { const int v = u - 128; seq2_unit<1>(a, z, v >> 4, (v >> 1) & 7, v & 1, lds); }
        } else {
            __syncthreads();
            const int lane = threadIdx.x & 63, wave = __builtin_amdgcn_readfirstlane(threadIdx.x >> 6);
            LAS float* W = (LAS float*)(lds + wave * 6144);
            const int gw = blockIdx.x * NWAVES + wave, NGW = gridDim.x * NWAVES;
            for (int v = gw; v < 2048; v += NGW) samp_unit_v<0>(a, z, v >> 4, (v >> 2) & 3, v & 3, W, lane);
            for (int v = gw; v < 2048; v += NGW) samp_unit<1>(a, z, v >> 4, (v >> 1) & 7, v & 1, W, lane);
            __syncthreads();
        }
    }
}
__device__ __forceinline__ void phase_mix1(const Args& a, int z, LAS unsigned char* lds) {
    const bool flip = (((int)blockIdx.x >> 3) & 1) != 0;
    for (int st = 0; st < 2; ++st) {
        if ((st == 0) != flip) {
            for (int u = blockIdx.x; u < 256; u += gridDim.x) seq2_unit<2>(a, z, u >> 5, (u >> 3) & 3, u & 7, lds);
        } else {
            __syncthreads();
            const int lane = threadIdx.x & 63, wave = __builtin_amdgcn_readfirstlane(threadIdx.x >> 6);
            LAS float* W = (LAS float*)(lds + wave * 6144);
            const int gw = blockIdx.x * NWAVES + wave, NGW = gridDim.x * NWAVES;
            for (int v = gw; v < 4096; v += NGW) samp_unit_v<2>(a, z, v >> 5, (v >> 3) & 3, v & 7, W, lane);
            __syncthreads();
        }
    }
}

struct CapOrder {
    int c; unsigned* cnt;
    __device__ __forceinline__ bool next(int i, pg8::Unit& u) const {
        int ii = i;
        if (c >= 128 && c < 172) { if (i == 0) { const int s = c - 128; u.pm = 64 + s / 22; u.pn = s % 22; return true; } ii = i - 1; }
        const int cap = (c >= 248) ? 3 : ((c >= 128 && c < 172) ? 5 : 6);
        if (ii >= cap) return false;
        int idx;
        if (ii < 3) idx = ii * 256 + c; else if (ii < 5) idx = 768 + (ii - 3) * 248 + c; else idx = 1264 + (c < 128 ? c : c - 44);
        if (idx >= 1408) return false;
        const int xcd = idx & 7, off = idx >> 3, wgid = xcd * 176 + off;
        const int gid = wgid / 176, w2 = wgid - gid * 176;
        u.pm = gid * 8 + (w2 & 7); u.pn = w2 >> 3; return true;
    }
    __device__ __forceinline__ void a_ready(const pg8::Unit&) const {}
    __device__ __forceinline__ void done(const pg8::Unit& u) const {
        if (u.pm >= 64) { asm volatile("s_waitcnt vmcnt(0)" ::: "memory");
            if ((threadIdx.x & 63) == 0) __hip_atomic_fetch_add(cnt, 1u, __ATOMIC_RELAXED, __HIP_MEMORY_SCOPE_AGENT); }
    }
};
struct OneUnit {
    int pm, pn;
    __device__ __forceinline__ bool next(int i, pg8::Unit& u) const { if (i != 0) return false; u.pm = pm; u.pn = pn; return true; }
    __device__ __forceinline__ void a_ready(const pg8::Unit&) const {}
    __device__ __forceinline__ void done(const pg8::Unit&) const {}
};
__device__ __forceinline__ void wait_count(unsigned* cnt, unsigned need) {
    if (threadIdx.x == 0) { unsigned sp = 0; while (__hip_atomic_load(cnt, __ATOMIC_RELAXED, __HIP_MEMORY_SCOPE_AGENT) < need && ++sp < (1u << 22)) __builtin_amdgcn_s_sleep(2); }
    __builtin_amdgcn_fence(__ATOMIC_ACQUIRE, "agent"); asm volatile("s_waitcnt vmcnt(0)" ::: "memory");
    __syncthreads();
    __builtin_amdgcn_fence(__ATOMIC_ACQUIRE, "agent"); asm volatile("s_waitcnt vmcnt(0)" ::: "memory");
}

template <int LAYER>
__device__ __forceinline__ void post_row(const Args& a, int R, int lane, const float (&wn)[16]) {
    const bf16* PJ = (const bf16*)(a.ws + WS_PROJ); bf16* OG = (bf16*)(a.ws + WS_OG);
    const int c = 16 * lane;
    {
        const v4u o0 = *(const v4u*)(OG + (size_t)R * D + c), o1 = *(const v4u*)(OG + (size_t)R * D + c + 8);
        const bf16* gp = (LAYER == 0) ? PJ + (size_t)R * PA + 1536 + c : PJ + (size_t)R * PG + 2048 + c;
        const v4u g0 = *(const v4u*)gp, g1 = *(const v4u*)(gp + 8);
        float o[16], gt[16];
        const unsigned ow[8] = {o0.x, o0.y, o0.z, o0.w, o1.x, o1.y, o1.z, o1.w}, gw8[8] = {g0.x, g0.y, g0.z, g0.w, g1.x, g1.y, g1.z, g1.w};
#pragma unroll
        for (int j = 0; j < 8; ++j) { o[2 * j] = __uint_as_float(ow[j] << 16); o[2 * j + 1] = __uint_as_float(ow[j] & 0xffff0000u);
            gt[2 * j] = __uint_as_float(gw8[j] << 16); gt[2 * j + 1] = __uint_as_float(gw8[j] & 0xffff0000u); }
        const bool pre_gate = (LAYER == 0) && (lane >= 32);
        float ss = 0.f;
#pragma unroll
        for (int j = 0; j < 16; ++j) { if (pre_gate) o[j] *= gt[j]; ss += o[j] * o[j]; }
        ss += __shfl_xor(ss, 1); ss += __shfl_xor(ss, 2); ss += __shfl_xor(ss, 4);
        const float t8 = __shfl_xor(ss, 8);
        const bool wide = (LAYER == 1) || (lane >= 32);
        if (wide) ss += t8;
        const float rstd = rsqrtf(ss * (wide ? (1.f / 256.f) : (1.f / 128.f)) + EPS);
        unsigned r[8];
#pragma unroll
        for (int j = 0; j < 8; ++j) {
            float y0 = o[2 * j] * rstd * wn[2 * j], y1 = o[2 * j + 1] * rstd * wn[2 * j + 1];
            if (!pre_gate) { y0 *= gt[2 * j]; y1 *= gt[2 * j + 1]; }
            r[j] = pk2(y0, y1);
        }
        if (R >= TP) {
            unsigned long long* p8 = (unsigned long long*)(OG + (size_t)R * D + c);
#pragma unroll
            for (int j = 0; j < 4; ++j) __hip_atomic_store(p8 + j, (unsigned long long)r[2 * j] | ((unsigned long long)r[2 * j + 1] << 32), __ATOMIC_RELAXED, __HIP_MEMORY_SCOPE_AGENT);
        } else { *(v4u*)(OG + (size_t)R * D + c) = (v4u){r[0], r[1], r[2], r[3]}; *(v4u*)(OG + (size_t)R * D + c + 8) = (v4u){r[4], r[5], r[6], r[7]}; }
    }
}
template <int LAYER>
__device__ __forceinline__ void phase_post(const Args& a, int z, LAS unsigned char* lds, unsigned* cnt) {
    const int tid = threadIdx.x, lane = tid & 63, wave = tid >> 6;
    const int gw = blockIdx.x * NWAVES + wave, NGW = gridDim.x * NWAVES;
    const bf16* PJ = (const bf16*)(a.ws + WS_PROJ);
    const int c = 16 * lane;
    float wn[16];
    if (LAYER == 0) {
#pragma unroll
        for (int j = 0; j < 16; ++j) wn[j] = (lane < 32) ? a.in[z + 17][(c + j) & 127] : a.in[z + 23][c - 512 + j];
    } else {
#pragma unroll
        for (int j = 0; j < 16; ++j) wn[j] = a.in[z + 27][(c + j) & 255];
    }
    bool did = false;
    for (int R = TP + gw; R < T; R += NGW) { post_row<LAYER>(a, R, lane, wn); did = true; }
    if (did) { asm volatile("s_waitcnt vmcnt(0)" ::: "memory");
        if (lane == 0) __hip_atomic_fetch_add(cnt, 1u, __ATOMIC_RELAXED, __HIP_MEMORY_SCOPE_AGENT); }
    const int nsamp_waves = (T - TP) < NGW ? (T - TP) : NGW;
    if (blockIdx.x >= 248) {
        wait_count(cnt, (unsigned)nsamp_waves);
        pg8::Gemm g{(const bf16*)(a.ws + WS_OG), (const bf16*)(a.ws + (LAYER == 0 ? WS_WAO : WS_WGO)), T, D, D};
        OneUnit S{64 + ((int)blockIdx.x - 248) / 4, ((int)blockIdx.x - 248) % 4};
        Epi<1, 1> E{a.ws, a.out, a.out, a.out + (size_t)TP * D, a.in[16], a.in[20]};
        pg8::gemm_phase<Epi<1, 1>, OneUnit, true, true>(lds, g, S, E);
        return;
    }
    for (int R = gw; R < TP; R += 248 * NWAVES) post_row<LAYER>(a, R, lane, wn);
    if (LAYER == 0) {
        const int gt_ = blockIdx.x * 512 + tid, NT = 248 * 512;
        for (int e = gt_; e < 136 * 3072; e += NT) {
            const int sq = e / 3072, r = (e / 1024) % 3, ch = e & 1023;
            const int row = (sq < 8) ? sq * 2048 + 2045 + r : TP + (sq - 8) * 4 + 1 + r;
            const float v = bf2f(PJ[(size_t)row * PA + 2560 + ch]);
            if (sq < 8) a.out[O_CP + e] = v; else a.out[O_CS + (e - 8 * 3072)] = v;
        }
    }
}

__device__ __forceinline__ void phase_final(const Args& a, int z) {
    const int tid = threadIdx.x, lane = tid & 63, wave = tid >> 6;
    const int gw = blockIdx.x * NWAVES + wave, NGW = gridDim.x * NWAVES;
    const float* SSQ = (const float*)(a.ws + WS_SSQ);
    f32x4 wn[4];
#pragma unroll
    for (int j = 0; j < 4; ++j) wn[j] = *((const f32x4*)a.in[z + (9)] + lane + 64 * j);
    for (int R = gw; R < T; R += 2 * NGW) {
        const int R2 = R + NGW; const bool two = R2 < T;
        f32x4* xr = (f32x4*)(a.out + (size_t)R * D) + lane; f32x4* xr2 = (f32x4*)(a.out + (size_t)(two ? R2 : R) * D) + lane;
        f32x4 v[4], v2[4];
#pragma unroll
        for (int j = 0; j < 4; ++j) { v[j] = xr[64 * j]; v2[j] = xr2[64 * j]; }
        float s = (lane < 16) ? SSQ[(size_t)R * 16 + lane] : 0.f, s2 = (lane < 16) ? SSQ[(size_t)(two ? R2 : R) * 16 + lane] : 0.f;
        s = wave_sum(s); s2 = wave_sum(s2);
        const float rstd = rsqrtf(s * (1.f / 1024.f) + EPS), rstd2 = rsqrtf(s2 * (1.f / 1024.f) + EPS);
#pragma unroll
        for (int j = 0; j < 4; ++j) xr[64 * j] = v[j] * rstd * wn[j];
        if (two) {
#pragma unroll
            for (int j = 0; j < 4; ++j) xr2[64 * j] = v2[j] * rstd2 * wn[j];
        }
    }
}


#define GAS __attribute__((address_space(1)))
typedef GAS unsigned gu32;
#define RLX_AGENT __ATOMIC_RELAXED, __HIP_MEMORY_SCOPE_AGENT
#define XB_TMO      128
#define XB_XCNT(j)  (256  + 64 * (j))
#define XB_XSUB(j)  (1280 + 64 * (j))
#define XB_XGEN(j)  (2304 + 64 * (j))
#define XB_TOP      3328
#define XB_TOPGEN   3392
#define XCD_BAR_WORDS 3456
#define XB_SPIN_CAP (1u << 18)

__device__ __forceinline__ unsigned xb_ld(unsigned* p)              { return __hip_atomic_load(p, __ATOMIC_RELAXED, __HIP_MEMORY_SCOPE_AGENT); }
__device__ __forceinline__ unsigned xb_add(unsigned* p, unsigned v) { return __hip_atomic_fetch_add(p, v, __ATOMIC_RELAXED, __HIP_MEMORY_SCOPE_AGENT); }
__device__ __forceinline__ unsigned xb_xcc_id() { return (unsigned)__builtin_amdgcn_s_getreg((3 << 11) | 20) & 0xFu; }
#define XB_SPIN(cond, bar) do { unsigned _sp = 0; while (cond) { __builtin_amdgcn_s_sleep(1); \
    if ((++_sp & 255u) == 0u) { if (xb_ld(&(bar)[XB_TMO])) break; if (_sp > XB_SPIN_CAP) { atomicAdd(&(bar)[XB_TMO], 1u); break; } } } } while (0)

struct XcdBarrier {
    unsigned* bar; unsigned x;
    volatile LAS unsigned* st;
};

__device__ __forceinline__ XcdBarrier xcd_barrier_post(unsigned* bar, volatile LAS unsigned* st) {
    XcdBarrier b; b.bar = bar; b.x = xb_xcc_id(); b.st = st;
    if (threadIdx.x == 0) (void)xb_add(&bar[XB_XCNT(b.x)], 1u);
    return b;
}
__device__ __forceinline__ void xcd_barrier_complete(unsigned* bar, unsigned x, unsigned& nloc, unsigned& nx) {
    const unsigned G = gridDim.x * gridDim.y * gridDim.z;
    unsigned sum, cnt, mine, sp = 0u;
    for (;;) {
        sum = 0u; cnt = 0u; mine = 0u;
#pragma unroll
        for (unsigned j = 0; j < 16; ++j) { const unsigned c = xb_ld(&bar[XB_XCNT(j)]); sum += c; cnt += (c > 0u) ? 1u : 0u; mine = (j == x) ? c : mine; }
        if (sum == G) break;
        __builtin_amdgcn_s_sleep(1);
        if ((++sp & 255u) == 0u) { if (xb_ld(&bar[XB_TMO])) break; if (sp > XB_SPIN_CAP) { atomicAdd(&bar[XB_TMO], 1u); break; } }
    }
    nloc = mine > 0u ? mine : 1u; nx = cnt > 0u ? cnt : 1u;
}

__device__ __forceinline__ void xcd_barrier(const XcdBarrier& b) {
    asm volatile("s_waitcnt vmcnt(0)" ::: "memory");
    __syncthreads();
    if (threadIdx.x == 0) {
        unsigned* bar = b.bar;
        __builtin_amdgcn_s_waitcnt(0);
        unsigned nloc = b.st[0], nx = b.st[1];
        if (nloc == 0u) { xcd_barrier_complete(bar, b.x, nloc, nx); b.st[0] = nloc; b.st[1] = nx; }
        const unsigned old = xb_add(&bar[XB_XSUB(b.x)], 1u);
        const unsigned gen = old / nloc;
        if (old + 1u == (gen + 1u) * nloc) {
            __builtin_amdgcn_fence(__ATOMIC_RELEASE, "agent");
            asm volatile("s_waitcnt vmcnt(0)" ::: "memory");
            const unsigned og = xb_add(&bar[XB_TOP], 1u);
            const unsigned tg = og / nx;
            if (og + 1u == (tg + 1u) * nx) xb_add(&bar[XB_TOPGEN], 1u);
            else XB_SPIN(xb_ld(&bar[XB_TOPGEN]) == tg, bar);
            __builtin_amdgcn_fence(__ATOMIC_ACQUIRE, "agent");
            xb_add(&bar[XB_XGEN(b.x)], 1u);
            asm volatile("s_waitcnt vmcnt(0)" ::: "memory");
        } else {
            XB_SPIN(xb_ld(&bar[XB_XGEN(b.x)]) == gen, bar);
            __builtin_amdgcn_fence(__ATOMIC_ACQUIRE, "agent");
            asm volatile("s_waitcnt vmcnt(0)" ::: "memory");
        }
    }
    __syncthreads();
}


__global__ void __launch_bounds__(NWAVES * 64, 2) fwd_megakernel(Args args) {
    extern __shared__ __attribute__((aligned(16))) unsigned char lds_raw[];
    LAS unsigned char* lds = (LAS unsigned char*)lds_raw;
    cg::grid_group grid = cg::this_grid();
    const int lo = args.ph_lo, hi = args.ph_hi;
    if (hi < 0) grid.sync();
    unsigned char* ws = args.ws;
    const int z = 0;
    for (int u = threadIdx.x; u < 64; u += NWAVES * 64) ((LAS unsigned*)(lds + 131072))[u] = 0u;
    __syncthreads();
    XcdBarrier bar; bar.bar = (unsigned*)(ws + WS_CTL) + 4096; bar.x = 0; bar.st = nullptr;
    if (hi - lo > 1) bar = xcd_barrier_post((unsigned*)(ws + WS_CTL) + 4096, (volatile LAS unsigned*)(lds + 131072 + 32));
#define IN_PH(k) (lo <= (k) && (k) < hi)
#define SEAM(k) do { if (IN_PH(k) && IN_PH((k) + 1)) xcd_barrier(bar); } while (0)
#define GEMM_PH(k, MODE, SUB, AOFF, BOFF, NN, KK, RP, RS) do { if (IN_PH(k)) { \
        pg8::Gemm g{(const bf16*)(ws + (AOFF)), (const bf16*)(ws + (BOFF)), T, (NN), (KK)}; \
        pg8::StaticOrder S; S.init(T, (NN), (int)gridDim.x, (int)blockIdx.x); \
        Epi<MODE, SUB> E{ws, args.out, (RP), (RS), args.in[16], args.in[20]}; \
        pg8::gemm_phase<Epi<MODE, SUB>, pg8::StaticOrder, true, true>(lds, g, S, E); } SEAM(k); } while (0)
#define GEMM_PHP(k, MODE, SUB, AOFF, BOFF, NN, KK, RP, RS) do { if (IN_PH(k)) { \
        pg8::Gemm g{(const bf16*)(ws + (AOFF)), (const bf16*)(ws + (BOFF)), TP, (NN), (KK)}; \
        pg8::StaticOrder S; S.init(TP, (NN), (int)gridDim.x, (int)blockIdx.x); \
        Epi<MODE, SUB> E{ws, args.out, (RP), (RS), args.in[16], args.in[20]}; \
        pg8::gemm_phase<Epi<MODE, SUB>, pg8::StaticOrder, true, true>(lds, g, S, E); } SEAM(k); } while (0)
#define FFN_IN_PH(k, FI, RP, RS) do { if (IN_PH(k)) { \
        unsigned* cnt = (unsigned*)(ws + WS_CTL) + 16384 + 64 * (FI); \
        { pg8::Gemm g{(const bf16*)(ws + WS_XB), (const bf16*)(ws + WS_WFI + (FI) * SZ_WFI), T, NFI, D}; \
          CapOrder S{(int)blockIdx.x, cnt}; Epi<0, 0> E{ws, args.out, XR, XRS, args.in[16], args.in[20]}; \
          pg8::gemm_phase<Epi<0, 0>, CapOrder, true, true>(lds, g, S, E); } \
        if (blockIdx.x >= 248) { wait_count(cnt, 44u * 8u); \
          pg8::Gemm g2{(const bf16*)(ws + WS_ACT), (const bf16*)(ws + WS_WFO + (FI) * SZ_WFO), T, D, DFF}; \
          OneUnit S2{64 + ((int)blockIdx.x - 248) / 4, ((int)blockIdx.x - 248) % 4}; Epi<1, 0> E2{ws, args.out, (RP), (RS), args.in[16], args.in[20]}; \
          pg8::gemm_phase<Epi<1, 0>, OneUnit, true, true>(lds, g2, S2, E2); } \
        } SEAM(k); } while (0)
#define FFN_OUT_PH(k, FO, RP, RS) do { if (IN_PH(k)) { \
        pg8::Gemm g{(const bf16*)(ws + WS_ACT), (const bf16*)(ws + WS_WFO + (FO) * SZ_WFO), TP, D, DFF}; \
        pg8::StaticOrder S; S.init(TP, D, (int)gridDim.x, (int)blockIdx.x); \
        Epi<1, 0> E{ws, args.out, (RP), (RS), args.in[16], args.in[20]}; \
        pg8::gemm_phase<Epi<1, 0>, pg8::StaticOrder, true, true>(lds, g, S, E); } SEAM(k); } while (0)
    float* const XR = args.out; float* const XRS = args.out + (size_t)TP * D;
    if (IN_PH(PH_PREP)) phase_prep(args, z, lds);
    SEAM(PH_PREP);
    FFN_IN_PH(PH_L0F1I, 0, args.in[0], args.in[1]);
    FFN_OUT_PH(PH_L0F1O, 0, args.in[0], args.in[1]);
    GEMM_PH(PH_ABI, 2, 0, WS_XB, WS_WAI, NAB_PAD, D, XR, XRS);
    if (IN_PH(PH_MIX0)) { phase_mix_pre0(args, z, lds); if (hi - lo > 1) xcd_barrier(bar); phase_mix0(args, z, lds); }
    SEAM(PH_MIX0);
    if (IN_PH(PH_POST0)) phase_post<0>(args, z, lds, (unsigned*)(ws + WS_CTL) + 16384 + 64 * 8);
    SEAM(PH_POST0);
    GEMM_PHP(PH_ABO, 1, 1, WS_OG, WS_WAO, D, D, XR, XRS);
    FFN_IN_PH(PH_L0F2I, 1, XR, XRS);
    FFN_OUT_PH(PH_L0F2O, 1, XR, XRS);
    FFN_IN_PH(PH_L1F1I, 2, XR, XRS);
    FFN_OUT_PH(PH_L1F1O, 2, XR, XRS);
    GEMM_PH(PH_GLI, 2, 1, WS_XB, WS_WGI, NGL_PAD, D, XR, XRS);
    if (IN_PH(PH_MIX1)) { phase_mix_pre1(args, z, lds); if (hi - lo > 1) xcd_barrier(bar); phase_mix1(args, z, lds); }
    SEAM(PH_MIX1);
    if (IN_PH(PH_POST1)) phase_post<1>(args, z, lds, (unsigned*)(ws + WS_CTL) + 16384 + 64 * 9);
    SEAM(PH_POST1);
    GEMM_PHP(PH_GLO, 1, 1, WS_OG, WS_WGO, D, D, XR, XRS);
    FFN_IN_PH(PH_L1F2I, 3, XR, XRS);
    if (IN_PH(PH_L1F2O)) {
        pg8::Gemm g{(const bf16*)(ws + WS_ACT), (const bf16*)(ws + WS_WFO + 3 * SZ_WFO), TP, D, DFF};
        pg8::StaticOrder S; S.init(TP, D, (int)gridDim.x, (int)blockIdx.x);
        Epi<1, 2> E{ws, args.out, XR, XRS, args.in[16], args.in[20]};
        pg8::gemm_phase<Epi<1, 2>, pg8::StaticOrder, true, true>(lds, g, S, E); }
    SEAM(PH_L1F2O);
    if (IN_PH(PH_FINAL)) phase_final(args, z);
}

#ifndef ONE_LAUNCH
#define ONE_LAUNCH 1
#endif
extern "C" void kernel_launch(void* const* d_in, const int* in_sizes, int n_in, void* d_out, int out_size, void* d_ws, size_t ws_size, hipStream_t stream) {
    static int grid = 0;
    if (grid == 0) {
        if (n_in != 29 || ws_size < WS_NEED) { fprintf(stderr, "kernel_launch: n_in %d ws %zu (need %zu)\n", n_in, ws_size, (size_t)WS_END); grid = -1; return; }
        int dev = 0, cus = 0, per_cu = 0;
        hipGetDevice(&dev); hipDeviceGetAttribute(&cus, hipDeviceAttributeMultiprocessorCount, dev);
        hipFuncSetAttribute((const void*)fwd_megakernel, hipFuncAttributeMaxDynamicSharedMemorySize, LDS_BYTES);
        if (hipOccupancyMaxActiveBlocksPerMultiprocessor(&per_cu, (const void*)fwd_megakernel, NWAVES * 64, LDS_BYTES) != hipSuccess || per_cu < 1) { fprintf(stderr, "occupancy query failed/0\n"); per_cu = 1; }
        (void)hipGetLastError();
        grid = cus;
        if (grid != 256) { fprintf(stderr, "kernel_launch: built for a 256-CU device, found %d\n", cus); grid = -1; return; }
    }
    if (grid < 0) return;
    Args a{};
    for (int i = 0; i < 29; ++i) a.in[i] = (const float*)d_in[i];
    a.out = (float*)d_out; a.ws = (unsigned char*)d_ws;
    if (hipMemsetAsync((char*)d_ws + WS_CTL, 0, 131072, stream) != hipSuccess) { fprintf(stderr, "memset failed\n"); return; }
#if ONE_LAUNCH
    a.ph_lo = 0; a.ph_hi = N_PH;
    void* kargs[] = {&a};
    hipError_t e = hipLaunchCooperativeKernel((const void*)fwd_megakernel, dim3(grid), dim3(NWAVES * 64), kargs, LDS_BYTES, stream);
    if (e != hipSuccess) fprintf(stderr, "cooperative launch failed: %s\n", hipGetErrorString(e));
#else
    for (int ph = 0; ph < N_PH; ++ph) { a.ph_lo = ph; a.ph_hi = ph + 1; hipLaunchKernelGGL(fwd_megakernel, dim3(grid), dim3(NWAVES * 64), LDS_BYTES, stream, a); }
#endif
}
```

```cpp
#include <hip/hip_runtime.h>
#include <hip/hip_cooperative_groups.h>
#include <cstdio>
#include <cstdint>
namespace cg = cooperative_groups;
namespace pg8 {
#define PG8_LAS __attribute__((address_space(3)))
typedef unsigned short bf16_t;
typedef short bf16x8 __attribute__((ext_vector_type(8)));
typedef float f32x4 __attribute__((ext_vector_type(4)));
typedef unsigned u32x4 __attribute__((ext_vector_type(4)));
constexpr int BM = 256, BK = 64, HALF = 128, HTB = HALF * BK * 2  , STAGE_BYTES = 8 * HTB, NXCD = 8, WGM = 8;

__host__ __device__ __forceinline__ int lds_byte(int r, int c) { const int st = (r >> 4) * 2 + (c >> 5), rr = r & 15, cc = c & 31, ob = rr * 64 + cc * 2; return st * 1024 + (ob ^ (((ob >> 9) & 1) << 5)); }
__host__ __device__ __forceinline__ void stage_rc(int b, int& R, int& C) { const int st = b / 1024, sb = b % 1024, swz = sb ^ (((sb >> 9) & 1) << 5); R = (st >> 1) * 16 + swz / 64; C = (st & 1) * 32 + (swz % 64) / 2; }
__host__ __device__ __forceinline__ int perm32(int rho) { const int n = rho >> 4, i = rho & 15; return 8 * (i >> 2) + 4 * n + (i & 3); }

struct Unit { int pm, pn; };
struct Gemm { const bf16_t* A; const bf16_t* Bt; int M, N, K; };

struct StaticOrder {
    int nM, nN, nwg, G, c;
    __host__ __device__ void init(int M, int N, int G_, int c_) { nM = M / BM; nN = N / BM; nwg = nM * nN; G = G_; c = c_; }
    __host__ __device__ bool next(int i, Unit& u) const {
        const long L = (long)i * G + c; if (L >= nwg) return false;
        int wgid = (int)L; { const int q = nwg / NXCD, r = nwg % NXCD, xcd = wgid % NXCD, off = wgid / NXCD; wgid = (xcd < r ? xcd * (q + 1) : r * (q + 1) + (xcd - r) * q) + off; }
        const int nig = WGM * nN, gid = wgid / nig, fm = gid * WGM, gsz = (nM - fm) < WGM ? (nM - fm) : WGM;
        u.pm = fm + ((wgid % nig) % gsz); u.pn = (wgid % nig) / gsz; return true;
    }
    __device__ __forceinline__ void a_ready(const Unit&) const {}
    __device__ __forceinline__ void done(const Unit&) const {}
};

__device__ __forceinline__ unsigned cvt_pk_bf16(float lo, float hi) { unsigned r; asm volatile("v_cvt_pk_bf16_f32 %0, %1, %2" : "=v"(r) : "v"(lo), "v"(hi)); return r; }
template <class Epi, class Sched, bool ALIGN_EPI = false, bool SP2 = false>
__device__ __forceinline__ void gemm_phase(PG8_LAS unsigned char* lds, const Gemm g, const Sched& S, const Epi& E) {
    const int tid = threadIdx.x, wid = __builtin_amdgcn_readfirstlane(tid >> 6), lane = tid & 63, wr = wid >> 2, wc = wid & 3, fr = lane & 15, fq = lane >> 4;
    const int K = g.K, nt = K / BK;
    unsigned voffA[2], voffB[2];
#pragma unroll
    for (int i = 0; i < 2; ++i) { int R, C; stage_rc(tid * 16 + i * 8192, R, C); const int Rb = Epi::PERM ? ((R & ~31) + perm32(R & 31)) : R;
        voffA[i] = (unsigned)(R * K + C) * 2u; voffB[i] = (unsigned)(Rb * K + C) * 2u; }
    const size_t kstep = (size_t)(BK * 2);
    const size_t hstep = (size_t)HALF * K * 2;
    const size_t tstep = 2 * hstep;
    const unsigned ldsw = (unsigned)wid * 1024u;
    const int aoff = lds_byte(wr * 64 + fr, fq * 8), boff = lds_byte(wc * 32 + fr, fq * 8);
#define PG8_SA(b, h) (((b) * 2 + (h)) * HTB)
#define PG8_SB(b, h) ((4 + (b) * 2 + (h)) * HTB)
#define PG8_STAGE(bufoff, gbase, voff) do { _Pragma("unroll") for (int _i = 0; _i < 2; ++_i) \
        __builtin_amdgcn_global_load_lds((const unsigned*)((const char*)(gbase) + (voff)[_i]), (PG8_LAS unsigned*)(lds + (bufoff) + ldsw + _i * 8192), 16, 0, 0); } while (0)
#define PG8_LDA(dst, b, h) do { _Pragma("unroll") for (int m = 0; m < 4; ++m) _Pragma("unroll") for (int k = 0; k < 2; ++k) dst[m][k] = *(const PG8_LAS bf16x8*)(lds + PG8_SA(b, h) + aoff + m * 2048 + k * 1024); } while (0)
#define PG8_LDB(dst, b, h) do { _Pragma("unroll") for (int n = 0; n < 2; ++n) _Pragma("unroll") for (int k = 0; k < 2; ++k) dst[n][k] = *(const PG8_LAS bf16x8*)(lds + PG8_SB(b, h) + boff + n * 2048 + k * 1024); } while (0)
#define PG8_MMA(ai, bj, At, Bt) do { __builtin_amdgcn_s_setprio(1); _Pragma("unroll") for (int m = 0; m < 4; ++m) _Pragma("unroll") for (int n = 0; n < 2; ++n) _Pragma("unroll") for (int k = 0; k < 2; ++k) \
        acc[ai][bj][m][n] = __builtin_amdgcn_mfma_f32_16x16x32_bf16(Bt[n][k], At[m][k], acc[ai][bj][m][n], 0, 0, 0); __builtin_amdgcn_s_setprio(0); } while (0)
#define PG8_WAIT_V(n) asm volatile("s_waitcnt vmcnt(" #n ")" ::: "memory")
#define PG8_WAIT_L(n) asm volatile("s_waitcnt lgkmcnt(" #n ")" ::: "memory")
#define PG8_BAR __builtin_amdgcn_s_barrier()
#define PG8_SCHED __builtin_amdgcn_sched_barrier(0)
    Unit cur, nxt; int ui = 0;
    if (!S.next(0, cur)) return;
    f32x4 acc[2][2][4][2];
#pragma unroll
    for (int a = 0; a < 2; ++a)
#pragma unroll
        for (int b = 0; b < 2; ++b)
#pragma unroll
            for (int m = 0; m < 4; ++m)
#pragma unroll
                for (int n = 0; n < 2; ++n) acc[a][b][m][n] = (f32x4){0.f, 0.f, 0.f, 0.f};
    bf16x8 At[4][2], B0[2][2], B1[2][2];
    const char* cA = (const char*)g.A + (size_t)cur.pm * tstep; const char* cB = (const char*)g.Bt + (size_t)cur.pn * tstep;
    S.a_ready(cur);
    if constexpr (SP2) {
        PG8_STAGE(PG8_SB(0, 0), cB, voffB); PG8_STAGE(PG8_SB(0, 1), cB + hstep, voffB); PG8_STAGE(PG8_SA(0, 0), cA, voffA); PG8_STAGE(PG8_SA(0, 1), cA + hstep, voffA);
        if (wr == 1) PG8_BAR;
        PG8_WAIT_V(2); PG8_BAR;
        PG8_STAGE(PG8_SB(1, 0), cB + kstep, voffB); PG8_STAGE(PG8_SA(1, 0), cA + kstep, voffA); PG8_STAGE(PG8_SB(1, 1), cB + hstep + kstep, voffB);
        PG8_WAIT_V(6); PG8_BAR;
    } else {
        PG8_STAGE(PG8_SB(0, 0), cB, voffB); PG8_STAGE(PG8_SA(0, 0), cA, voffA); PG8_STAGE(PG8_SB(0, 1), cB + hstep, voffB); PG8_STAGE(PG8_SA(0, 1), cA + hstep, voffA);
        if (wr == 1) PG8_BAR;
        PG8_WAIT_V(4); PG8_BAR;
        PG8_STAGE(PG8_SB(1, 0), cB + kstep, voffB); PG8_STAGE(PG8_SA(1, 0), cA + kstep, voffA); PG8_STAGE(PG8_SB(1, 1), cB + hstep + kstep, voffB);
        PG8_WAIT_V(6); PG8_BAR;
    }
    for (;;) {
        const bool has_next = S.next(ui + 1, nxt);
        const char* nA = has_next ? (const char*)g.A + (size_t)nxt.pm * tstep : cA; const char* nB = has_next ? (const char*)g.Bt + (size_t)nxt.pn * tstep : cB;
        for (int t = 0; t < nt; t += 2) {
            const bool last = (t == nt - 2);
            const char* a1 = cA + (size_t)(t + 1) * kstep;
            const char* a2 = last ? nA : cA + (size_t)(t + 2) * kstep; const char* b2 = last ? nB : cB + (size_t)(t + 2) * kstep;
            const char* a3 = a2 + kstep; const char* b3 = b2 + kstep;
            if (last && has_next) S.a_ready(nxt);
            if constexpr (SP2) {
            PG8_LDB(B0, 0, 0); PG8_LDB(B1, 0, 1); PG8_SCHED; PG8_LDA(At, 0, 0); PG8_STAGE(PG8_SA(1, 1), a1 + hstep, voffA);
            PG8_WAIT_V(8); PG8_WAIT_L(0); PG8_BAR; PG8_MMA(0, 0, At, B0); PG8_MMA(0, 1, At, B1); PG8_BAR; PG8_SCHED;
            PG8_LDA(At, 0, 1); PG8_STAGE(PG8_SB(0, 0), b2, voffB); PG8_STAGE(PG8_SB(0, 1), b2 + hstep, voffB); PG8_STAGE(PG8_SA(0, 0), a2, voffA);
            PG8_WAIT_V(8); PG8_WAIT_L(0); PG8_BAR; PG8_MMA(1, 0, At, B0); PG8_MMA(1, 1, At, B1); PG8_BAR; PG8_SCHED;
            PG8_LDB(B0, 1, 0); PG8_LDB(B1, 1, 1); PG8_SCHED; PG8_LDA(At, 1, 0); PG8_STAGE(PG8_SA(0, 1), a2 + hstep, voffA);
            PG8_WAIT_V(8); PG8_WAIT_L(0); PG8_BAR; PG8_MMA(0, 0, At, B0); PG8_MMA(0, 1, At, B1); PG8_BAR; PG8_SCHED;
            PG8_LDA(At, 1, 1); PG8_STAGE(PG8_SB(1, 0), b3, voffB); PG8_STAGE(PG8_SB(1, 1), b3 + hstep, voffB); PG8_STAGE(PG8_SA(1, 0), a3, voffA);
            PG8_WAIT_V(8); PG8_WAIT_L(0); PG8_BAR; PG8_MMA(1, 0, At, B0); PG8_MMA(1, 1, At, B1); PG8_BAR; PG8_SCHED;
            } else {
            PG8_LDB(B0, 0, 0); PG8_SCHED; PG8_LDA(At, 0, 0); PG8_STAGE(PG8_SA(1, 1), a1 + hstep, voffA);
            PG8_WAIT_L(8); PG8_BAR; PG8_WAIT_L(0); PG8_MMA(0, 0, At, B0); PG8_BAR; PG8_SCHED;
            PG8_LDB(B1, 0, 1); PG8_STAGE(PG8_SB(0, 0), b2, voffB);
            PG8_BAR; PG8_WAIT_L(0); PG8_MMA(0, 1, At, B1); PG8_BAR;
            PG8_LDA(At, 0, 1); PG8_STAGE(PG8_SA(0, 0), a2, voffA);
            PG8_BAR; PG8_WAIT_L(0); PG8_MMA(1, 0, At, B0); PG8_BAR; PG8_SCHED;
            PG8_STAGE(PG8_SB(0, 1), b2 + hstep, voffB);
            PG8_WAIT_V(6); PG8_BAR; PG8_MMA(1, 1, At, B1); PG8_BAR;
            PG8_LDB(B0, 1, 0); PG8_SCHED; PG8_LDA(At, 1, 0); PG8_STAGE(PG8_SA(0, 1), a2 + hstep, voffA);
            PG8_WAIT_L(8); PG8_BAR; PG8_WAIT_L(0); PG8_MMA(0, 0, At, B0); PG8_BAR; PG8_SCHED;
            PG8_LDB(B1, 1, 1); PG8_STAGE(PG8_SB(1, 0), b3, voffB);
            PG8_BAR; PG8_WAIT_L(0); PG8_MMA(0, 1, At, B1); PG8_BAR;
            PG8_LDA(At, 1, 1); PG8_STAGE(PG8_SA(1, 0), a3, voffA);
            PG8_BAR; PG8_WAIT_L(0); PG8_MMA(1, 0, At, B0); PG8_BAR; PG8_SCHED;
            PG8_STAGE(PG8_SB(1, 1), b3 + hstep, voffB);
            PG8_WAIT_V(6); PG8_BAR; PG8_MMA(1, 1, At, B1); PG8_BAR;
            }
        }
        if constexpr (ALIGN_EPI) { if (wr == 0) PG8_BAR; }
        if constexpr (!Epi::AFTER_DRAIN) { E(acc, cur, wr, wc, fr, fq); S.done(cur); }
        if (!has_next) break;
#pragma unroll
        for (int a = 0; a < 2; ++a)
#pragma unroll
            for (int b = 0; b < 2; ++b)
#pragma unroll
                for (int m = 0; m < 4; ++m)
#pragma unroll
                    for (int n = 0; n < 2; ++n) acc[a][b][m][n] = (f32x4){0.f, 0.f, 0.f, 0.f};
        cur = nxt; cA = nA; cB = nB; ++ui;
        if constexpr (ALIGN_EPI) { if (wr == 1) PG8_BAR; }
    }
    PG8_WAIT_V(0);
    if constexpr (!ALIGN_EPI) { if (wr == 0) PG8_BAR; }
    PG8_BAR;
    if constexpr (Epi::AFTER_DRAIN) { E.fused(acc, cur, wr, wc, fr, fq, lds, wid, lane); S.done(cur); }
#undef PG8_SA
#undef PG8_SB
#undef PG8_STAGE
#undef PG8_LDA
#undef PG8_LDB
#undef PG8_MMA
#undef PG8_WAIT_V
#undef PG8_WAIT_L
#undef PG8_BAR
#undef PG8_SCHED
}
}

#define LAS __attribute__((address_space(3)))
typedef unsigned short bf16;
typedef unsigned v4u __attribute__((ext_vector_type(4)));
typedef unsigned v2u __attribute__((ext_vector_type(2)));
typedef float f32x4 __attribute__((ext_vector_type(4)));

constexpr int T = 16896, TP = 16384, D = 1024, DFF = 2816, NFI = 5632;
constexpr int NAB = 3592, NAB_PAD = 3840, PA = 3584;
constexpr int NGL = 3088, NGL_PAD = 3328, PG = 3072;
constexpr float EPS = 1e-6f;
constexpr int NWAVES = 8;
constexpr int LDS_BYTES = 147456;

constexpr size_t O_HP = 17301504, O_HS = 17825792, O_SP = 26214400, O_SS = 26738688, O_CP = 35127296, O_CS = 35151872, O_GP = 35545088, O_GS = 36593664;

constexpr size_t MiB = 1u << 20;
constexpr size_t SZ_WFI = (size_t)NFI * D * 2, SZ_WFO = (size_t)D * DFF * 2;
constexpr size_t WS_CTL = 0;
constexpr size_t WS_WFI = 1 * MiB;
constexpr size_t WS_WFO = WS_WFI + 4 * SZ_WFI;
constexpr size_t WS_WAI = WS_WFO + 4 * SZ_WFO;
constexpr size_t WS_WAO = WS_WAI + (size_t)NAB_PAD * D * 2;
constexpr size_t WS_WGI = WS_WAO + (size_t)D * D * 2;
constexpr size_t WS_WGO = WS_WGI + (size_t)NGL_PAD * D * 2;
constexpr size_t WS_XB  = WS_WGO + (size_t)D * D * 2;
constexpr size_t WS_SSQ = WS_XB + (size_t)T * D * 2;
constexpr size_t WS_BIG = WS_SSQ + (size_t)T * 16 * 4;
constexpr size_t WS_ACT = WS_BIG;
constexpr size_t WS_PROJ = WS_BIG;
constexpr size_t WS_LF = WS_PROJ + (size_t)T * PA * 2;
constexpr size_t WS_DT = WS_LF + (size_t)T * 512 * 4;
constexpr size_t WS_GK = WS_DT + (size_t)T * 8 * 4;
constexpr size_t WS_OG = WS_GK + (size_t)T * 16 * 4;
constexpr size_t WS_END = WS_OG + (size_t)T * D * 2;

enum { PH_PREP = 0, PH_L0F1I, PH_L0F1O, PH_ABI, PH_MIX0, PH_POST0, PH_ABO, PH_L0F2I, PH_L0F2O,
       PH_L1F1I, PH_L1F1O, PH_GLI, PH_MIX1, PH_POST1, PH_GLO, PH_L1F2I, PH_L1F2O, PH_FINAL, N_PH };

struct Args { const float* in[29]; float* out; unsigned char* ws; int ph_lo, ph_hi; };

__device__ __forceinline__ float bf2f(bf16 b) { return __uint_as_float(((unsigned)b) << 16); }
typedef float f32x2_t __attribute__((ext_vector_type(2))); typedef __bf16 bf16x2_t __attribute__((ext_vector_type(2)));
__device__ __forceinline__ unsigned pk2(float lo, float hi) { const bf16x2_t v = __builtin_convertvector((f32x2_t){lo, hi}, bf16x2_t); return __builtin_bit_cast(unsigned, v); }
__device__ __forceinline__ f32x2_t silu_mul_pk(f32x2_t g, f32x2_t u) {
    const f32x2_t t = g * (-1.4426950408889634f);
    f32x2_t e; e.x = __builtin_amdgcn_exp2f(t.x); e.y = __builtin_amdgcn_exp2f(t.y);
    const f32x2_t d = e + 1.0f;
    f32x2_t r; r.x = __builtin_amdgcn_rcpf(d.x); r.y = __builtin_amdgcn_rcpf(d.y);
    return (g * r) * u;
}
__device__ __forceinline__ unsigned pk2v(f32x2_t v) { const bf16x2_t b = __builtin_convertvector(v, bf16x2_t); return __builtin_bit_cast(unsigned, b); }
__device__ __forceinline__ float silu_f(float x) { return x * __builtin_amdgcn_rcpf(1.f + __expf(-x)); }
__device__ __forceinline__ float sigmoid_f(float x) { return __builtin_amdgcn_rcpf(1.f + __expf(-x)); }
__device__ __forceinline__ float softplus_f(float x) { return fmaxf(x, 0.f) + log1pf(__expf(-fabsf(x))); }
__device__ __forceinline__ float wave_sum(float v) {
#pragma unroll
    for (int o = 1; o < 64; o <<= 1) v += __shfl_xor(v, o);
    return v;
}
#define LDS_WAIT() asm volatile("s_waitcnt lgkmcnt(0)" ::: "memory")

enum { ACT_NONE = 0, ACT_RAW, ACT_SILU, ACT_QSCALE, ACT_FGATE, ACT_DT, ACT_GK };
constexpr unsigned long long ACTS_AB = 0x2ull | (0x2ull << 4) | (0x4ull << 8) | (0x4ull << 12) | (0x1ull << 16) | (0x1ull << 20) | (0x2ull << 24) | (0x2ull << 28) | (0x2ull << 32) | (0x2ull << 36)
               | (0x1ull << 40) | (0x1ull << 44) | (0x1ull << 48) | (0x1ull << 52) | (0x5ull << 56);
constexpr unsigned long long ACTS_GL = 0x3ull | (0x3ull << 4) | (0x1ull << 8) | (0x1ull << 12) | (0x1ull << 16) | (0x1ull << 20) | (0x1ull << 24) | (0x1ull << 28) | (0x2ull << 32) | (0x2ull << 36)
               | (0x2ull << 40) | (0x2ull << 44) | (0x6ull << 48);
template <int mode  ,
          int sub   >
struct Epi {
    static constexpr bool PERM = true, AFTER_DRAIN = false;
    unsigned char* ws; float* out;
    const float* res_p; const float* res_s;
    const float* lbl; const float* dtb;
    mutable int cpm = -1; mutable float crs[2][4] = {{0.f, 0.f, 0.f, 0.f}, {0.f, 0.f, 0.f, 0.f}};
    __device__ __forceinline__ void operator()(const pg8::f32x4 (&acc)[2][2][4][2], const pg8::Unit& u, int wr, int wc, int fr, int fq) const {
        const int rbase = u.pm * 256 + wr * 64 + fr;
        const int cl = wc * 32 + 8 * fq;
        const float* ssq_in = (const float*)(ws + WS_SSQ);
        bf16* obf = (bf16*)(ws + WS_BIG);
        if (mode == 1) {
            float* xr = out; bf16* xb = (bf16*)(ws + WS_XB); float* ssq_out = (float*)(ws + WS_SSQ);
            const float scale = (sub == 1) ? 1.f : 0.5f;
            const int c00 = u.pn * 256 + cl;
            f32x4 rb[2][4];
            {
                const int row = rbase;
                const float* rp = (row < TP) ? res_p + (size_t)row * D : res_s + (size_t)(row - TP) * D;
                rb[0][0] = *(const f32x4*)(rp + c00); rb[0][1] = *(const f32x4*)(rp + c00 + 4); rb[0][2] = *(const f32x4*)(rp + c00 + 128); rb[0][3] = *(const f32x4*)(rp + c00 + 132);
            }
#pragma unroll
            for (int gi = 0; gi < 8; ++gi) {
                const int ai = gi >> 2, m = gi & 3;
                const int row = rbase + ai * 128 + m * 16;
                if (gi + 1 < 8) {
                    const int rown = rbase + ((gi + 1) >> 2) * 128 + ((gi + 1) & 3) * 16;
                    const float* rp = (rown < TP) ? res_p + (size_t)rown * D : res_s + (size_t)(rown - TP) * D;
                    rb[(gi + 1) & 1][0] = *(const f32x4*)(rp + c00); rb[(gi + 1) & 1][1] = *(const f32x4*)(rp + c00 + 4);
                    rb[(gi + 1) & 1][2] = *(const f32x4*)(rp + c00 + 128); rb[(gi + 1) & 1][3] = *(const f32x4*)(rp + c00 + 132);
                }
                float ss = 0.f;
#pragma unroll
                for (int bj = 0; bj < 2; ++bj) {
                    const int c0 = c00 + bj * 128;
                    const f32x4 x0 = rb[gi & 1][2 * bj] + acc[ai][bj][m][0] * scale, x1 = rb[gi & 1][2 * bj + 1] + acc[ai][bj][m][1] * scale;
                    *(f32x4*)(xr + (size_t)row * D + c0) = x0; *(f32x4*)(xr + (size_t)row * D + c0 + 4) = x1;
                    if (sub != 2) {
                        v4u w; w.x = pk2(x0[0], x0[1]); w.y = pk2(x0[2], x0[3]); w.z = pk2(x1[0], x1[1]); w.w = pk2(x1[2], x1[3]);
                        *(v4u*)(xb + (size_t)row * D + c0) = w; }
                    ss += (x0[0] * x0[0] + x0[1] * x0[1]) + (x0[2] * x0[2] + x0[3] * x0[3]) + (x1[0] * x1[0] + x1[1] * x1[1]) + (x1[2] * x1[2] + x1[3] * x1[3]);
                }
                ss += __shfl_xor(ss, 16); ss += __shfl_xor(ss, 32);
                if (fq == 0) ssq_out[(size_t)row * 16 + u.pn * 4 + wc] = ss;
                asm volatile("" ::: "memory");
            }
            return;
        }
        if (u.pm != cpm) {
            cpm = u.pm;
#pragma unroll
            for (int ai = 0; ai < 2; ++ai)
#pragma unroll
                for (int m = 0; m < 4; ++m) {
                    const int row = rbase + ai * 128 + m * 16;
                    const f32x4 p = *(const f32x4*)(ssq_in + (size_t)row * 16 + 4 * fq);
                    float s = (p[0] + p[1]) + (p[2] + p[3]); s += __shfl_xor(s, 16); s += __shfl_xor(s, 32);
                    crs[ai][m] = rsqrtf(s * (1.f / 1024.f) + EPS);
                }
        }
        float rstd[2][4];
#pragma unroll
        for (int ai = 0; ai < 2; ++ai)
#pragma unroll
            for (int m = 0; m < 4; ++m) rstd[ai][m] = crs[ai][m];
        if (mode == 0) {
            const int hc = u.pn * 128 + cl;
#pragma unroll
            for (int ai = 0; ai < 2; ++ai)
#pragma unroll
                for (int m = 0; m < 4; ++m) {
                    const int row = rbase + ai * 128 + m * 16; const float rs = rstd[ai][m];
                    const f32x4 g0 = acc[ai][0][m][0] * rs, g1 = acc[ai][0][m][1] * rs, u0 = acc[ai][1][m][0] * rs, u1 = acc[ai][1][m][1] * rs;
                    v4u w;
                    w.x = pk2v(silu_mul_pk((f32x2_t){g0[0], g0[1]}, (f32x2_t){u0[0], u0[1]})); w.y = pk2v(silu_mul_pk((f32x2_t){g0[2], g0[3]}, (f32x2_t){u0[2], u0[3]}));
                    w.z = pk2v(silu_mul_pk((f32x2_t){g1[0], g1[1]}, (f32x2_t){u1[0], u1[1]})); w.w = pk2v(silu_mul_pk((f32x2_t){g1[2], g1[3]}, (f32x2_t){u1[2], u1[3]}));
                    if (u.pm >= 64) {
                        unsigned long long* p8 = (unsigned long long*)(obf + (size_t)row * DFF + hc);
                        __hip_atomic_store(p8, (unsigned long long)w.x | ((unsigned long long)w.y << 32), __ATOMIC_RELAXED, __HIP_MEMORY_SCOPE_AGENT);
                        __hip_atomic_store(p8 + 1, (unsigned long long)w.z | ((unsigned long long)w.w << 32), __ATOMIC_RELAXED, __HIP_MEMORY_SCOPE_AGENT);
                    } else *(v4u*)(obf + (size_t)row * DFF + hc) = w;
                    asm volatile("" ::: "memory");
                }
            return;
        }
        const unsigned long long acts = sub ? ACTS_GL : ACTS_AB;
        const int ldo = sub ? PG : PA;
        const int code = (int)((acts >> (4 * u.pn)) & 15ull);
        if (code == ACT_NONE) return;
        if (code == ACT_DT) {
            if (cl == 0) {
                float* aux = (float*)(ws + WS_DT);
#pragma unroll
                for (int ai = 0; ai < 2; ++ai)
#pragma unroll
                    for (int m = 0; m < 4; ++m) {
                        const int row = rbase + ai * 128 + m * 16; const float rs = rstd[ai][m];
                        const f32x4 a0 = acc[ai][0][m][0] * rs, a1 = acc[ai][0][m][1] * rs; f32x4 d0, d1;
#pragma unroll
                        for (int j = 0; j < 4; ++j) { d0[j] = softplus_f(a0[j] + dtb[j]); d1[j] = softplus_f(a1[j] + dtb[4 + j]); }
                        *(f32x4*)(aux + (size_t)row * 8) = d0; *(f32x4*)(aux + (size_t)row * 8 + 4) = d1;
                    }
            }
            return;
        }
        if (code == ACT_GK) {
            if (cl < 16) {
                float* aux = (float*)(ws + WS_GK);
#pragma unroll
                for (int ai = 0; ai < 2; ++ai)
#pragma unroll
                    for (int m = 0; m < 4; ++m) {
                        const int row = rbase + ai * 128 + m * 16; const float rs = rstd[ai][m];
                        *(f32x4*)(aux + (size_t)row * 16 + cl) = acc[ai][0][m][0] * rs; *(f32x4*)(aux + (size_t)row * 16 + cl + 4) = acc[ai][0][m][1] * rs;
                    }
            }
            return;
        }
#pragma unroll
        for (int bj = 0; bj < 2; ++bj) {
            const int c0 = u.pn * 256 + bj * 128 + cl;
            float lbv[8];
            if (code == ACT_FGATE) {
#pragma unroll
                for (int j = 0; j < 8; ++j) { const float l0 = lbl[c0 - 512 + j], l1 = lbl[c0 + j]; lbv[j] = __builtin_amdgcn_rcpf(1.f + __expf(l1 - l0)); }
            }
#pragma unroll
            for (int ai = 0; ai < 2; ++ai)
#pragma unroll
                for (int m = 0; m < 4; ++m) {
                    const int row = rbase + ai * 128 + m * 16; const float rs = rstd[ai][m];
                    const f32x4 a0 = acc[ai][bj][m][0] * rs, a1 = acc[ai][bj][m][1] * rs;
                    float v[8] = {a0[0], a0[1], a0[2], a0[3], a1[0], a1[1], a1[2], a1[3]};
                    if (code == ACT_SILU) {
#pragma unroll
                        for (int j = 0; j < 8; ++j) v[j] = silu_f(v[j]);
                    } else if (code == ACT_QSCALE) {
#pragma unroll
                        for (int j = 0; j < 8; ++j) v[j] *= 0.08838834764831845f;
                    } else if (code == ACT_FGATE) {
                        float* lf = (float*)(ws + WS_LF);
                        f32x4 l0, l1;
#pragma unroll
                        for (int j = 0; j < 8; ++j) {
                            const float f = lbv[j] + (1.f - lbv[j]) * sigmoid_f(v[j]);
                            const float lg = __logf(f);
                            if (j < 4) l0[j] = lg; else l1[j - 4] = lg;
                            v[j] = 1.f - f;
                        }
                        *(f32x4*)(lf + (size_t)row * 512 + (c0 - 512)) = l0; *(f32x4*)(lf + (size_t)row * 512 + (c0 - 512) + 4) = l1;
                    }
                    if (code != ACT_FGATE) {
                        v4u w; w.x = pk2(v[0], v[1]); w.y = pk2(v[2], v[3]); w.z = pk2(v[4], v[5]); w.w = pk2(v[6], v[7]);
                        *(v4u*)(obf + (size_t)row * ldo + c0) = w; }
                    asm volatile("" ::: "memory");
                }
        }
    }
};

__device__ __forceinline__ void transpose_item(const float* __restrict__ W, int K, int N, bf16* __restrict__ WT, const float* __restrict__ scale, int mapmode,
                                               int item, int nblk, LAS float* scr, int lane) {
    const int kb = item / nblk, nb = item - kb * nblk, k0 = 64 * kb, n0 = 32 * nb;
    const int kr = lane >> 3, c4 = lane & 7;
    const bool ok = (n0 + 4 * c4) < N;
    f32x4 v[8];
#pragma unroll
    for (int i = 0; i < 8; ++i) v[i] = ok ? __builtin_nontemporal_load((const f32x4*)(W + (size_t)(k0 + kr + 8 * i) * N + n0 + 4 * c4)) : (f32x4){0.f, 0.f, 0.f, 0.f};
    if (scale) {
#pragma unroll
        for (int i = 0; i < 8; ++i) v[i] = v[i] * scale[k0 + kr + 8 * i];
    }
#pragma unroll
    for (int i = 0; i < 8; ++i) { LAS float* sp = scr + (kr + 8 * i) * 33 + 4 * c4; sp[0] = v[i][0]; sp[1] = v[i][1]; sp[2] = v[i][2]; sp[3] = v[i][3]; }
    LDS_WAIT(); asm volatile("" ::: "memory");
    int drow0 = n0;
    if (mapmode == 1) drow0 = (n0 < DFF) ? (n0 >> 7) * 256 + (n0 & 127) : ((n0 - DFF) >> 7) * 256 + 128 + ((n0 - DFF) & 127);
    const int c = lane & 7;
#pragma unroll
    for (int j = 0; j < 4; ++j) {
        const int nn = (lane >> 3) + 8 * j; const LAS float* s = scr + (8 * c) * 33 + nn;
        v4u o; o.x = pk2(s[0 * 33], s[1 * 33]); o.y = pk2(s[2 * 33], s[3 * 33]); o.z = pk2(s[4 * 33], s[5 * 33]); o.w = pk2(s[6 * 33], s[7 * 33]);
        __builtin_nontemporal_store(o, (v4u*)(WT + (size_t)(drow0 + nn) * K + k0 + 8 * c));
    }
    LDS_WAIT(); asm volatile("" ::: "memory");
}

__device__ __forceinline__ void phase_prep(const Args& a, int z, LAS unsigned char* lds) {
    const int tid = threadIdx.x, lane = tid & 63, wave = tid >> 6;
    LAS float* scr = (LAS float*)(lds + wave * 16384);
    const int gw = blockIdx.x * NWAVES + wave, NGW = gridDim.x * NWAVES;
    unsigned char* ws = a.ws;
    constexpr int I_FI = 16 * 176, I_FO = 44 * 32, I_AI = 16 * 120, I_AO = 16 * 32, I_GI = 16 * 104, I_GO = 16 * 32;
    constexpr int NITEMS = 4 * I_FI + 4 * I_FO + I_AI + I_AO + I_GI + I_GO;
    for (int it = gw; it < NITEMS; it += NGW) {
        int r = it;
        if (r < 4 * I_FI) { const int i = r / I_FI, l = i >> 1, w2 = i & 1; r -= i * I_FI;
            transpose_item(a.in[z + (w2 ? 12 : 10)] + (size_t)l * D * NFI, D, NFI, (bf16*)(ws + WS_WFI + i * SZ_WFI), a.in[z + (w2 ? 8 : 6)] + l * D, 1, r, 176, scr, lane); continue; }
        r -= 4 * I_FI;
        if (r < 4 * I_FO) { const int i = r / I_FO, l = i >> 1, w2 = i & 1; r -= i * I_FO;
            transpose_item(a.in[z + (w2 ? 13 : 11)] + (size_t)l * DFF * D, DFF, D, (bf16*)(ws + WS_WFO + i * SZ_WFO), nullptr, 0, r, 32, scr, lane); continue; }
        r -= 4 * I_FO;
        if (r < I_AI) { transpose_item(a.in[z + (14)], D, NAB, (bf16*)(ws + WS_WAI), a.in[z + (7)], 0, r, 120, scr, lane); continue; }
        r -= I_AI;
        if (r < I_AO) { transpose_item(a.in[z + (15)], D, D, (bf16*)(ws + WS_WAO), nullptr, 0, r, 32, scr, lane); continue; }
        r -= I_AO;
        if (r < I_GI) { transpose_item(a.in[z + (24)], D, NGL, (bf16*)(ws + WS_WGI), a.in[z + (7)] + D, 0, r, 104, scr, lane); continue; }
        r -= I_GI;
        transpose_item(a.in[z + (28)], D, D, (bf16*)(ws + WS_WGO), nullptr, 0, r, 32, scr, lane);
    }
    bf16* XB = (bf16*)(ws + WS_XB); float* SSQ = (float*)(ws + WS_SSQ);
    for (int m = gw; m < T; m += NGW) {
        const float* src = (m < TP) ? a.in[z + (0)] + (size_t)m * D : a.in[z + (1)] + (size_t)(m - TP) * D;
        const f32x4* xr = (const f32x4*)src + lane;
        unsigned long long* o8 = (unsigned long long*)(XB + (size_t)m * D) + lane;
        float s = 0.f;
#pragma unroll
        for (int j = 0; j < 4; ++j) { const f32x4 v = xr[64 * j]; s += (v[0] * v[0] + v[1] * v[1]) + (v[2] * v[2] + v[3] * v[3]);
            o8[64 * j] = (unsigned long long)pk2(v[0], v[1]) | ((unsigned long long)pk2(v[2], v[3]) << 32); }
        s = wave_sum(s);
        if (lane < 16) SSQ[(size_t)m * 16 + lane] = (lane == 0) ? s : 0.f;
    }
}

constexpr int CK_QD = 0, CK_QS = 17408, CK_KI = 34816, CK_KET = 52224, CK_VT = 70656, CK_P = 75264, CK_ST = 84480, CK_SEG = 93184, CK_DEC = 95232,
              CK_OX = 95744, CK_DTS = 103936, CK_DTV = 104192, CK_GS = 104448;
constexpr int LQ = 136, LT = 72;
typedef short bf16x8_t __attribute__((ext_vector_type(8)));

__device__ __forceinline__ f32x4 mma_tile(const LAS bf16* F, int ldf, const LAS bf16* Sx, int lds_, int kc, f32x4 acc, int lane) {
    const int r = lane & 15, q = lane >> 4;
    const LAS bf16* fp = F + r * ldf + 8 * q; const LAS bf16* sp = Sx + r * lds_ + 8 * q;
    for (int k = 0; k < kc; k += 32) {
        const bf16x8_t fa = *(const LAS bf16x8_t*)(fp + k), sb = *(const LAS bf16x8_t*)(sp + k);
        acc = __builtin_amdgcn_mfma_f32_16x16x32_bf16(fa, sb, acc, 0, 0, 0);
    }
    return acc;
}

template <int TYPE>
__device__ __forceinline__ void chunk_unit(const Args& a, int z, int b, int h, int s, LAS unsigned char* lds) {
    constexpr int V = (TYPE == 0) ? 128 : (TYPE == 1) ? 64 : 256;
    constexpr int H = (TYPE == 1) ? 8 : 4;
    const int tid = threadIdx.x, lane = tid & 63, wave = tid >> 6, r = lane & 15, q = lane >> 4;
    LAS bf16* Qd = (LAS bf16*)(lds + CK_QD); LAS bf16* Qs = (TYPE == 1) ? (LAS bf16*)(lds + CK_QS) : Qd; LAS bf16* Ki = (LAS bf16*)(lds + CK_KI);
    LAS bf16* KeT = (LAS bf16*)(lds + CK_KET); LAS bf16* VT = (LAS bf16*)(lds + CK_VT); LAS bf16* P = (LAS bf16*)(lds + CK_P); LAS bf16* ST = (LAS bf16*)(lds + CK_ST);
    LAS float* SEG = (LAS float*)(lds + CK_SEG); LAS float* DEC = (LAS float*)(lds + CK_DEC); LAS float* OX = (LAS float*)(lds + CK_OX);
    LAS float* DTS = (LAS float*)(lds + CK_DTS); LAS float* DTV = (LAS float*)(lds + CK_DTV); LAS float* GS = (LAS float*)(lds + CK_GS);
    unsigned char* ws = a.ws;
    const bf16* PJ = (const bf16*)(ws + WS_PROJ);
    const float* LF = (const float*)(ws + WS_LF); const float* DT = (const float*)(ws + WS_DT); const float* GK = (const float*)(ws + WS_GK);
    bf16* OG = (bf16*)(ws + WS_OG);
    const int kl = tid & 127, seg = tid >> 7;
    const int vl = tid & 31, tq = tid >> 5;
    const int g = h >> 2;
    float a_h = 0.f, d_h = 0.f;
    if (TYPE == 1) { a_h = -__expf(a.in[z + 21][h]); d_h = a.in[z + 22][h]; }
    f32x4 sacc[2] = {(f32x4){0.f, 0.f, 0.f, 0.f}, (f32x4){0.f, 0.f, 0.f, 0.f}};
    __syncthreads();
    for (int e = tid; e < 32 * LQ / 2; e += 512) ((LAS unsigned*)ST)[e] = 0u;
    const int colbase = (TYPE == 0) ? h * 128 + s * 32 : (TYPE == 1) ? 512 + h * 64 + s * 32 : h * 256 + s * 32;
    const int tb = 16 * seg;
    constexpr int PP = (TYPE == 2) ? PG : PA;
    struct Raw { float lf[16]; unsigned q[16], k[16], v[4]; float dt; };
    const bf16* CV = (const bf16*)(ws + WS_XB);
    auto load_raw = [&](Raw& w, int n_) {
        const int row0_ = b * 2048 + n_ * 64;
#pragma unroll
        for (int i = 0; i < 16; ++i) { const size_t R = (size_t)(row0_ + tb + i);
            if (TYPE != 1) { w.lf[i] = LF[R * 512 + h * 128 + kl]; w.q[i] = PJ[R * PP + h * 128 + kl]; if (TYPE == 2) w.k[i] = PJ[R * PP + 512 + h * 128 + kl]; }
            else { w.q[i] = CV[R * 1024 + 768 + g * 128 + kl]; w.k[i] = CV[R * 1024 + 512 + g * 128 + kl]; } }
#pragma unroll
        for (int i = 0; i < 4; ++i) { const size_t R = (size_t)(row0_ + 4 * tq + i);
            w.v[i] = (TYPE == 1) ? CV[R * 1024 + h * 64 + s * 32 + vl] : PJ[R * PP + 1024 + h * V + s * 32 + vl]; }
        if (TYPE == 1) w.dt = (tid < 64) ? DT[(size_t)(row0_ + tid) * 8 + h] : 0.f;
    };
    Raw rc, rn;
    load_raw(rc, 0);
    for (int n = 0; n < 32; ++n) {
        const int row0 = b * 2048 + n * 64;
        if (n + 1 < 32) load_raw(rn, n + 1);
        float glast, goff;
        if (TYPE != 1) {
            float run = 0.f;
#pragma unroll
            for (int i = 0; i < 16; ++i) run += rc.lf[i];
            SEG[seg * 128 + kl] = run;
            __syncthreads();
            const float s0 = SEG[kl], s1 = SEG[128 + kl], s2 = SEG[256 + kl], s3 = SEG[384 + kl];
            goff = (seg > 0 ? s0 : 0.f) + (seg > 1 ? s1 : 0.f) + (seg > 2 ? s2 : 0.f);
            glast = (s0 + s1) + (s2 + s3);
        } else {
            if (tid < 64) { DTS[tid] = rc.dt * a_h; DTV[tid] = rc.dt; }
            __syncthreads();
            float off = 0.f, tot = 0.f;
            for (int t = 0; t < 64; t += 4) { const f32x4 d4 = *(const LAS f32x4*)(DTS + t); const float d = (d4[0] + d4[1]) + (d4[2] + d4[3]); tot += d; if (t < tb) off += d; }
            glast = tot; goff = off;
        }
        {
            const float eglast = __expf(glast);
            unsigned kew[8];
            float grun = goff;
#pragma unroll
            for (int i = 0; i < 16; i += 2) {
                float q0, q1, k0, k1, g0, g1;
                q0 = __uint_as_float(rc.q[i] << 16); q1 = __uint_as_float(rc.q[i + 1] << 16);
                if (TYPE == 0) { k0 = 1.f - __expf(rc.lf[i]); k1 = 1.f - __expf(rc.lf[i + 1]); }
                else { k0 = __uint_as_float(rc.k[i] << 16); k1 = __uint_as_float(rc.k[i + 1] << 16); }
                if (TYPE != 1) { grun += rc.lf[i]; g0 = grun; grun += rc.lf[i + 1]; g1 = grun; }
                else { grun += DTS[tb + i]; g0 = grun; grun += DTS[tb + i + 1]; g1 = grun; if (kl == 0) { GS[tb + i] = g0; GS[tb + i + 1] = g1; } }
                const float e0 = __expf(g0), e1 = __expf(g1);
                const int t = tb + i;
                if (TYPE == 1) {
                    const unsigned cq = pk2(q0, q1), ck = pk2(k0, k1);
                    Qs[t * LQ + kl] = (bf16)(cq & 0xffffu); Qs[(t + 1) * LQ + kl] = (bf16)(cq >> 16);
                    Ki[t * LQ + kl] = (bf16)(ck & 0xffffu); Ki[(t + 1) * LQ + kl] = (bf16)(ck >> 16);
                    kew[i >> 1] = pk2(k0 * __expf(glast - g0), k1 * __expf(glast - g1));
                } else {
                    const float i0 = __builtin_amdgcn_rcpf(e0), i1 = __builtin_amdgcn_rcpf(e1);
                    const unsigned kk = pk2(k0 * i0, k1 * i1);
                    Ki[t * LQ + kl] = (bf16)(kk & 0xffffu); Ki[(t + 1) * LQ + kl] = (bf16)(kk >> 16);
                    kew[i >> 1] = pk2(k0 * (eglast * i0), k1 * (eglast * i1));
                }
                const unsigned qq = pk2(q0 * e0, q1 * e1);
                Qd[t * LQ + kl] = (bf16)(qq & 0xffffu); Qd[(t + 1) * LQ + kl] = (bf16)(qq >> 16);
            }
            *(LAS v4u*)(KeT + kl * LT + tb) = (v4u){kew[0], kew[1], kew[2], kew[3]};
            *(LAS v4u*)(KeT + kl * LT + tb + 8) = (v4u){kew[4], kew[5], kew[6], kew[7]};
            if (seg == 0) DEC[kl] = eglast;
        }
        {
            if (TYPE != 1) {
                *(LAS v2u*)(VT + vl * LT + 4 * tq) = (v2u){rc.v[0] | (rc.v[1] << 16), rc.v[2] | (rc.v[3] << 16)};
            } else {
                float vv4[4];
#pragma unroll
                for (int i = 0; i < 4; ++i) { const float x = __uint_as_float(rc.v[i] << 16); OX[(4 * tq + i) * 32 + vl] = d_h * x; vv4[i] = x * DTV[4 * tq + i]; }
                *(LAS v2u*)(VT + vl * LT + 4 * tq) = (v2u){pk2(vv4[0], vv4[1]), pk2(vv4[2], vv4[3])};
            }
        }
        __syncthreads();
#pragma unroll
        for (int u2 = 0; u2 < 2; ++u2) {
            const int t = 2 * wave + u2, ti = t >> 2, tj = t & 3;
            v2u w = (v2u){0u, 0u};
            if (tj <= ti) {
                f32x4 acc = (f32x4){0.f, 0.f, 0.f, 0.f};
                acc = mma_tile(Ki + tj * 16 * LQ, LQ, Qs + ti * 16 * LQ, LQ, 128, acc, lane);
                const int i = 16 * ti + r, j0 = 16 * tj + 4 * q;
                float pv[4];
#pragma unroll
                for (int e = 0; e < 4; ++e) { float x = acc[e];
                    if (TYPE == 1) x *= __expf(fminf(GS[i] - GS[j0 + e], 0.f));
                    pv[e] = (j0 + e <= i) ? x : 0.f; }
                w = (v2u){pk2(pv[0], pv[1]), pk2(pv[2], pv[3])};
            }
            *(LAS v2u*)(P + (16 * ti + r) * LT + 16 * tj + 4 * q) = w;
        }
        __syncthreads();
        {
            const int ti = wave >> 1, tv = wave & 1;
            f32x4 acc = (f32x4){0.f, 0.f, 0.f, 0.f};
            acc = mma_tile(VT + tv * 16 * LT, LT, P + ti * 16 * LT, LT, (ti < 2) ? 32 : 64, acc, lane);
            acc = mma_tile(ST + tv * 16 * LQ, LQ, Qd + ti * 16 * LQ, LQ, 128, acc, lane);
            const int i = 16 * ti + r, v0 = 16 * tv + 4 * q;
            if (TYPE == 1) { const f32x4 ox = *(const LAS f32x4*)(OX + i * 32 + v0); acc = acc + ox; }
            *(v2u*)(OG + (size_t)(row0 + i) * D + colbase + v0) = (v2u){pk2(acc[0], acc[1]), pk2(acc[2], acc[3])};
        }
#pragma unroll
        for (int u2 = 0; u2 < 2; ++u2) {
            const int ti = 2 * wave + u2, vt = ti >> 3, kt = ti & 7;
            const f32x4 dc = *(const LAS f32x4*)(DEC + 16 * kt + 4 * q);
            sacc[u2] = sacc[u2] * dc;
            sacc[u2] = mma_tile(KeT + kt * 16 * LT, LT, VT + vt * 16 * LT, LT, 64, sacc[u2], lane);
        }
        __syncthreads();
#pragma unroll
        for (int u2 = 0; u2 < 2; ++u2) {
            const int ti = 2 * wave + u2, vt = ti >> 3, kt = ti & 7;
            *(LAS v2u*)(ST + (16 * vt + r) * LQ + 16 * kt + 4 * q) = (v2u){pk2(sacc[u2][0], sacc[u2][1]), pk2(sacc[u2][2], sacc[u2][3])};
        }
        rc = rn;
    }
#pragma unroll
    for (int u2 = 0; u2 < 2; ++u2) {
        const int ti = 2 * wave + u2, vt = ti >> 3, kt = ti & 7;
        const int k0 = 16 * kt + 4 * q, v = 16 * vt + r;
        if (TYPE == 1) {
            *(f32x4*)(a.out + O_SP + ((size_t)(b * 8 + h) * 64 + s * 32 + v) * 128 + k0) = sacc[u2];
        } else {
            float* dp = a.out + (TYPE == 0 ? O_HP : O_GP) + (size_t)(b * H + h) * 128 * V + s * 32 + v;
#pragma unroll
            for (int e = 0; e < 4; ++e) dp[(size_t)(k0 + e) * V] = sacc[u2][e];
        }
    }
    __syncthreads();
}

constexpr int RECA = 36352, RECP = 9216;
constexpr size_t WS_PREA = WS_END;
constexpr size_t WS_PREP_V = WS_WFI, WS_PREP_S = WS_WFO;
constexpr size_t WS_NEED = WS_PREA + (size_t)1536 * RECA;

template <int TYPE>
__device__ __forceinline__ void pre_unit(const Args& a, int z, int b, int h, int n, int rec, LAS unsigned char* lds) {
    const int tid = threadIdx.x, lane = tid & 63, wave = __builtin_amdgcn_readfirstlane(tid >> 6), r = lane & 15, q = lane >> 4;
    LAS bf16* Qd = (LAS bf16*)(lds + CK_QD); LAS bf16* Qs = (LAS bf16*)(lds + CK_QS); LAS bf16* Ki = (LAS bf16*)(lds + CK_KI);
    LAS bf16* KeT = (LAS bf16*)(lds + CK_KET); LAS bf16* P = (LAS bf16*)(lds + CK_P);
    LAS float* SEG = (LAS float*)(lds + CK_SEG); LAS float* DEC = (LAS float*)(lds + CK_DEC);
    unsigned char* ws = a.ws;
    const bf16* PJ = (const bf16*)(ws + WS_PROJ); const float* LF = (const float*)(ws + WS_LF); const bf16* CV = (const bf16*)(ws + WS_XB);
    const int kl = tid & 127, seg = tid >> 7, tb = 16 * seg;
    constexpr int PP = (TYPE == 2) ? PG : PA;
    const int row0 = b * 2048 + n * 64;
    float lf[16]; unsigned rq[16], rk[16];
#pragma unroll
    for (int i = 0; i < 16; ++i) { const size_t R = (size_t)(row0 + tb + i);
        if (TYPE == 0) { lf[i] = LF[R * 512 + h * 128 + kl]; rq[i] = PJ[R * PP + h * 128 + kl]; }
        else if (TYPE == 2) { rq[i] = PJ[R * PP + h * 128 + kl]; rk[i] = PJ[R * PP + 512 + h * 128 + kl]; } }
    if (TYPE == 2) {
        const float* GK = (const float*)(ws + WS_GK);
        float wg[16];
#pragma unroll
        for (int r2 = 0; r2 < 16; ++r2) wg[r2] = a.in[z + 25][r2 * 512 + h * 128 + kl];
        const float bg = a.in[z + 26][h * 128 + kl];
#pragma unroll
        for (int i = 0; i < 16; ++i) { const size_t R = (size_t)(row0 + tb + i);
            const f32x4 g0 = *(const f32x4*)(GK + R * 16), g1 = *(const f32x4*)(GK + R * 16 + 4), g2 = *(const f32x4*)(GK + R * 16 + 8), g3 = *(const f32x4*)(GK + R * 16 + 12);
            float x = bg;
#pragma unroll
            for (int j = 0; j < 4; ++j) x += g0[j] * wg[j] + g1[j] * wg[4 + j] + g2[j] * wg[8 + j] + g3[j] * wg[12 + j];
            lf[i] = -softplus_f(-x) * (1.f / 16.f); }
    }
    if (TYPE == 1) {
        float rb[19], rcc[19];
#pragma unroll
        for (int i = 0; i < 19; ++i) { const int tt = n * 64 + tb - 3 + i;
            if (tt >= 0) { const size_t R2 = (size_t)(b * 2048 + tt); rb[i] = bf2f(PJ[R2 * PA + 2560 + 512 + h * 128 + kl]); rcc[i] = bf2f(PJ[R2 * PA + 2560 + 768 + h * 128 + kl]); }
            else { rb[i] = 0.f; rcc[i] = 0.f; } }
        float cwB[4], cwC[4];
#pragma unroll
        for (int w = 0; w < 4; ++w) { cwB[w] = a.in[z + 18][w * 1024 + 512 + h * 128 + kl]; cwC[w] = a.in[z + 18][w * 1024 + 768 + h * 128 + kl]; }
        const float cbB = a.in[z + 19][512 + h * 128 + kl], cbC = a.in[z + 19][768 + h * 128 + kl];
#pragma unroll
        for (int i = 0; i < 16; i += 2) { float ab0 = cbB, ac0 = cbC, ab1 = cbB, ac1 = cbC;
#pragma unroll
            for (int w = 0; w < 4; ++w) { ab0 += rb[i + w] * cwB[w]; ac0 += rcc[i + w] * cwC[w]; ab1 += rb[i + 1 + w] * cwB[w]; ac1 += rcc[i + 1 + w] * cwC[w]; }
            const unsigned pb = pk2(silu_f(ab0), silu_f(ab1)), pc = pk2(silu_f(ac0), silu_f(ac1));
            rk[i] = pb & 0xffffu; rk[i + 1] = pb >> 16; rq[i] = pc & 0xffffu; rq[i + 1] = pc >> 16; }
        {
            const int xc = h * 256 + (tid & 255), t0x = 32 * (tid >> 8);
            bf16* CVw = (bf16*)(ws + WS_XB);
            float cwX[4];
#pragma unroll
            for (int w = 0; w < 4; ++w) cwX[w] = a.in[z + 18][w * 1024 + xc];
            const float cbX = a.in[z + 19][xc];
            float w3[3];
#pragma unroll
            for (int j = 0; j < 3; ++j) { const int tt = n * 64 + t0x - 3 + j; w3[j] = (tt >= 0) ? bf2f(PJ[(size_t)(b * 2048 + tt) * PA + 2560 + xc]) : 0.f; }
            for (int t8 = 0; t8 < 32; t8 += 8) {
                float nw[8];
#pragma unroll
                for (int j = 0; j < 8; ++j) nw[j] = bf2f(PJ[(size_t)(row0 + t0x + t8 + j) * PA + 2560 + xc]);
#pragma unroll
                for (int j = 0; j < 8; ++j) { const float ax = cbX + w3[0] * cwX[0] + w3[1] * cwX[1] + w3[2] * cwX[2] + nw[j] * cwX[3];
                    CVw[(size_t)(row0 + t0x + t8 + j) * 1024 + xc] = (bf16)(pk2(silu_f(ax), 0.f) & 0xffffu);
                    w3[0] = w3[1]; w3[1] = w3[2]; w3[2] = nw[j]; }
            }
        }
    }
    if (TYPE != 1) {
        float run = 0.f;
#pragma unroll
        for (int i = 0; i < 16; ++i) run += lf[i];
        SEG[seg * 128 + kl] = run;
        __syncthreads();
        const float s0 = SEG[kl], s1 = SEG[128 + kl], s2 = SEG[256 + kl], s3 = SEG[384 + kl];
        const float goff = (seg > 0 ? s0 : 0.f) + (seg > 1 ? s1 : 0.f) + (seg > 2 ? s2 : 0.f);
        const float glast = (s0 + s1) + (s2 + s3), eglast = __expf(glast);
        unsigned kew[8]; float grun = goff;
#pragma unroll
        for (int i = 0; i < 16; i += 2) {
            const float q0 = __uint_as_float(rq[i] << 16), q1 = __uint_as_float(rq[i + 1] << 16);
            float k0, k1;
            if (TYPE == 0) { k0 = 1.f - __expf(lf[i]); k1 = 1.f - __expf(lf[i + 1]); } else { k0 = __uint_as_float(rk[i] << 16); k1 = __uint_as_float(rk[i + 1] << 16); }
            grun += lf[i]; const float g0 = grun; grun += lf[i + 1]; const float g1 = grun;
            const float e0 = __expf(g0), e1 = __expf(g1), i0 = __builtin_amdgcn_rcpf(e0), i1 = __builtin_amdgcn_rcpf(e1);
            const int t = tb + i;
            const unsigned kk = pk2(k0 * i0, k1 * i1), qq = pk2(q0 * e0, q1 * e1);
            Ki[t * LQ + kl] = (bf16)(kk & 0xffffu); Ki[(t + 1) * LQ + kl] = (bf16)(kk >> 16);
            Qd[t * LQ + kl] = (bf16)(qq & 0xffffu); Qd[(t + 1) * LQ + kl] = (bf16)(qq >> 16);
            kew[i >> 1] = pk2(k0 * (eglast * i0), k1 * (eglast * i1));
        }
        *(LAS v4u*)(KeT + kl * LT + tb) = (v4u){kew[0], kew[1], kew[2], kew[3]};
        *(LAS v4u*)(KeT + kl * LT + tb + 8) = (v4u){kew[4], kew[5], kew[6], kew[7]};
        if (seg == 0) DEC[kl] = eglast;
    } else {
        unsigned kew[8];
#pragma unroll
        for (int i = 0; i < 16; i += 2) { const int t = tb + i;
            Qs[t * LQ + kl] = (bf16)rq[i]; Qs[(t + 1) * LQ + kl] = (bf16)rq[i + 1];
            Ki[t * LQ + kl] = (bf16)rk[i]; Ki[(t + 1) * LQ + kl] = (bf16)rk[i + 1];
            kew[i >> 1] = rk[i] | (rk[i + 1] << 16); }
        *(LAS v4u*)(KeT + kl * LT + tb) = (v4u){kew[0], kew[1], kew[2], kew[3]};
        *(LAS v4u*)(KeT + kl * LT + tb + 8) = (v4u){kew[4], kew[5], kew[6], kew[7]};
    }
    __syncthreads();
    {
        LAS bf16* Qx = (TYPE == 1) ? Qs : Qd;
#pragma unroll
        for (int u2 = 0; u2 < 2; ++u2) {
            const int t = 2 * wave + u2, ti = t >> 2, tj = t & 3;
            v2u w = (v2u){0u, 0u};
            if (tj <= ti) {
                f32x4 acc = (f32x4){0.f, 0.f, 0.f, 0.f};
                acc = mma_tile(Ki + tj * 16 * LQ, LQ, Qx + ti * 16 * LQ, LQ, 128, acc, lane);
                const int i = 16 * ti + r, j0 = 16 * tj + 4 * q;
                float pv[4];
#pragma unroll
                for (int e = 0; e < 4; ++e) pv[e] = (TYPE == 1 || j0 + e <= i) ? acc[e] : 0.f;
                w = (v2u){pk2(pv[0], pv[1]), pk2(pv[2], pv[3])};
            }
            *(LAS v2u*)(P + (16 * ti + r) * LT + 16 * tj + 4 * q) = w;
        }
    }
    __syncthreads();
    {
        unsigned char* ra = ws + WS_PREA + (size_t)rec * RECA;
        unsigned char* rp = ws + ((TYPE == 1) ? WS_PREP_S : WS_PREP_V) + (size_t)((TYPE == 1) ? rec - 1024 : rec) * RECP;
        const LAS unsigned char* s0 = lds + ((TYPE == 1) ? CK_QS : CK_QD);
        for (int p = tid; p < 1088; p += 512) *(v4u*)(ra + 16 * p) = *(const LAS v4u*)(s0 + 16 * p);
        for (int p = tid; p < 1152; p += 512) *(v4u*)(ra + 17408 + 16 * p) = *(const LAS v4u*)(lds + CK_KET + 16 * p);
        if (TYPE != 1 && tid < 32) *(v4u*)(ra + 35840 + 16 * tid) = *(const LAS v4u*)(lds + CK_DEC + 16 * tid);
        for (int p = tid; p < 576; p += 512) *(v4u*)(rp + 16 * p) = *(const LAS v4u*)(lds + CK_P + 16 * p);
    }
    __syncthreads();
}

constexpr int S2_QD = 0, S2_KET = 17408, S2_DEC = 35840, S2_P = 36352, S2_VT = 45568, S2_ST = 50176, S2_VT2 = 58880, S2_OX = 63488, S2_GS = 71680, S2_EG = 72192, S2_DTV = 72704, S2_GL = 73216;
template <int TYPE>
__device__ __forceinline__ void seq2_unit(const Args& a, int z, int b, int h, int s, LAS unsigned char* lds) {
    constexpr int V = (TYPE == 0) ? 128 : (TYPE == 1) ? 64 : 256;
    constexpr int H = (TYPE == 1) ? 8 : 4;
    const int tid = threadIdx.x, lane = tid & 63, wave = __builtin_amdgcn_readfirstlane(tid >> 6), r = lane & 15, q = lane >> 4;
    LAS bf16* Qd = (LAS bf16*)(lds + S2_QD); LAS bf16* KeT = (LAS bf16*)(lds + S2_KET); LAS float* DEC = (LAS float*)(lds + S2_DEC);
    LAS bf16* P = (LAS bf16*)(lds + S2_P); LAS bf16* VT = (LAS bf16*)(lds + S2_VT); LAS bf16* ST = (LAS bf16*)(lds + S2_ST); LAS bf16* VT2 = (LAS bf16*)(lds + S2_VT2);
    LAS float* OX = (LAS float*)(lds + S2_OX); LAS float* GS = (LAS float*)(lds + S2_GS); LAS float* EG = (LAS float*)(lds + S2_EG); LAS float* DTV = (LAS float*)(lds + S2_DTV);
    LAS float* GL = (LAS float*)(lds + S2_GL);
    unsigned char* ws = a.ws;
    const bf16* PJ = (const bf16*)(ws + WS_PROJ); const float* DT = (const float*)(ws + WS_DT); const bf16* CV = (const bf16*)(ws + WS_XB);
    bf16* OG = (bf16*)(ws + WS_OG);
    const int vl = tid & 31, tq = tid >> 5;
    constexpr int PP = (TYPE == 2) ? PG : PA;
    float a_h = 0.f, d_h = 0.f;
    if (TYPE == 1) { a_h = -__expf(a.in[z + 21][h]); d_h = a.in[z + 22][h]; }
    const int rec0 = (TYPE == 1) ? 1024 + (b * 2 + (h >> 2)) * 32 : (b * 4 + h) * 32;
    const unsigned char* ra0 = ws + WS_PREA + (size_t)rec0 * RECA;
    const unsigned char* rp0 = ws + ((TYPE == 1) ? WS_PREP_S + (size_t)(rec0 - 1024) * RECP : WS_PREP_V + (size_t)rec0 * RECP);
    constexpr int NA = (TYPE == 1) ? 2240 : 2272;
    struct Pre { v4u a[5]; v4u p[2]; unsigned v[4]; float dt; };
    auto load_pre = [&](Pre& w, int n_) {
        const unsigned char* ra = ra0 + (size_t)n_ * RECA; const unsigned char* rp = rp0 + (size_t)n_ * RECP;
#pragma unroll
        for (int j = 0; j < 5; ++j) { const int p = tid + 512 * j; if (p < NA) w.a[j] = *(const v4u*)(ra + 16 * p); }
        w.p[0] = *(const v4u*)(rp + 16 * tid); if (tid < 64) w.p[1] = *(const v4u*)(rp + 16 * (tid + 512));
        const int row0_ = b * 2048 + n_ * 64;
#pragma unroll
        for (int i = 0; i < 4; ++i) { const size_t R = (size_t)(row0_ + 4 * tq + i);
            w.v[i] = (TYPE == 1) ? CV[R * 1024 + h * 64 + s * 32 + vl] : PJ[R * PP + 1024 + h * V + s * 32 + vl]; }
        if (TYPE == 1) w.dt = (tid < 64) ? DT[(size_t)(row0_ + tid) * 8 + h] : 0.f;
    };
    f32x4 sacc[2] = {(f32x4){0.f, 0.f, 0.f, 0.f}, (f32x4){0.f, 0.f, 0.f, 0.f}};
    __syncthreads();
    for (int e = tid; e < 32 * LQ / 2; e += 512) ((LAS unsigned*)ST)[e] = 0u;
    const int colbase = (TYPE == 0) ? h * 128 + s * 32 : (TYPE == 1) ? 512 + h * 64 + s * 32 : h * 256 + s * 32;
    Pre rc, rn;
    load_pre(rc, 0);
    float dt1 = 0.f, dt2 = 0.f;
    auto scan_into = [&](float dtv, int buf) {
        float x = dtv * a_h;
#pragma unroll
        for (int o = 1; o < 64; o <<= 1) { const float y = __shfl_up(x, o); if (lane >= o) x += y; }
        GS[64 * buf + lane] = x; EG[64 * buf + lane] = __expf(x); DTV[64 * buf + lane] = dtv; if (lane == 63) GL[buf] = x;
    };
    if (TYPE == 1) {
        if (wave == 0) { scan_into(rc.dt, 0); dt1 = DT[(size_t)(b * 2048 + 64 + lane) * 8 + h]; }
        __syncthreads();
    }
    for (int n = 0; n < 32; ++n) {
        const int row0 = b * 2048 + n * 64;
        const int sb = n & 1;
        if (n + 1 < 32) load_pre(rn, n + 1);
        if (TYPE == 1 && wave == 0 && n + 2 < 32) dt2 = DT[(size_t)(b * 2048 + (n + 2) * 64 + lane) * 8 + h];
#pragma unroll
        for (int j = 0; j < 5; ++j) { const int p = tid + 512 * j; if (p < NA) *(LAS v4u*)(lds + 16 * p) = rc.a[j]; }
        if (TYPE != 1) {
            *(LAS v4u*)(lds + S2_P + 16 * tid) = rc.p[0]; if (tid < 64) *(LAS v4u*)(lds + S2_P + 16 * (tid + 512)) = rc.p[1];
            *(LAS v2u*)(VT + vl * LT + 4 * tq) = (v2u){rc.v[0] | (rc.v[1] << 16), rc.v[2] | (rc.v[3] << 16)};
        } else {
            const LAS float* GSb = GS + 64 * sb; const LAS float* DTVb = DTV + 64 * sb;
            const float glast = GL[sb];
#pragma unroll
            for (int jj = 0; jj < 2; ++jj) {
                const int p = tid + 512 * jj;
                if (jj == 0 || tid < 64) {
                    const int i = p / 9, c8 = p - 9 * i; v4u c = rc.p[jj];
                    if (c8 < 8) {
                        const int j0 = 8 * c8; const unsigned cw[4] = {c.x, c.y, c.z, c.w}; unsigned o[4];
                        const float gi = GSb[i];
#pragma unroll
                        for (int e = 0; e < 4; ++e) { const int j = j0 + 2 * e;
                            const float x0 = (j <= i) ? __uint_as_float(cw[e] << 16) * __expf(gi - GSb[j]) : 0.f;
                            const float x1 = (j + 1 <= i) ? __uint_as_float(cw[e] & 0xffff0000u) * __expf(gi - GSb[j + 1]) : 0.f;
                            o[e] = pk2(x0, x1); }
                        c = (v4u){o[0], o[1], o[2], o[3]};
                    }
                    *(LAS v4u*)(lds + S2_P + 16 * p) = c;
                }
            }
            {
                float v1[4], v2[4];
#pragma unroll
                for (int i = 0; i < 4; ++i) { const int t = 4 * tq + i; const float x = __uint_as_float(rc.v[i] << 16); OX[t * 32 + vl] = d_h * x; v1[i] = x * DTVb[t]; v2[i] = v1[i] * __expf(glast - GSb[t]); }
                *(LAS v2u*)(VT + vl * LT + 4 * tq) = (v2u){pk2(v1[0], v1[1]), pk2(v1[2], v1[3])};
                *(LAS v2u*)(VT2 + vl * LT + 4 * tq) = (v2u){pk2(v2[0], v2[1]), pk2(v2[2], v2[3])};
            }
        }
        __syncthreads();
        if (TYPE == 1 && wave == 0 && n + 1 < 32) scan_into(dt1, sb ^ 1);
        {
            const int ti = wave >> 1, tv = wave & 1;
            f32x4 acc = (f32x4){0.f, 0.f, 0.f, 0.f}, acc2 = (f32x4){0.f, 0.f, 0.f, 0.f};
            acc = mma_tile(VT + tv * 16 * LT, LT, P + ti * 16 * LT, LT, (ti < 2) ? 32 : 64, acc, lane);
            acc2 = mma_tile(ST + tv * 16 * LQ, LQ, Qd + ti * 16 * LQ, LQ, 128, acc2, lane);
            const int i = 16 * ti + r, v0 = 16 * tv + 4 * q;
            if (TYPE == 1) { const f32x4 ox = *(const LAS f32x4*)(OX + i * 32 + v0); acc = acc + acc2 * EG[64 * sb + i] + ox; } else acc = acc + acc2;
            *(v2u*)(OG + (size_t)(row0 + i) * D + colbase + v0) = (v2u){pk2(acc[0], acc[1]), pk2(acc[2], acc[3])};
        }
#pragma unroll
        for (int u2 = 0; u2 < 2; ++u2) {
            const int ti = 2 * wave + u2, vt = ti >> 3, kt = ti & 7;
            if (TYPE == 1) { const float dc = __expf(GL[sb]); sacc[u2] = sacc[u2] * dc; }
            else { const f32x4 dc = *(const LAS f32x4*)(DEC + 16 * kt + 4 * q); sacc[u2] = sacc[u2] * dc; }
            sacc[u2] = mma_tile(KeT + kt * 16 * LT, LT, ((TYPE == 1) ? VT2 : VT) + vt * 16 * LT, LT, 64, sacc[u2], lane);
        }
        __syncthreads();
#pragma unroll
        for (int u2 = 0; u2 < 2; ++u2) {
            const int ti = 2 * wave + u2, vt = ti >> 3, kt = ti & 7;
            *(LAS v2u*)(ST + (16 * vt + r) * LQ + 16 * kt + 4 * q) = (v2u){pk2(sacc[u2][0], sacc[u2][1]), pk2(sacc[u2][2], sacc[u2][3])};
        }
        rc = rn; dt1 = dt2;
    }
#pragma unroll
    for (int u2 = 0; u2 < 2; ++u2) {
        const int ti = 2 * wave + u2, vt = ti >> 3, kt = ti & 7;
        const int k0 = 16 * kt + 4 * q, v = 16 * vt + r;
        if (TYPE == 1) {
            *(f32x4*)(a.out + O_SP + ((size_t)(b * 8 + h) * 64 + s * 32 + v) * 128 + k0) = sacc[u2];
        } else {
            float* dp = a.out + (TYPE == 0 ? O_HP : O_GP) + (size_t)(b * H + h) * 128 * V + s * 32 + v;
#pragma unroll
            for (int e = 0; e < 4; ++e) dp[(size_t)(k0 + e) * V] = sacc[u2][e];
        }
    }
    __syncthreads();
}

template <int TYPE>
__device__ __forceinline__ void samp_unit(const Args& a, int z, int sx, int h, int s, LAS float* W, int lane) {
    constexpr int V = (TYPE == 0) ? 128 : (TYPE == 1) ? 64 : 256;
    constexpr int H = (TYPE == 1) ? 8 : 4;
    const int v = lane & 31, kh = lane >> 5;
    const int row0 = TP + sx * 4;
    unsigned char* ws = a.ws;
    const bf16* PJ = (const bf16*)(ws + WS_PROJ);
    const float* LF = (const float*)(ws + WS_LF); const float* DT = (const float*)(ws + WS_DT); const float* GK = (const float*)(ws + WS_GK);
    bf16* OG = (bf16*)(ws + WS_OG);
    LAS float* Wq = W; LAS float* Wk = W + 512; LAS float* Wf = W + 1024;
    float S[64];
    if (TYPE == 1) {
        const float* sp = a.in[z + 3] + ((size_t)(sx * 8 + h) * 64 + s * 32 + v) * 128 + 64 * kh;
#pragma unroll
        for (int j = 0; j < 16; ++j) { const f32x4 x = *(const f32x4*)(sp + 4 * j); S[4 * j] = x[0]; S[4 * j + 1] = x[1]; S[4 * j + 2] = x[2]; S[4 * j + 3] = x[3]; }
    } else {
        const float* sp = a.in[z + (TYPE == 0 ? 2 : 5)] + (size_t)(sx * H + h) * 128 * V + (size_t)(64 * kh) * V + s * 32 + v;
#pragma unroll
        for (int i = 0; i < 64; ++i) S[i] = sp[(size_t)i * V];
    }
    float vt[4], xsk[4] = {0.f, 0.f, 0.f, 0.f};
    if (TYPE == 0) {
#pragma unroll
        for (int t = 0; t < 4; ++t) { const size_t R = (size_t)(row0 + t);
#pragma unroll
            for (int c = 0; c < 2; ++c) { const int kk = lane + 64 * c; const float f = __expf(LF[R * 512 + h * 128 + kk]);
                Wq[t * 128 + kk] = bf2f(PJ[R * PA + h * 128 + kk]); Wk[t * 128 + kk] = 1.f - f; Wf[t * 128 + kk] = f; }
            vt[t] = bf2f(PJ[R * PA + 1024 + h * 128 + s * 32 + v]); }
    } else if (TYPE == 2) {
#pragma unroll
        for (int c = 0; c < 2; ++c) { const int kk = lane + 64 * c;
            float wg[16];
#pragma unroll
            for (int r = 0; r < 16; ++r) wg[r] = a.in[z + 25][r * 512 + h * 128 + kk];
            const float bg = a.in[z + 26][h * 128 + kk];
#pragma unroll
            for (int t = 0; t < 4; ++t) { const size_t R = (size_t)(row0 + t); float x = bg;
#pragma unroll
                for (int r = 0; r < 16; ++r) x += GK[R * 16 + r] * wg[r];
                Wf[t * 128 + kk] = __expf(-softplus_f(-x) * (1.f / 16.f));
                Wq[t * 128 + kk] = bf2f(PJ[R * PG + h * 128 + kk]); Wk[t * 128 + kk] = bf2f(PJ[R * PG + 512 + h * 128 + kk]); } }
#pragma unroll
        for (int t = 0; t < 4; ++t) vt[t] = bf2f(PJ[(size_t)(row0 + t) * PG + 1024 + h * 256 + s * 32 + v]);
    } else {
        const int g = h >> 2;
        const float* cst = a.in[z + 4] + (size_t)sx * 3 * 1024;
        const float a_h = -__expf(a.in[z + 21][h]), d_h = a.in[z + 22][h];
        float dtv[4];
#pragma unroll
        for (int t = 0; t < 4; ++t) dtv[t] = DT[(size_t)(row0 + t) * 8 + h];
#pragma unroll
        for (int c = 0; c < 2; ++c) { const int kk = lane + 64 * c;
#pragma unroll
            for (int bc = 0; bc < 2; ++bc) { const int ch = (bc ? 768 : 512) + g * 128 + kk;
                float raw[7];
#pragma unroll
                for (int j = 0; j < 7; ++j) raw[j] = (j < 3) ? cst[j * 1024 + ch] : bf2f(PJ[(size_t)(row0 + j - 3) * PA + 2560 + ch]);
                const float cb = a.in[z + 19][ch];
#pragma unroll
                for (int t = 0; t < 4; ++t) { float acc = cb;
#pragma unroll
                    for (int w = 0; w < 4; ++w) acc += raw[t + w] * a.in[z + 18][w * 1024 + ch];
                    (bc ? Wq : Wk)[t * 128 + kk] = silu_f(acc); } }
#pragma unroll
            for (int t = 0; t < 4; ++t) Wf[t * 128 + kk] = __expf(dtv[t] * a_h); }
        { const int ch = h * 64 + s * 32 + v; float raw[7];
#pragma unroll
            for (int j = 0; j < 7; ++j) raw[j] = (j < 3) ? cst[j * 1024 + ch] : bf2f(PJ[(size_t)(row0 + j - 3) * PA + 2560 + ch]);
            const float cb = a.in[z + 19][ch];
#pragma unroll
            for (int t = 0; t < 4; ++t) { float acc = cb;
#pragma unroll
                for (int w = 0; w < 4; ++w) acc += raw[t + w] * a.in[z + 18][w * 1024 + ch];
                const float x = silu_f(acc); vt[t] = x * dtv[t]; xsk[t] = d_h * x; } }
    }
    asm volatile("s_waitcnt lgkmcnt(0)" ::: "memory"); __builtin_amdgcn_wave_barrier();
    const int colbase = (TYPE == 0) ? h * 128 + s * 32 : (TYPE == 1) ? 512 + h * 64 + s * 32 : h * 256 + s * 32;
#pragma unroll
    for (int t = 0; t < 4; ++t) {
        float p = 0.f;
#pragma unroll
        for (int j = 0; j < 16; ++j) {
            const f32x4 q4 = *(const LAS f32x4*)(Wq + t * 128 + 64 * kh + 4 * j), k4 = *(const LAS f32x4*)(Wk + t * 128 + 64 * kh + 4 * j), f4 = *(const LAS f32x4*)(Wf + t * 128 + 64 * kh + 4 * j);
#pragma unroll
            for (int e = 0; e < 4; ++e) { S[4 * j + e] = f4[e] * S[4 * j + e] + k4[e] * vt[t]; p += q4[e] * S[4 * j + e]; }
        }
        p += __shfl_xor(p, 32);
        p += xsk[t];
        const float pn = __shfl_down(p, 1);
        if (lane < 32 && (lane & 1) == 0) *(unsigned*)(OG + (size_t)(row0 + t) * D + colbase + v) = pk2(p, pn);
    }
    asm volatile("s_waitcnt lgkmcnt(0)" ::: "memory"); __builtin_amdgcn_wave_barrier();
    if (TYPE == 1) {
        float* dp = a.out + O_SS + ((size_t)(sx * 8 + h) * 64 + s * 32 + v) * 128 + 64 * kh;
#pragma unroll
        for (int j = 0; j < 16; ++j) *(f32x4*)(dp + 4 * j) = (f32x4){S[4 * j], S[4 * j + 1], S[4 * j + 2], S[4 * j + 3]};
    } else {
        float* dp = a.out + (TYPE == 0 ? O_HS : O_GS) + (size_t)(sx * H + h) * 128 * V + (size_t)(64 * kh) * V + s * 32 + v;
#pragma unroll
        for (int i = 0; i < 64; ++i) dp[(size_t)i * V] = S[i];
    }
}

__device__ __forceinline__ void phase_ssd_conv(const Args& a, int z) {
    const int c = 2 * threadIdx.x;
    const bf16* PJ = (const bf16*)(a.ws + WS_PROJ); bf16* CV = (bf16*)(a.ws + WS_XB);
    float cw0[4], cw1[4];
#pragma unroll
    for (int w = 0; w < 4; ++w) { cw0[w] = a.in[z + 18][w * 1024 + c]; cw1[w] = a.in[z + 18][w * 1024 + c + 1]; }
    const float cb0 = a.in[z + 19][c], cb1 = a.in[z + 19][c + 1];
    for (int strip = blockIdx.x; strip < 256; strip += gridDim.x) {
        const int b = strip >> 5, t0 = (strip & 31) * 64;
        unsigned w3[3];
#pragma unroll
        for (int j = 0; j < 3; ++j) { const int t = t0 - 3 + j; w3[j] = (t >= 0) ? *(const unsigned*)(PJ + (size_t)(b * 2048 + t) * PA + 2560 + c) : 0u; }
        for (int tt = 0; tt < 64; tt += 8) {
            unsigned nw[8];
#pragma unroll
            for (int j = 0; j < 8; ++j) nw[j] = *(const unsigned*)(PJ + (size_t)(b * 2048 + t0 + tt + j) * PA + 2560 + c);
#pragma unroll
            for (int j = 0; j < 8; ++j) {
                const unsigned r0 = w3[0], r1 = w3[1], r2 = w3[2], r3 = nw[j];
                const float a0 = cb0 + __uint_as_float(r0 << 16) * cw0[0] + __uint_as_float(r1 << 16) * cw0[1] + __uint_as_float(r2 << 16) * cw0[2] + __uint_as_float(r3 << 16) * cw0[3];
                const float a1 = cb1 + __uint_as_float(r0 & 0xffff0000u) * cw1[0] + __uint_as_float(r1 & 0xffff0000u) * cw1[1] + __uint_as_float(r2 & 0xffff0000u) * cw1[2] + __uint_as_float(r3 & 0xffff0000u) * cw1[3];
                *(unsigned*)(CV + (size_t)(b * 2048 + t0 + tt + j) * 1024 + c) = pk2(silu_f(a0), silu_f(a1));
                w3[0] = r1; w3[1] = r2; w3[2] = r3;
            }
        }
    }
}

__device__ __forceinline__ void phase_gla_lf(const Args& a, int z) {
    const int c = threadIdx.x;
    float wg[16];
#pragma unroll
    for (int r = 0; r < 16; ++r) wg[r] = a.in[z + 25][r * 512 + c];
    const float bg = a.in[z + 26][c];
    const float* GK = (const float*)(a.ws + WS_GK); float* LF = (float*)(a.ws + WS_LF);
    for (int R = blockIdx.x; R < T; R += gridDim.x) {
        const f32x4 g0 = *(const f32x4*)(GK + (size_t)R * 16), g1 = *(const f32x4*)(GK + (size_t)R * 16 + 4), g2 = *(const f32x4*)(GK + (size_t)R * 16 + 8), g3 = *(const f32x4*)(GK + (size_t)R * 16 + 12);
        float x = bg;
#pragma unroll
        for (int j = 0; j < 4; ++j) x += g0[j] * wg[j] + g1[j] * wg[4 + j] + g2[j] * wg[8 + j] + g3[j] * wg[12 + j];
        LF[(size_t)R * 512 + c] = -softplus_f(-x) * (1.f / 16.f);
    }
}

template <int TYPE>
__device__ __forceinline__ void samp_unit_v(const Args& a, int z, int sx, int h, int s, LAS float* W, int lane) {
    constexpr int V = (TYPE == 0) ? 128 : 256;
    constexpr int PP = (TYPE == 0) ? PA : PG;
    const int v4 = lane & 7, kg = lane >> 3;
    const int row0 = TP + sx * 4;
    unsigned char* ws = a.ws;
    const bf16* PJ = (const bf16*)(ws + WS_PROJ);
    const float* LF = (const float*)(ws + WS_LF); const float* GK = (const float*)(ws + WS_GK);
    bf16* OG = (bf16*)(ws + WS_OG);
    LAS float* Wq = W; LAS float* Wk = W + 512; LAS float* Wf = W + 1024;
    f32x4 S[16];
    const float* sp = a.in[z + (TYPE == 0 ? 2 : 5)] + (size_t)(sx * 4 + h) * 128 * V + (size_t)(16 * kg) * V + s * 32 + 4 * v4;
#pragma unroll
    for (int i = 0; i < 16; ++i) S[i] = *(const f32x4*)(sp + (size_t)i * V);
    f32x4 vt[4];
    if (TYPE == 0) {
#pragma unroll
        for (int t = 0; t < 4; ++t) { const size_t R = (size_t)(row0 + t);
#pragma unroll
            for (int c = 0; c < 2; ++c) { const int kk = lane + 64 * c; const float f = __expf(LF[R * 512 + h * 128 + kk]);
                Wq[t * 128 + kk] = bf2f(PJ[R * PA + h * 128 + kk]); Wk[t * 128 + kk] = 1.f - f; Wf[t * 128 + kk] = f; } }
    } else {
#pragma unroll
        for (int c = 0; c < 2; ++c) { const int kk = lane + 64 * c;
            float wg[16];
#pragma unroll
            for (int r = 0; r < 16; ++r) wg[r] = a.in[z + 25][r * 512 + h * 128 + kk];
            const float bg = a.in[z + 26][h * 128 + kk];
#pragma unroll
            for (int t = 0; t < 4; ++t) { const size_t R = (size_t)(row0 + t); float x = bg;
#pragma unroll
                for (int r = 0; r < 16; ++r) x += GK[R * 16 + r] * wg[r];
                Wf[t * 128 + kk] = __expf(-softplus_f(-x) * (1.f / 16.f));
                Wq[t * 128 + kk] = bf2f(PJ[R * PG + h * 128 + kk]); Wk[t * 128 + kk] = bf2f(PJ[R * PG + 512 + h * 128 + kk]); } }
    }
#pragma unroll
    for (int t = 0; t < 4; ++t) { const v2u w = *(const v2u*)(PJ + (size_t)(row0 + t) * PP + 1024 + h * V + s * 32 + 4 * v4);
        vt[t] = (f32x4){__uint_as_float(w.x << 16), __uint_as_float(w.x & 0xffff0000u), __uint_as_float(w.y << 16), __uint_as_float(w.y & 0xffff0000u)}; }
    asm volatile("s_waitcnt lgkmcnt(0)" ::: "memory"); __builtin_amdgcn_wave_barrier();
    const int colbase = (TYPE == 0) ? h * 128 + s * 32 : h * 256 + s * 32;
#pragma unroll
    for (int t = 0; t < 4; ++t) {
        f32x4 p = (f32x4){0.f, 0.f, 0.f, 0.f};
#pragma unroll
        for (int j = 0; j < 4; ++j) {
            const f32x4 q4 = *(const LAS f32x4*)(Wq + t * 128 + 16 * kg + 4 * j), k4 = *(const LAS f32x4*)(Wk + t * 128 + 16 * kg + 4 * j), f4 = *(const LAS f32x4*)(Wf + t * 128 + 16 * kg + 4 * j);
#pragma unroll
            for (int e = 0; e < 4; ++e) { S[4 * j + e] = S[4 * j + e] * f4[e] + vt[t] * k4[e]; p = p + S[4 * j + e] * q4[e]; }
        }
#pragma unroll
        for (int e = 0; e < 4; ++e) { float x = p[e]; x += __shfl_xor(x, 8); x += __shfl_xor(x, 16); x += __shfl_xor(x, 32); p[e] = x; }
        if (lane < 8) *(v2u*)(OG + (size_t)(row0 + t) * D + colbase + 4 * v4) = (v2u){pk2(p[0], p[1]), pk2(p[2], p[3])};
    }
    asm volatile("s_waitcnt lgkmcnt(0)" ::: "memory"); __builtin_amdgcn_wave_barrier();
    float* dp = a.out + (TYPE == 0 ? O_HS : O_GS) + (size_t)(sx * 4 + h) * 128 * V + (size_t)(16 * kg) * V + s * 32 + 4 * v4;
#pragma unroll
    for (int i = 0; i < 16; ++i) *(f32x4*)(dp + (size_t)i * V) = S[i];
}

__device__ __forceinline__ void phase_mix_pre0(const Args& a, int z, LAS unsigned char* lds) {
    for (int u = blockIdx.x; u < 1536; u += gridDim.x) {
        if (u < 1024) pre_unit<0>(a, z, u >> 7, (u >> 5) & 3, u & 31, u, lds);
        else { const int v = u - 1024; pre_unit<1>(a, z, v >> 6, (v >> 5) & 1, v & 31, u, lds); }
    }
}
__device__ __forceinline__ void phase_mix_pre1(const Args& a, int z, LAS unsigned char* lds) {
    for (int u = blockIdx.x; u < 1024; u += gridDim.x) pre_unit<2>(a, z, u >> 7, (u >> 5) & 3, u & 31, u, lds);
}
__device__ __forceinline__ void phase_mix0(const Args& a, int z, LAS unsigned char* lds) {
    for (int u = blockIdx.x; u < 128; u += gridDim.x) seq2_unit<0>(a, z, u >> 4, (u >> 2) & 3, u & 3, lds);
    for (int u = blockIdx.x; u < 256; u += gridDim.x) if (u >= 128) { const int v = u - 128; seq2_unit<1>(a, z, v >> 4, (v >> 1) & 7, v & 1, lds); }
    const int lane = threadIdx.x & 63, wave = __builtin_amdgcn_readfirstlane(threadIdx.x >> 6);
    LAS float* W = (LAS float*)(lds + wave * 6144);
    const int gw = blockIdx.x * NWAVES + wave, NGW = gridDim.x * NWAVES;
    for (int v = gw; v < 2048; v += NGW) samp_unit_v<0>(a, z, v >> 4, (v >> 2) & 3, v & 3, W, lane);
    for (int v = gw; v < 2048; v += NGW) samp_unit<1>(a, z, v >> 4, (v >> 1) & 7, v & 1, W, lane);
}
__device__ __forceinline__ void phase_mix1(const Args& a, int z, LAS unsigned char* lds) {
    for (int u = blockIdx.x; u < 256; u += gridDim.x) seq2_unit<2>(a, z, u >> 5, (u >> 3) & 3, u & 7, lds);
    const int lane = threadIdx.x & 63, wave = __builtin_amdgcn_readfirstlane(threadIdx.x >> 6);
    LAS float* W = (LAS float*)(lds + wave * 6144);
    const int gw = blockIdx.x * NWAVES + wave, NGW = gridDim.x * NWAVES;
    for (int v = gw; v < 4096; v += NGW) samp_unit_v<2>(a, z, v >> 5, (v >> 3) & 3, v & 7, W, lane);
}

struct CapOrder {
    int c; unsigned* cnt;
    __device__ __forceinline__ bool next(int i, pg8::Unit& u) const {
        int ii = i;
        if (c >= 128 && c < 172) { if (i == 0) { const int s = c - 128; u.pm = 64 + s / 22; u.pn = s % 22; return true; } ii = i - 1; }
        const int cap = (c >= 248) ? 3 : ((c >= 128 && c < 172) ? 5 : 6);
        if (ii >= cap) return false;
        int idx;
        if (ii < 3) idx = ii * 256 + c; else if (ii < 5) idx = 768 + (ii - 3) * 248 + c; else idx = 1264 + (c < 128 ? c : c - 44);
        if (idx >= 1408) return false;
        const int xcd = idx & 7, off = idx >> 3, wgid = xcd * 176 + off;
        const int gid = wgid / 176, w2 = wgid - gid * 176;
        u.pm = gid * 8 + (w2 & 7); u.pn = w2 >> 3; return true;
    }
    __device__ __forceinline__ void a_ready(const pg8::Unit&) const {}
    __device__ __forceinline__ void done(const pg8::Unit& u) const {
        if (u.pm >= 64) { asm volatile("s_waitcnt vmcnt(0)" ::: "memory");
            if ((threadIdx.x & 63) == 0) __hip_atomic_fetch_add(cnt, 1u, __ATOMIC_RELAXED, __HIP_MEMORY_SCOPE_AGENT); }
    }
};
struct OneUnit {
    int pm, pn;
    __device__ __forceinline__ bool next(int i, pg8::Unit& u) const { if (i != 0) return false; u.pm = pm; u.pn = pn; return true; }
    __device__ __forceinline__ void a_ready(const pg8::Unit&) const {}
    __device__ __forceinline__ void done(const pg8::Unit&) const {}
};
__device__ __forceinline__ void wait_count(unsigned* cnt, unsigned need) {
    if (threadIdx.x == 0) { unsigned sp = 0; while (__hip_atomic_load(cnt, __ATOMIC_RELAXED, __HIP_MEMORY_SCOPE_AGENT) < need && ++sp < (1u << 22)) __builtin_amdgcn_s_sleep(2); }
    __builtin_amdgcn_fence(__ATOMIC_ACQUIRE, "agent"); asm volatile("s_waitcnt vmcnt(0)" ::: "memory");
    __syncthreads();
    __builtin_amdgcn_fence(__ATOMIC_ACQUIRE, "agent"); asm volatile("s_waitcnt vmcnt(0)" ::: "memory");
}

template <int LAYER>
__device__ __forceinline__ void post_row(const Args& a, int R, int lane, const float (&wn)[16]) {
    const bf16* PJ = (const bf16*)(a.ws + WS_PROJ); bf16* OG = (bf16*)(a.ws + WS_OG);
    const int c = 16 * lane;
    {
        const v4u o0 = *(const v4u*)(OG + (size_t)R * D + c), o1 = *(const v4u*)(OG + (size_t)R * D + c + 8);
        const bf16* gp = (LAYER == 0) ? PJ + (size_t)R * PA + 1536 + c : PJ + (size_t)R * PG + 2048 + c;
        const v4u g0 = *(const v4u*)gp, g1 = *(const v4u*)(gp + 8);
        float o[16], gt[16];
        const unsigned ow[8] = {o0.x, o0.y, o0.z, o0.w, o1.x, o1.y, o1.z, o1.w}, gw8[8] = {g0.x, g0.y, g0.z, g0.w, g1.x, g1.y, g1.z, g1.w};
#pragma unroll
        for (int j = 0; j < 8; ++j) { o[2 * j] = __uint_as_float(ow[j] << 16); o[2 * j + 1] = __uint_as_float(ow[j] & 0xffff0000u);
            gt[2 * j] = __uint_as_float(gw8[j] << 16); gt[2 * j + 1] = __uint_as_float(gw8[j] & 0xffff0000u); }
        const bool pre_gate = (LAYER == 0) && (lane >= 32);
        float ss = 0.f;
#pragma unroll
        for (int j = 0; j < 16; ++j) { if (pre_gate) o[j] *= gt[j]; ss += o[j] * o[j]; }
        ss += __shfl_xor(ss, 1); ss += __shfl_xor(ss, 2); ss += __shfl_xor(ss, 4);
        const float t8 = __shfl_xor(ss, 8);
        const bool wide = (LAYER == 1) || (lane >= 32);
        if (wide) ss += t8;
        const float rstd = rsqrtf(ss * (wide ? (1.f / 256.f) : (1.f / 128.f)) + EPS);
        unsigned r[8];
#pragma unroll
        for (int j = 0; j < 8; ++j) {
            float y0 = o[2 * j] * rstd * wn[2 * j], y1 = o[2 * j + 1] * rstd * wn[2 * j + 1];
            if (!pre_gate) { y0 *= gt[2 * j]; y1 *= gt[2 * j + 1]; }
            r[j] = pk2(y0, y1);
        }
        if (R >= TP) {
            unsigned long long* p8 = (unsigned long long*)(OG + (size_t)R * D + c);
#pragma unroll
            for (int j = 0; j < 4; ++j) __hip_atomic_store(p8 + j, (unsigned long long)r[2 * j] | ((unsigned long long)r[2 * j + 1] << 32), __ATOMIC_RELAXED, __HIP_MEMORY_SCOPE_AGENT);
        } else { *(v4u*)(OG + (size_t)R * D + c) = (v4u){r[0], r[1], r[2], r[3]}; *(v4u*)(OG + (size_t)R * D + c + 8) = (v4u){r[4], r[5], r[6], r[7]}; }
    }
}
template <int LAYER>
__device__ __forceinline__ void phase_post(const Args& a, int z, LAS unsigned char* lds, unsigned* cnt) {
    const int tid = threadIdx.x, lane = tid & 63, wave = tid >> 6;
    const int gw = blockIdx.x * NWAVES + wave, NGW = gridDim.x * NWAVES;
    const bf16* PJ = (const bf16*)(a.ws + WS_PROJ);
    const int c = 16 * lane;
    float wn[16];
    if (LAYER == 0) {
#pragma unroll
        for (int j = 0; j < 16; ++j) wn[j] = (lane < 32) ? a.in[z + 17][(c + j) & 127] : a.in[z + 23][c - 512 + j];
    } else {
#pragma unroll
        for (int j = 0; j < 16; ++j) wn[j] = a.in[z + 27][(c + j) & 255];
    }
    bool did = false;
    for (int R = TP + gw; R < T; R += NGW) { post_row<LAYER>(a, R, lane, wn); did = true; }
    if (did) { asm volatile("s_waitcnt vmcnt(0)" ::: "memory");
        if (lane == 0) __hip_atomic_fetch_add(cnt, 1u, __ATOMIC_RELAXED, __HIP_MEMORY_SCOPE_AGENT); }
    const int nsamp_waves = (T - TP) < NGW ? (T - TP) : NGW;
    if (blockIdx.x >= 248) {
        wait_count(cnt, (unsigned)nsamp_waves);
        pg8::Gemm g{(const bf16*)(a.ws + WS_OG), (const bf16*)(a.ws + (LAYER == 0 ? WS_WAO : WS_WGO)), T, D, D};
        OneUnit S{64 + ((int)blockIdx.x - 248) / 4, ((int)blockIdx.x - 248) % 4};
        Epi<1, 1> E{a.ws, a.out, a.out, a.out + (size_t)TP * D, a.in[16], a.in[20]};
        pg8::gemm_phase<Epi<1, 1>, OneUnit, true, true>(lds, g, S, E);
        return;
    }
    for (int R = gw; R < TP; R += 248 * NWAVES) post_row<LAYER>(a, R, lane, wn);
    if (LAYER == 0) {
        const int gt_ = blockIdx.x * 512 + tid, NT = 248 * 512;
        for (int e = gt_; e < 136 * 3072; e += NT) {
            const int sq = e / 3072, r = (e / 1024) % 3, ch = e & 1023;
            const int row = (sq < 8) ? sq * 2048 + 2045 + r : TP + (sq - 8) * 4 + 1 + r;
            const float v = bf2f(PJ[(size_t)row * PA + 2560 + ch]);
            if (sq < 8) a.out[O_CP + e] = v; else a.out[O_CS + (e - 8 * 3072)] = v;
        }
    }
}

__device__ __forceinline__ void phase_final(const Args& a, int z) {
    const int tid = threadIdx.x, lane = tid & 63, wave = tid >> 6;
    const int gw = blockIdx.x * NWAVES + wave, NGW = gridDim.x * NWAVES;
    const float* SSQ = (const float*)(a.ws + WS_SSQ);
    f32x4 wn[4];
#pragma unroll
    for (int j = 0; j < 4; ++j) wn[j] = *((const f32x4*)a.in[z + (9)] + lane + 64 * j);
    for (int R = gw; R < T; R += 2 * NGW) {
        const int R2 = R + NGW; const bool two = R2 < T;
        f32x4* xr = (f32x4*)(a.out + (size_t)R * D) + lane; f32x4* xr2 = (f32x4*)(a.out + (size_t)(two ? R2 : R) * D) + lane;
        f32x4 v[4], v2[4];
#pragma unroll
        for (int j = 0; j < 4; ++j) { v[j] = xr[64 * j]; v2[j] = xr2[64 * j]; }
        float s = (lane < 16) ? SSQ[(size_t)R * 16 + lane] : 0.f, s2 = (lane < 16) ? SSQ[(size_t)(two ? R2 : R) * 16 + lane] : 0.f;
        s = wave_sum(s); s2 = wave_sum(s2);
        const float rstd = rsqrtf(s * (1.f / 1024.f) + EPS), rstd2 = rsqrtf(s2 * (1.f / 1024.f) + EPS);
#pragma unroll
        for (int j = 0; j < 4; ++j) xr[64 * j] = v[j] * rstd * wn[j];
        if (two) {
#pragma unroll
            for (int j = 0; j < 4; ++j) xr2[64 * j] = v2[j] * rstd2 * wn[j];
        }
    }
}


#define GAS __attribute__((address_space(1)))
typedef GAS unsigned gu32;
#define RLX_AGENT __ATOMIC_RELAXED, __HIP_MEMORY_SCOPE_AGENT
#define XB_TMO      128
#define XB_XCNT(j)  (256  + 64 * (j))
#define XB_XSUB(j)  (1280 + 64 * (j))
#define XB_XGEN(j)  (2304 + 64 * (j))
#define XB_TOP      3328
#define XB_TOPGEN   3392
#define XCD_BAR_WORDS 3456
#define XB_SPIN_CAP (1u << 18)

__device__ __forceinline__ unsigned xb_ld(unsigned* p)              { return __hip_atomic_load(p, __ATOMIC_RELAXED, __HIP_MEMORY_SCOPE_AGENT); }
__device__ __forceinline__ unsigned xb_add(unsigned* p, unsigned v) { return __hip_atomic_fetch_add(p, v, __ATOMIC_RELAXED, __HIP_MEMORY_SCOPE_AGENT); }
__device__ __forceinline__ unsigned xb_xcc_id() { return (unsigned)__builtin_amdgcn_s_getreg((3 << 11) | 20) & 0xFu; }
#define XB_SPIN(cond, bar) do { unsigned _sp = 0; while (cond) { __builtin_amdgcn_s_sleep(1); \
    if ((++_sp & 255u) == 0u) { if (xb_ld(&(bar)[XB_TMO])) break; if (_sp > XB_SPIN_CAP) { atomicAdd(&(bar)[XB_TMO], 1u); break; } } } } while (0)

struct XcdBarrier {
    unsigned* bar; unsigned x;
    volatile LAS unsigned* st;
};

__device__ __forceinline__ XcdBarrier xcd_barrier_post(unsigned* bar, volatile LAS unsigned* st) {
    XcdBarrier b; b.bar = bar; b.x = xb_xcc_id(); b.st = st;
    if (threadIdx.x == 0) (void)xb_add(&bar[XB_XCNT(b.x)], 1u);
    return b;
}
__device__ __forceinline__ void xcd_barrier_complete(unsigned* bar, unsigned x, unsigned& nloc, unsigned& nx) {
    const unsigned G = gridDim.x * gridDim.y * gridDim.z;
    unsigned sum, cnt, mine, sp = 0u;
    for (;;) {
        sum = 0u; cnt = 0u; mine = 0u;
#pragma unroll
        for (unsigned j = 0; j < 16; ++j) { const unsigned c = xb_ld(&bar[XB_XCNT(j)]); sum += c; cnt += (c > 0u) ? 1u : 0u; mine = (j == x) ? c : mine; }
        if (sum == G) break;
        __builtin_amdgcn_s_sleep(1);
        if ((++sp & 255u) == 0u) { if (xb_ld(&bar[XB_TMO])) break; if (sp > XB_SPIN_CAP) { atomicAdd(&bar[XB_TMO], 1u); break; } }
    }
    nloc = mine > 0u ? mine : 1u; nx = cnt > 0u ? cnt : 1u;
}

__device__ __forceinline__ void xcd_barrier(const XcdBarrier& b) {
    asm volatile("s_waitcnt vmcnt(0)" ::: "memory");
    __syncthreads();
    if (threadIdx.x == 0) {
        unsigned* bar = b.bar;
        __builtin_amdgcn_s_waitcnt(0);
        unsigned nloc = b.st[0], nx = b.st[1];
        if (nloc == 0u) { xcd_barrier_complete(bar, b.x, nloc, nx); b.st[0] = nloc; b.st[1] = nx; }
        const unsigned old = xb_add(&bar[XB_XSUB(b.x)], 1u);
        const unsigned gen = old / nloc;
        if (old + 1u == (gen + 1u) * nloc) {
            __builtin_amdgcn_fence(__ATOMIC_RELEASE, "agent");
            asm volatile("s_waitcnt vmcnt(0)" ::: "memory");
            const unsigned og = xb_add(&bar[XB_TOP], 1u);
            const unsigned tg = og / nx;
            if (og + 1u == (tg + 1u) * nx) xb_add(&bar[XB_TOPGEN], 1u);
            else XB_SPIN(xb_ld(&bar[XB_TOPGEN]) == tg, bar);
            __builtin_amdgcn_fence(__ATOMIC_ACQUIRE, "agent");
            xb_add(&bar[XB_XGEN(b.x)], 1u);
            asm volatile("s_waitcnt vmcnt(0)" ::: "memory");
        } else {
            XB_SPIN(xb_ld(&bar[XB_XGEN(b.x)]) == gen, bar);
            __builtin_amdgcn_fence(__ATOMIC_ACQUIRE, "agent");
            asm volatile("s_waitcnt vmcnt(0)" ::: "memory");
        }
    }
    __syncthreads();
}


__global__ void __launch_bounds__(NWAVES * 64, 2) fwd_megakernel(Args args) {
    extern __shared__ __attribute__((aligned(16))) unsigned char lds_raw[];
    LAS unsigned char* lds = (LAS unsigned char*)lds_raw;
    cg::grid_group grid = cg::this_grid();
    const int lo = args.ph_lo, hi = args.ph_hi;
    if (hi < 0) grid.sync();
    unsigned char* ws = args.ws;
    const int z = 0;
    for (int u = threadIdx.x; u < 64; u += NWAVES * 64) ((LAS unsigned*)(lds + 131072))[u] = 0u;
    __syncthreads();
    XcdBarrier bar; bar.bar = (unsigned*)(ws + WS_CTL) + 4096; bar.x = 0; bar.st = nullptr;
    if (hi - lo > 1) bar = xcd_barrier_post((unsigned*)(ws + WS_CTL) + 4096, (volatile LAS unsigned*)(lds + 131072 + 32));
#define IN_PH(k) (lo <= (k) && (k) < hi)
#define SEAM(k) do { if (IN_PH(k) && IN_PH((k) + 1)) xcd_barrier(bar); } while (0)
#define GEMM_PH(k, MODE, SUB, AOFF, BOFF, NN, KK, RP, RS) do { if (IN_PH(k)) { \
        pg8::Gemm g{(const bf16*)(ws + (AOFF)), (const bf16*)(ws + (BOFF)), T, (NN), (KK)}; \
        pg8::StaticOrder S; S.init(T, (NN), (int)gridDim.x, (int)blockIdx.x); \
        Epi<MODE, SUB> E{ws, args.out, (RP), (RS), args.in[16], args.in[20]}; \
        pg8::gemm_phase<Epi<MODE, SUB>, pg8::StaticOrder, true, true>(lds, g, S, E); } SEAM(k); } while (0)
#define GEMM_PHP(k, MODE, SUB, AOFF, BOFF, NN, KK, RP, RS) do { if (IN_PH(k)) { \
        pg8::Gemm g{(const bf16*)(ws + (AOFF)), (const bf16*)(ws + (BOFF)), TP, (NN), (KK)}; \
        pg8::StaticOrder S; S.init(TP, (NN), (int)gridDim.x, (int)blockIdx.x); \
        Epi<MODE, SUB> E{ws, args.out, (RP), (RS), args.in[16], args.in[20]}; \
        pg8::gemm_phase<Epi<MODE, SUB>, pg8::StaticOrder, true, true>(lds, g, S, E); } SEAM(k); } while (0)
#define FFN_IN_PH(k, FI, RP, RS) do { if (IN_PH(k)) { \
        unsigned* cnt = (unsigned*)(ws + WS_CTL) + 16384 + 64 * (FI); \
        { pg8::Gemm g{(const bf16*)(ws + WS_XB), (const bf16*)(ws + WS_WFI + (FI) * SZ_WFI), T, NFI, D}; \
          CapOrder S{(int)blockIdx.x, cnt}; Epi<0, 0> E{ws, args.out, XR, XRS, args.in[16], args.in[20]}; \
          pg8::gemm_phase<Epi<0, 0>, CapOrder, true, true>(lds, g, S, E); } \
        if (blockIdx.x >= 248) { wait_count(cnt, 44u * 8u); \
          pg8::Gemm g2{(const bf16*)(ws + WS_ACT), (const bf16*)(ws + WS_WFO + (FI) * SZ_WFO), T, D, DFF}; \
          OneUnit S2{64 + ((int)blockIdx.x - 248) / 4, ((int)blockIdx.x - 248) % 4}; Epi<1, 0> E2{ws, args.out, (RP), (RS), args.in[16], args.in[20]}; \
          pg8::gemm_phase<Epi<1, 0>, OneUnit, true, true>(lds, g2, S2, E2); } \
        } SEAM(k); } while (0)
#define FFN_OUT_PH(k, FO, RP, RS) do { if (IN_PH(k)) { \
        pg8::Gemm g{(const bf16*)(ws + WS_ACT), (const bf16*)(ws + WS_WFO + (FO) * SZ_WFO), TP, D, DFF}; \
        pg8::StaticOrder S; S.init(TP, D, (int)gridDim.x, (int)blockIdx.x); \
        Epi<1, 0> E{ws, args.out, (RP), (RS), args.in[16], args.in[20]}; \
        pg8::gemm_phase<Epi<1, 0>, pg8::StaticOrder, true, true>(lds, g, S, E); } SEAM(k); } while (0)
    float* const XR = args.out; float* const XRS = args.out + (size_t)TP * D;
    if (IN_PH(PH_PREP)) phase_prep(args, z, lds);
    SEAM(PH_PREP);
    FFN_IN_PH(PH_L0F1I, 0, args.in[0], args.in[1]);
    FFN_OUT_PH(PH_L0F1O, 0, args.in[0], args.in[1]);
    GEMM_PH(PH_ABI, 2, 0, WS_XB, WS_WAI, NAB_PAD, D, XR, XRS);
    if (IN_PH(PH_MIX0)) { phase_mix_pre0(args, z, lds); if (hi - lo > 1) xcd_barrier(bar); phase_mix0(args, z, lds); }
    SEAM(PH_MIX0);
    if (IN_PH(PH_POST0)) phase_post<0>(args, z, lds, (unsigned*)(ws + WS_CTL) + 16384 + 64 * 8);
    SEAM(PH_POST0);
    GEMM_PHP(PH_ABO, 1, 1, WS_OG, WS_WAO, D, D, XR, XRS);
    FFN_IN_PH(PH_L0F2I, 1, XR, XRS);
    FFN_OUT_PH(PH_L0F2O, 1, XR, XRS);
    FFN_IN_PH(PH_L1F1I, 2, XR, XRS);
    FFN_OUT_PH(PH_L1F1O, 2, XR, XRS);
    GEMM_PH(PH_GLI, 2, 1, WS_XB, WS_WGI, NGL_PAD, D, XR, XRS);
    if (IN_PH(PH_MIX1)) { phase_mix_pre1(args, z, lds); if (hi - lo > 1) xcd_barrier(bar); phase_mix1(args, z, lds); }
    SEAM(PH_MIX1);
    if (IN_PH(PH_POST1)) phase_post<1>(args, z, lds, (unsigned*)(ws + WS_CTL) + 16384 + 64 * 9);
    SEAM(PH_POST1);
    GEMM_PHP(PH_GLO, 1, 1, WS_OG, WS_WGO, D, D, XR, XRS);
    FFN_IN_PH(PH_L1F2I, 3, XR, XRS);
    if (IN_PH(PH_L1F2O)) {
        pg8::Gemm g{(const bf16*)(ws + WS_ACT), (const bf16*)(ws + WS_WFO + 3 * SZ_WFO), TP, D, DFF};
        pg8::StaticOrder S; S.init(TP, D, (int)gridDim.x, (int)blockIdx.x);
        Epi<1, 2> E{ws, args.out, XR, XRS, args.in[16], args.in[20]};
        pg8::gemm_phase<Epi<1, 2>, pg8::StaticOrder, true, true>(lds, g, S, E); }
    SEAM(PH_L1F2O);
    if (IN_PH(PH_FINAL)) phase_final(args, z);
}

#ifndef ONE_LAUNCH
#define ONE_LAUNCH 1
#endif
extern "C" void kernel_launch(void* const* d_in, const int* in_sizes, int n_in, void* d_out, int out_size, void* d_ws, size_t ws_size, hipStream_t stream) {
    static int grid = 0;
    if (grid == 0) {
        if (n_in != 29 || ws_size < WS_NEED) { fprintf(stderr, "kernel_launch: n_in %d ws %zu (need %zu)\n", n_in, ws_size, (size_t)WS_END); grid = -1; return; }
        int dev = 0, cus = 0, per_cu = 0;
        hipGetDevice(&dev); hipDeviceGetAttribute(&cus, hipDeviceAttributeMultiprocessorCount, dev);
        hipFuncSetAttribute((const void*)fwd_megakernel, hipFuncAttributeMaxDynamicSharedMemorySize, LDS_BYTES);
        if (hipOccupancyMaxActiveBlocksPerMultiprocessor(&per_cu, (const void*)fwd_megakernel, NWAVES * 64, LDS_BYTES) != hipSuccess || per_cu < 1) { fprintf(stderr, "occupancy query failed/0\n"); per_cu = 1; }
        (void)hipGetLastError();
        grid = cus;
        if (grid != 256) { fprintf(stderr, "kernel_launch: built for a 256-CU device, found %d\n", cus); grid = -1; return; }
    }
    if (grid < 0) return;
    Args a{};
    for (int i = 0; i < 29; ++i) a.in[i] = (const float*)d_in[i];
    a.out = (float*)d_out; a.ws = (unsigned char*)d_ws;
    if (hipMemsetAsync((char*)d_ws + WS_CTL, 0, 131072, stream) != hipSuccess) { fprintf(stderr, "memset failed\n"); return; }
#if ONE_LAUNCH
    a.ph_lo = 0; a.ph_hi = N_PH;
    void* kargs[] = {&a};
    hipError_t e = hipLaunchCooperativeKernel((const void*)fwd_megakernel, dim3(grid), dim3(NWAVES * 64), kargs, LDS_BYTES, stream);
    if (e != hipSuccess) fprintf(stderr, "cooperative launch failed: %s\n", hipGetErrorString(e));
#else
    for (int ph = 0; ph < N_PH; ++ph) { a.ph_lo = ph; a.ph_hi = ph + 1; hipLaunchKernelGGL(fwd_megakernel, dim3(grid), dim3(NWAVES * 64), LDS_BYTES, stream, a); }
#endif
}
```

```cpp
#include <hip/hip_runtime.h>
#include <hip/hip_cooperative_groups.h>
#include <cstdio>
#include <cstdint>
namespace cg = cooperative_groups;
namespace pg8 {
#define PG8_LAS __attribute__((address_space(3)))
typedef unsigned short bf16_t;
typedef short bf16x8 __attribute__((ext_vector_type(8)));
typedef float f32x4 __attribute__((ext_vector_type(4)));
typedef unsigned u32x4 __attribute__((ext_vector_type(4)));
constexpr int BM = 256, BK = 64, HALF = 128, HTB = HALF * BK * 2  , STAGE_BYTES = 8 * HTB, NXCD = 8, WGM = 8;

__host__ __device__ __forceinline__ int lds_byte(int r, int c) { const int st = (r >> 4) * 2 + (c >> 5), rr = r & 15, cc = c & 31, ob = rr * 64 + cc * 2; return st * 1024 + (ob ^ (((ob >> 9) & 1) << 5)); }
__host__ __device__ __forceinline__ void stage_rc(int b, int& R, int& C) { const int st = b / 1024, sb = b % 1024, swz = sb ^ (((sb >> 9) & 1) << 5); R = (st >> 1) * 16 + swz / 64; C = (st & 1) * 32 + (swz % 64) / 2; }
__host__ __device__ __forceinline__ int perm32(int rho) { const int n = rho >> 4, i = rho & 15; return 8 * (i >> 2) + 4 * n + (i & 3); }

struct Unit { int pm, pn; };
struct Gemm { const bf16_t* A; const bf16_t* Bt; int M, N, K; };

struct StaticOrder {
    int nM, nN, nwg, G, c;
    __host__ __device__ void init(int M, int N, int G_, int c_) { nM = M / BM; nN = N / BM; nwg = nM * nN; G = G_; c = c_; }
    __host__ __device__ bool next(int i, Unit& u) const {
        const long L = (long)i * G + c; if (L >= nwg) return false;
        int wgid = (int)L; { const int q = nwg / NXCD, r = nwg % NXCD, xcd = wgid % NXCD, off = wgid / NXCD; wgid = (xcd < r ? xcd * (q + 1) : r * (q + 1) + (xcd - r) * q) + off; }
        const int nig = WGM * nN, gid = wgid / nig, fm = gid * WGM, gsz = (nM - fm) < WGM ? (nM - fm) : WGM;
        u.pm = fm + ((wgid % nig) % gsz); u.pn = (wgid % nig) / gsz; return true;
    }
    __device__ __forceinline__ void a_ready(const Unit&) const {}
    __device__ __forceinline__ void done(const Unit&) const {}
};

__device__ __forceinline__ unsigned cvt_pk_bf16(float lo, float hi) { unsigned r; asm volatile("v_cvt_pk_bf16_f32 %0, %1, %2" : "=v"(r) : "v"(lo), "v"(hi)); return r; }
template <class Epi, class Sched, bool ALIGN_EPI = false, bool SP2 = false>
__device__ __forceinline__ void gemm_phase(PG8_LAS unsigned char* lds, const Gemm g, const Sched& S, const Epi& E) {
    const int tid = threadIdx.x, wid = __builtin_amdgcn_readfirstlane(tid >> 6), lane = tid & 63, wr = wid >> 2, wc = wid & 3, fr = lane & 15, fq = lane >> 4;
    const int K = g.K, nt = K / BK;
    unsigned voffA[2], voffB[2];
#pragma unroll
    for (int i = 0; i < 2; ++i) { int R, C; stage_rc(tid * 16 + i * 8192, R, C); const int Rb = Epi::PERM ? ((R & ~31) + perm32(R & 31)) : R;
        voffA[i] = (unsigned)(R * K + C) * 2u; voffB[i] = (unsigned)(Rb * K + C) * 2u; }
    const size_t kstep = (size_t)(BK * 2);
    const size_t hstep = (size_t)HALF * K * 2;
    const size_t tstep = 2 * hstep;
    const unsigned ldsw = (unsigned)wid * 1024u;
    const int aoff = lds_byte(wr * 64 + fr, fq * 8), boff = lds_byte(wc * 32 + fr, fq * 8);
#define PG8_SA(b, h) (((b) * 2 + (h)) * HTB)
#define PG8_SB(b, h) ((4 + (b) * 2 + (h)) * HTB)
#define PG8_STAGE(bufoff, gbase, voff) do { _Pragma("unroll") for (int _i = 0; _i < 2; ++_i) \
        __builtin_amdgcn_global_load_lds((const unsigned*)((const char*)(gbase) + (voff)[_i]), (PG8_LAS unsigned*)(lds + (bufoff) + ldsw + _i * 8192), 16, 0, 0); } while (0)
#define PG8_LDA(dst, b, h) do { _Pragma("unroll") for (int m = 0; m < 4; ++m) _Pragma("unroll") for (int k = 0; k < 2; ++k) dst[m][k] = *(const PG8_LAS bf16x8*)(lds + PG8_SA(b, h) + aoff + m * 2048 + k * 1024); } while (0)
#define PG8_LDB(dst, b, h) do { _Pragma("unroll") for (int n = 0; n < 2; ++n) _Pragma("unroll") for (int k = 0; k < 2; ++k) dst[n][k] = *(const PG8_LAS bf16x8*)(lds + PG8_SB(b, h) + boff + n * 2048 + k * 1024); } while (0)
#define PG8_MMA(ai, bj, At, Bt) do { __builtin_amdgcn_s_setprio(1); _Pragma("unroll") for (int m = 0; m < 4; ++m) _Pragma("unroll") for (int n = 0; n < 2; ++n) _Pragma("unroll") for (int k = 0; k < 2; ++k) \
        acc[ai][bj][m][n] = __builtin_amdgcn_mfma_f32_16x16x32_bf16(Bt[n][k], At[m][k], acc[ai][bj][m][n], 0, 0, 0); __builtin_amdgcn_s_setprio(0); } while (0)
#define PG8_WAIT_V(n) asm volatile("s_waitcnt vmcnt(" #n ")" ::: "memory")
#define PG8_WAIT_L(n) asm volatile("s_waitcnt lgkmcnt(" #n ")" ::: "memory")
#define PG8_BAR __builtin_amdgcn_s_barrier()
#define PG8_SCHED __builtin_amdgcn_sched_barrier(0)
    Unit cur, nxt; int ui = 0;
    if (!S.next(0, cur)) return;
    f32x4 acc[2][2][4][2];
#pragma unroll
    for (int a = 0; a < 2; ++a)
#pragma unroll
        for (int b = 0; b < 2; ++b)
#pragma unroll
            for (int m = 0; m < 4; ++m)
#pragma unroll
                for (int n = 0; n < 2; ++n) acc[a][b][m][n] = (f32x4){0.f, 0.f, 0.f, 0.f};
    bf16x8 At[4][2], B0[2][2], B1[2][2];
    const char* cA = (const char*)g.A + (size_t)cur.pm * tstep; const char* cB = (const char*)g.Bt + (size_t)cur.pn * tstep;
    S.a_ready(cur);
    if constexpr (SP2) {
        PG8_STAGE(PG8_SB(0, 0), cB, voffB); PG8_STAGE(PG8_SB(0, 1), cB + hstep, voffB); PG8_STAGE(PG8_SA(0, 0), cA, voffA); PG8_STAGE(PG8_SA(0, 1), cA + hstep, voffA);
        if (wr == 1) PG8_BAR;
        PG8_WAIT_V(2); PG8_BAR;
        PG8_STAGE(PG8_SB(1, 0), cB + kstep, voffB); PG8_STAGE(PG8_SA(1, 0), cA + kstep, voffA); PG8_STAGE(PG8_SB(1, 1), cB + hstep + kstep, voffB);
        PG8_WAIT_V(6); PG8_BAR;
    } else {
        PG8_STAGE(PG8_SB(0, 0), cB, voffB); PG8_STAGE(PG8_SA(0, 0), cA, voffA); PG8_STAGE(PG8_SB(0, 1), cB + hstep, voffB); PG8_STAGE(PG8_SA(0, 1), cA + hstep, voffA);
        if (wr == 1) PG8_BAR;
        PG8_WAIT_V(4); PG8_BAR;
        PG8_STAGE(PG8_SB(1, 0), cB + kstep, voffB); PG8_STAGE(PG8_SA(1, 0), cA + kstep, voffA); PG8_STAGE(PG8_SB(1, 1), cB + hstep + kstep, voffB);
        PG8_WAIT_V(6); PG8_BAR;
    }
    for (;;) {
        const bool has_next = S.next(ui + 1, nxt);
        const char* nA = has_next ? (const char*)g.A + (size_t)nxt.pm * tstep : cA; const char* nB = has_next ? (const char*)g.Bt + (size_t)nxt.pn * tstep : cB;
        for (int t = 0; t < nt; t += 2) {
            const bool last = (t == nt - 2);
            const char* a1 = cA + (size_t)(t + 1) * kstep;
            const char* a2 = last ? nA : cA + (size_t)(t + 2) * kstep; const char* b2 = last ? nB : cB + (size_t)(t + 2) * kstep;
            const char* a3 = a2 + kstep; const char* b3 = b2 + kstep;
            if (last && has_next) S.a_ready(nxt);
            if constexpr (SP2) {
            PG8_LDB(B0, 0, 0); PG8_LDB(B1, 0, 1); PG8_SCHED; PG8_LDA(At, 0, 0); PG8_STAGE(PG8_SA(1, 1), a1 + hstep, voffA);
            PG8_WAIT_V(8); PG8_WAIT_L(0); PG8_BAR; PG8_MMA(0, 0, At, B0); PG8_MMA(0, 1, At, B1); PG8_BAR; PG8_SCHED;
            PG8_LDA(At, 0, 1); PG8_STAGE(PG8_SB(0, 0), b2, voffB); PG8_STAGE(PG8_SB(0, 1), b2 + hstep, voffB); PG8_STAGE(PG8_SA(0, 0), a2, voffA);
            PG8_WAIT_V(8); PG8_WAIT_L(0); PG8_BAR; PG8_MMA(1, 0, At, B0); PG8_MMA(1, 1, At, B1); PG8_BAR; PG8_SCHED;
            PG8_LDB(B0, 1, 0); PG8_LDB(B1, 1, 1); PG8_SCHED; PG8_LDA(At, 1, 0); PG8_STAGE(PG8_SA(0, 1), a2 + hstep, voffA);
            PG8_WAIT_V(8); PG8_WAIT_L(0); PG8_BAR; PG8_MMA(0, 0, At, B0); PG8_MMA(0, 1, At, B1); PG8_BAR; PG8_SCHED;
            PG8_LDA(At, 1, 1); PG8_STAGE(PG8_SB(1, 0), b3, voffB); PG8_STAGE(PG8_SB(1, 1), b3 + hstep, voffB); PG8_STAGE(PG8_SA(1, 0), a3, voffA);
            PG8_WAIT_V(8); PG8_WAIT_L(0); PG8_BAR; PG8_MMA(1, 0, At, B0); PG8_MMA(1, 1, At, B1); PG8_BAR; PG8_SCHED;
            } else {
            PG8_LDB(B0, 0, 0); PG8_SCHED; PG8_LDA(At, 0, 0); PG8_STAGE(PG8_SA(1, 1), a1 + hstep, voffA);
            PG8_WAIT_L(8); PG8_BAR; PG8_WAIT_L(0); PG8_MMA(0, 0, At, B0); PG8_BAR; PG8_SCHED;
            PG8_LDB(B1, 0, 1); PG8_STAGE(PG8_SB(0, 0), b2, voffB);
            PG8_BAR; PG8_WAIT_L(0); PG8_MMA(0, 1, At, B1); PG8_BAR;
            PG8_LDA(At, 0, 1); PG8_STAGE(PG8_SA(0, 0), a2, voffA);
            PG8_BAR; PG8_WAIT_L(0); PG8_MMA(1, 0, At, B0); PG8_BAR; PG8_SCHED;
            PG8_STAGE(PG8_SB(0, 1), b2 + hstep, voffB);
            PG8_WAIT_V(6); PG8_BAR; PG8_MMA(1, 1, At, B1); PG8_BAR;
            PG8_LDB(B0, 1, 0); PG8_SCHED; PG8_LDA(At, 1, 0); PG8_STAGE(PG8_SA(0, 1), a2 + hstep, voffA);
            PG8_WAIT_L(8); PG8_BAR; PG8_WAIT_L(0); PG8_MMA(0, 0, At, B0); PG8_BAR; PG8_SCHED;
            PG8_LDB(B1, 1, 1); PG8_STAGE(PG8_SB(1, 0), b3, voffB);
            PG8_BAR; PG8_WAIT_L(0); PG8_MMA(0, 1, At, B1); PG8_BAR;
            PG8_LDA(At, 1, 1); PG8_STAGE(PG8_SA(1, 0), a3, voffA);
            PG8_BAR; PG8_WAIT_L(0); PG8_MMA(1, 0, At, B0); PG8_BAR; PG8_SCHED;
            PG8_STAGE(PG8_SB(1, 1), b3 + hstep, voffB);
            PG8_WAIT_V(6); PG8_BAR; PG8_MMA(1, 1, At, B1); PG8_BAR;
            }
        }
        if constexpr (ALIGN_EPI) { if (wr == 0) PG8_BAR; }
        if constexpr (!Epi::AFTER_DRAIN) { E(acc, cur, wr, wc, fr, fq); S.done(cur); }
        if (!has_next) break;
#pragma unroll
        for (int a = 0; a < 2; ++a)
#pragma unroll
            for (int b = 0; b < 2; ++b)
#pragma unroll
                for (int m = 0; m < 4; ++m)
#pragma unroll
                    for (int n = 0; n < 2; ++n) acc[a][b][m][n] = (f32x4){0.f, 0.f, 0.f, 0.f};
        cur = nxt; cA = nA; cB = nB; ++ui;
        if constexpr (ALIGN_EPI) { if (wr == 1) PG8_BAR; }
    }
    PG8_WAIT_V(0);
    if constexpr (!ALIGN_EPI) { if (wr == 0) PG8_BAR; }
    PG8_BAR;
    if constexpr (Epi::AFTER_DRAIN) { E.fused(acc, cur, wr, wc, fr, fq, lds, wid, lane); S.done(cur); }
#undef PG8_SA
#undef PG8_SB
#undef PG8_STAGE
#undef PG8_LDA
#undef PG8_LDB
#undef PG8_MMA
#undef PG8_WAIT_V
#undef PG8_WAIT_L
#undef PG8_BAR
#undef PG8_SCHED
}
}

#define LAS __attribute__((address_space(3)))
typedef unsigned short bf16;
typedef unsigned v4u __attribute__((ext_vector_type(4)));
typedef unsigned v2u __attribute__((ext_vector_type(2)));
typedef float f32x4 __attribute__((ext_vector_type(4)));

constexpr int T = 16896, TP = 16384, D = 1024, DFF = 2816, NFI = 5632;
constexpr int NAB = 3592, NAB_PAD = 3840, PA = 3584;
constexpr int NGL = 3088, NGL_PAD = 3328, PG = 3072;
constexpr float EPS = 1e-6f;
constexpr int NWAVES = 8;
constexpr int LDS_BYTES = 147456;

constexpr size_t O_HP = 17301504, O_HS = 17825792, O_SP = 26214400, O_SS = 26738688, O_CP = 35127296, O_CS = 35151872, O_GP = 35545088, O_GS = 36593664;

constexpr size_t MiB = 1u << 20;
constexpr size_t SZ_WFI = (size_t)NFI * D * 2, SZ_WFO = (size_t)D * DFF * 2;
constexpr size_t WS_CTL = 0;
constexpr size_t WS_WFI = 1 * MiB;
constexpr size_t WS_WFO = WS_WFI + 4 * SZ_WFI;
constexpr size_t WS_WAI = WS_WFO + 4 * SZ_WFO;
constexpr size_t WS_WAO = WS_WAI + (size_t)NAB_PAD * D * 2;
constexpr size_t WS_WGI = WS_WAO + (size_t)D * D * 2;
constexpr size_t WS_WGO = WS_WGI + (size_t)NGL_PAD * D * 2;
constexpr size_t WS_XB  = WS_WGO + (size_t)D * D * 2;
constexpr size_t WS_SSQ = WS_XB + (size_t)T * D * 2;
constexpr size_t WS_BIG = WS_SSQ + (size_t)T * 16 * 4;
constexpr size_t WS_ACT = WS_BIG;
constexpr size_t WS_PROJ = WS_BIG;
constexpr size_t WS_LF = WS_PROJ + (size_t)T * PA * 2;
constexpr size_t WS_DT = WS_LF + (size_t)T * 512 * 4;
constexpr size_t WS_GK = WS_DT + (size_t)T * 8 * 4;
constexpr size_t WS_OG = WS_GK + (size_t)T * 16 * 4;
constexpr size_t WS_END = WS_OG + (size_t)T * D * 2;

enum { PH_PREP = 0, PH_L0F1I, PH_L0F1O, PH_ABI, PH_MIX0, PH_POST0, PH_ABO, PH_L0F2I, PH_L0F2O,
       PH_L1F1I, PH_L1F1O, PH_GLI, PH_MIX1, PH_POST1, PH_GLO, PH_L1F2I, PH_L1F2O, PH_FINAL, N_PH };

struct Args { const float* in[29]; float* out; unsigned char* ws; int ph_lo, ph_hi; };

__device__ __forceinline__ float bf2f(bf16 b) { return __uint_as_float(((unsigned)b) << 16); }
typedef float f32x2_t __attribute__((ext_vector_type(2))); typedef __bf16 bf16x2_t __attribute__((ext_vector_type(2)));
__device__ __forceinline__ unsigned pk2(float lo, float hi) { const bf16x2_t v = __builtin_convertvector((f32x2_t){lo, hi}, bf16x2_t); return __builtin_bit_cast(unsigned, v); }
__device__ __forceinline__ f32x2_t silu_mul_pk(f32x2_t g, f32x2_t u) {
    const f32x2_t t = g * (-1.4426950408889634f);
    f32x2_t e; e.x = __builtin_amdgcn_exp2f(t.x); e.y = __builtin_amdgcn_exp2f(t.y);
    const f32x2_t d = e + 1.0f;
    f32x2_t r; r.x = __builtin_amdgcn_rcpf(d.x); r.y = __builtin_amdgcn_rcpf(d.y);
    return (g * r) * u;
}
__device__ __forceinline__ unsigned pk2v(f32x2_t v) { const bf16x2_t b = __builtin_convertvector(v, bf16x2_t); return __builtin_bit_cast(unsigned, b); }
__device__ __forceinline__ float silu_f(float x) { return x * __builtin_amdgcn_rcpf(1.f + __expf(-x)); }
__device__ __forceinline__ float sigmoid_f(float x) { return __builtin_amdgcn_rcpf(1.f + __expf(-x)); }
__device__ __forceinline__ float softplus_f(float x) { return fmaxf(x, 0.f) + log1pf(__expf(-fabsf(x))); }
__device__ __forceinline__ float wave_sum(float v) {
#pragma unroll
    for (int o = 1; o < 64; o <<= 1) v += __shfl_xor(v, o);
    return v;
}
#define LDS_WAIT() asm volatile("s_waitcnt lgkmcnt(0)" ::: "memory")

enum { ACT_NONE = 0, ACT_RAW, ACT_SILU, ACT_QSCALE, ACT_FGATE, ACT_DT, ACT_GK };
constexpr unsigned long long ACTS_AB = 0x2ull | (0x2ull << 4) | (0x4ull << 8) | (0x4ull << 12) | (0x1ull << 16) | (0x1ull << 20) | (0x2ull << 24) | (0x2ull << 28) | (0x2ull << 32) | (0x2ull << 36)
               | (0x1ull << 40) | (0x1ull << 44) | (0x1ull << 48) | (0x1ull << 52) | (0x5ull << 56);
constexpr unsigned long long ACTS_GL = 0x3ull | (0x3ull << 4) | (0x1ull << 8) | (0x1ull << 12) | (0x1ull << 16) | (0x1ull << 20) | (0x1ull << 24) | (0x1ull << 28) | (0x2ull << 32) | (0x2ull << 36)
               | (0x2ull << 40) | (0x2ull << 44) | (0x6ull << 48);
template <int mode  ,
          int sub   >
struct Epi {
    static constexpr bool PERM = true, AFTER_DRAIN = false;
    unsigned char* ws; float* out;
    const float* res_p; const float* res_s;
    const float* lbl; const float* dtb;
    mutable int cpm = -1; mutable float crs[2][4] = {{0.f, 0.f, 0.f, 0.f}, {0.f, 0.f, 0.f, 0.f}};
    __device__ __forceinline__ void operator()(const pg8::f32x4 (&acc)[2][2][4][2], const pg8::Unit& u, int wr, int wc, int fr, int fq) const {
        const int rbase = u.pm * 256 + wr * 64 + fr;
        const int cl = wc * 32 + 8 * fq;
        const float* ssq_in = (const float*)(ws + WS_SSQ);
        bf16* obf = (bf16*)(ws + WS_BIG);
        if (mode == 1) {
            float* xr = out; bf16* xb = (bf16*)(ws + WS_XB); float* ssq_out = (float*)(ws + WS_SSQ);
            const float scale = (sub == 1) ? 1.f : 0.5f;
            const int c00 = u.pn * 256 + cl;
            f32x4 rb[2][4];
            {
                const int row = rbase;
                const float* rp = (row < TP) ? res_p + (size_t)row * D : res_s + (size_t)(row - TP) * D;
                rb[0][0] = *(const f32x4*)(rp + c00); rb[0][1] = *(const f32x4*)(rp + c00 + 4); rb[0][2] = *(const f32x4*)(rp + c00 + 128); rb[0][3] = *(const f32x4*)(rp + c00 + 132);
            }
#pragma unroll
            for (int gi = 0; gi < 8; ++gi) {
                const int ai = gi >> 2, m = gi & 3;
                const int row = rbase + ai * 128 + m * 16;
                if (gi + 1 < 8) {
                    const int rown = rbase + ((gi + 1) >> 2) * 128 + ((gi + 1) & 3) * 16;
                    const float* rp = (rown < TP) ? res_p + (size_t)rown * D : res_s + (size_t)(rown - TP) * D;
                    rb[(gi + 1) & 1][0] = *(const f32x4*)(rp + c00); rb[(gi + 1) & 1][1] = *(const f32x4*)(rp + c00 + 4);
                    rb[(gi + 1) & 1][2] = *(const f32x4*)(rp + c00 + 128); rb[(gi + 1) & 1][3] = *(const f32x4*)(rp + c00 + 132);
                }
                float ss = 0.f;
#pragma unroll
                for (int bj = 0; bj < 2; ++bj) {
                    const int c0 = c00 + bj * 128;
                    const f32x4 x0 = rb[gi & 1][2 * bj] + acc[ai][bj][m][0] * scale, x1 = rb[gi & 1][2 * bj + 1] + acc[ai][bj][m][1] * scale;
                    *(f32x4*)(xr + (size_t)row * D + c0) = x0; *(f32x4*)(xr + (size_t)row * D + c0 + 4) = x1;
                    if (sub != 2) {
                        v4u w; w.x = pk2(x0[0], x0[1]); w.y = pk2(x0[2], x0[3]); w.z = pk2(x1[0], x1[1]); w.w = pk2(x1[2], x1[3]);
                        *(v4u*)(xb + (size_t)row * D + c0) = w; }
                    ss += (x0[0] * x0[0] + x0[1] * x0[1]) + (x0[2] * x0[2] + x0[3] * x0[3]) + (x1[0] * x1[0] + x1[1] * x1[1]) + (x1[2] * x1[2] + x1[3] * x1[3]);
                }
                ss += __shfl_xor(ss, 16); ss += __shfl_xor(ss, 32);
                if (fq == 0) ssq_out[(size_t)row * 16 + u.pn * 4 + wc] = ss;
                asm volatile("" ::: "memory");
            }
            return;
        }
        if (u.pm != cpm) {
            cpm = u.pm;
#pragma unroll
            for (int ai = 0; ai < 2; ++ai)
#pragma unroll
                for (int m = 0; m < 4; ++m) {
                    const int row = rbase + ai * 128 + m * 16;
                    const f32x4 p = *(const f32x4*)(ssq_in + (size_t)row * 16 + 4 * fq);
                    float s = (p[0] + p[1]) + (p[2] + p[3]); s += __shfl_xor(s, 16); s += __shfl_xor(s, 32);
                    crs[ai][m] = rsqrtf(s * (1.f / 1024.f) + EPS);
                }
        }
        float rstd[2][4];
#pragma unroll
        for (int ai = 0; ai < 2; ++ai)
#pragma unroll
            for (int m = 0; m < 4; ++m) rstd[ai][m] = crs[ai][m];
        if (mode == 0) {
            const int hc = u.pn * 128 + cl;
#pragma unroll
            for (int ai = 0; ai < 2; ++ai)
#pragma unroll
                for (int m = 0; m < 4; ++m) {
                    const int row = rbase + ai * 128 + m * 16; const float rs = rstd[ai][m];
                    const f32x4 g0 = acc[ai][0][m][0] * rs, g1 = acc[ai][0][m][1] * rs, u0 = acc[ai][1][m][0] * rs, u1 = acc[ai][1][m][1] * rs;
                    v4u w;
                    w.x = pk2v(silu_mul_pk((f32x2_t){g0[0], g0[1]}, (f32x2_t){u0[0], u0[1]})); w.y = pk2v(silu_mul_pk((f32x2_t){g0[2], g0[3]}, (f32x2_t){u0[2], u0[3]}));
                    w.z = pk2v(silu_mul_pk((f32x2_t){g1[0], g1[1]}, (f32x2_t){u1[0], u1[1]})); w.w = pk2v(silu_mul_pk((f32x2_t){g1[2], g1[3]}, (f32x2_t){u1[2], u1[3]}));
                    if (u.pm >= 64) {
                        unsigned long long* p8 = (unsigned long long*)(obf + (size_t)row * DFF + hc);
                        __hip_atomic_store(p8, (unsigned long long)w.x | ((unsigned long long)w.y << 32), __ATOMIC_RELAXED, __HIP_MEMORY_SCOPE_AGENT);
                        __hip_atomic_store(p8 + 1, (unsigned long long)w.z | ((unsigned long long)w.w << 32), __ATOMIC_RELAXED, __HIP_MEMORY_SCOPE_AGENT);
                    } else *(v4u*)(obf + (size_t)row * DFF + hc) = w;
                    asm volatile("" ::: "memory");
                }
            return;
        }
        const unsigned long long acts = sub ? ACTS_GL : ACTS_AB;
        const int ldo = sub ? PG : PA;
        const int code = (int)((acts >> (4 * u.pn)) & 15ull);
        if (code == ACT_NONE) return;
        if (code == ACT_DT) {
            if (cl == 0) {
                float* aux = (float*)(ws + WS_DT);
#pragma unroll
                for (int ai = 0; ai < 2; ++ai)
#pragma unroll
                    for (int m = 0; m < 4; ++m) {
                        const int row = rbase + ai * 128 + m * 16; const float rs = rstd[ai][m];
                        const f32x4 a0 = acc[ai][0][m][0] * rs, a1 = acc[ai][0][m][1] * rs; f32x4 d0, d1;
#pragma unroll
                        for (int j = 0; j < 4; ++j) { d0[j] = softplus_f(a0[j] + dtb[j]); d1[j] = softplus_f(a1[j] + dtb[4 + j]); }
                        *(f32x4*)(aux + (size_t)row * 8) = d0; *(f32x4*)(aux + (size_t)row * 8 + 4) = d1;
                    }
            }
            return;
        }
        if (code == ACT_GK) {
            if (cl < 16) {
                float* aux = (float*)(ws + WS_GK);
#pragma unroll
                for (int ai = 0; ai < 2; ++ai)
#pragma unroll
                    for (int m = 0; m < 4; ++m) {
                        const int row = rbase + ai * 128 + m * 16; const float rs = rstd[ai][m];
                        *(f32x4*)(aux + (size_t)row * 16 + cl) = acc[ai][0][m][0] * rs; *(f32x4*)(aux + (size_t)row * 16 + cl + 4) = acc[ai][0][m][1] * rs;
                    }
            }
            return;
        }
#pragma unroll
        for (int bj = 0; bj < 2; ++bj) {
            const int c0 = u.pn * 256 + bj * 128 + cl;
            float lbv[8];
            if (code == ACT_FGATE) {
#pragma unroll
                for (int j = 0; j < 8; ++j) { const float l0 = lbl[c0 - 512 + j], l1 = lbl[c0 + j]; lbv[j] = __builtin_amdgcn_rcpf(1.f + __expf(l1 - l0)); }
            }
#pragma unroll
            for (int ai = 0; ai < 2; ++ai)
#pragma unroll
                for (int m = 0; m < 4; ++m) {
                    const int row = rbase + ai * 128 + m * 16; const float rs = rstd[ai][m];
                    const f32x4 a0 = acc[ai][bj][m][0] * rs, a1 = acc[ai][bj][m][1] * rs;
                    float v[8] = {a0[0], a0[1], a0[2], a0[3], a1[0], a1[1], a1[2], a1[3]};
                    if (code == ACT_SILU) {
#pragma unroll
                        for (int j = 0; j < 8; ++j) v[j] = silu_f(v[j]);
                    } else if (code == ACT_QSCALE) {
#pragma unroll
                        for (int j = 0; j < 8; ++j) v[j] *= 0.08838834764831845f;
                    } else if (code == ACT_FGATE) {
                        float* lf = (float*)(ws + WS_LF);
                        f32x4 l0, l1;
#pragma unroll
                        for (int j = 0; j < 8; ++j) {
                            const float f = lbv[j] + (1.f - lbv[j]) * sigmoid_f(v[j]);
                            const float lg = __logf(f);
                            if (j < 4) l0[j] = lg; else l1[j - 4] = lg;
                            v[j] = 1.f - f;
                        }
                        *(f32x4*)(lf + (size_t)row * 512 + (c0 - 512)) = l0; *(f32x4*)(lf + (size_t)row * 512 + (c0 - 512) + 4) = l1;
                    }
                    if (code != ACT_FGATE) {
                        v4u w; w.x = pk2(v[0], v[1]); w.y = pk2(v[2], v[3]); w.z = pk2(v[4], v[5]); w.w = pk2(v[6], v[7]);
                        *(v4u*)(obf + (size_t)row * ldo + c0) = w; }
                    asm volatile("" ::: "memory");
                }
        }
    }
};

__device__ __forceinline__ void transpose_item(const float* __restrict__ W, int K, int N, bf16* __restrict__ WT, const float* __restrict__ scale, int mapmode,
                                               int item, int nblk, LAS float* scr, int lane) {
    const int kb = item / nblk, nb = item - kb * nblk, k0 = 64 * kb, n0 = 32 * nb;
    const int kr = lane >> 3, c4 = lane & 7;
    const bool ok = (n0 + 4 * c4) < N;
    f32x4 v[8];
#pragma unroll
    for (int i = 0; i < 8; ++i) v[i] = ok ? __builtin_nontemporal_load((const f32x4*)(W + (size_t)(k0 + kr + 8 * i) * N + n0 + 4 * c4)) : (f32x4){0.f, 0.f, 0.f, 0.f};
    if (scale) {
#pragma unroll
        for (int i = 0; i < 8; ++i) v[i] = v[i] * scale[k0 + kr + 8 * i];
    }
#pragma unroll
    for (int i = 0; i < 8; ++i) { LAS float* sp = scr + (kr + 8 * i) * 33 + 4 * c4; sp[0] = v[i][0]; sp[1] = v[i][1]; sp[2] = v[i][2]; sp[3] = v[i][3]; }
    LDS_WAIT(); asm volatile("" ::: "memory");
    int drow0 = n0;
    if (mapmode == 1) drow0 = (n0 < DFF) ? (n0 >> 7) * 256 + (n0 & 127) : ((n0 - DFF) >> 7) * 256 + 128 + ((n0 - DFF) & 127);
    const int c = lane & 7;
#pragma unroll
    for (int j = 0; j < 4; ++j) {
        const int nn = (lane >> 3) + 8 * j; const LAS float* s = scr + (8 * c) * 33 + nn;
        v4u o; o.x = pk2(s[0 * 33], s[1 * 33]); o.y = pk2(s[2 * 33], s[3 * 33]); o.z = pk2(s[4 * 33], s[5 * 33]); o.w = pk2(s[6 * 33], s[7 * 33]);
        *(v4u*)(WT + (size_t)(drow0 + nn) * K + k0 + 8 * c) = o;
    }
    LDS_WAIT(); asm volatile("" ::: "memory");
}

__device__ __forceinline__ void phase_prep(const Args& a, int z, LAS unsigned char* lds) {
    const int tid = threadIdx.x, lane = tid & 63, wave = tid >> 6;
    LAS float* scr = (LAS float*)(lds + wave * 16384);
    const int gw = blockIdx.x * NWAVES + wave, NGW = gridDim.x * NWAVES;
    unsigned char* ws = a.ws;
    constexpr int I_FI = 16 * 176, I_FO = 44 * 32, I_AI = 16 * 120, I_AO = 16 * 32, I_GI = 16 * 104, I_GO = 16 * 32;
    constexpr int NITEMS = 4 * I_FI + 4 * I_FO + I_AI + I_AO + I_GI + I_GO;
    for (int it = gw; it < NITEMS; it += NGW) {
        int r = it;
        if (r < 4 * I_FI) { const int i = r / I_FI, l = i >> 1, w2 = i & 1; r -= i * I_FI;
            if (i == 3) continue;
            transpose_item(a.in[z + (w2 ? 12 : 10)] + (size_t)l * D * NFI, D, NFI, (bf16*)(ws + WS_WFI + i * SZ_WFI), a.in[z + (w2 ? 8 : 6)] + l * D, 1, r, 176, scr, lane); continue; }
        r -= 4 * I_FI;
        if (r < 4 * I_FO) { const int i = r / I_FO, l = i >> 1, w2 = i & 1; r -= i * I_FO;
            if (i == 3) continue;
            transpose_item(a.in[z + (w2 ? 13 : 11)] + (size_t)l * DFF * D, DFF, D, (bf16*)(ws + WS_WFO + i * SZ_WFO), nullptr, 0, r, 32, scr, lane); continue; }
        r -= 4 * I_FO;
        if (r < I_AI) { transpose_item(a.in[z + (14)], D, NAB, (bf16*)(ws + WS_WAI), a.in[z + (7)], 0, r, 120, scr, lane); continue; }
        r -= I_AI;
        if (r < I_AO) { transpose_item(a.in[z + (15)], D, D, (bf16*)(ws + WS_WAO), nullptr, 0, r, 32, scr, lane); continue; }
        r -= I_AO;
        if (r < I_GI) { transpose_item(a.in[z + (24)], D, NGL, (bf16*)(ws + WS_WGI), a.in[z + (7)] + D, 0, r, 104, scr, lane); continue; }
        r -= I_GI;
        transpose_item(a.in[z + (28)], D, D, (bf16*)(ws + WS_WGO), nullptr, 0, r, 32, scr, lane);
    }
    bf16* XB = (bf16*)(ws + WS_XB); float* SSQ = (float*)(ws + WS_SSQ);
    for (int m = gw; m < T; m += NGW) {
        const float* src = (m < TP) ? a.in[z + (0)] + (size_t)m * D : a.in[z + (1)] + (size_t)(m - TP) * D;
        const f32x4* xr = (const f32x4*)src + lane;
        unsigned long long* o8 = (unsigned long long*)(XB + (size_t)m * D) + lane;
        float s = 0.f;
#pragma unroll
        for (int j = 0; j < 4; ++j) { const f32x4 v = xr[64 * j]; s += (v[0] * v[0] + v[1] * v[1]) + (v[2] * v[2] + v[3] * v[3]);
            o8[64 * j] = (unsigned long long)pk2(v[0], v[1]) | ((unsigned long long)pk2(v[2], v[3]) << 32); }
        s = wave_sum(s);
        if (lane < 16) SSQ[(size_t)m * 16 + lane] = (lane == 0) ? s : 0.f;
    }
}

__device__ __forceinline__ void prep_late(const Args& a, int z, LAS unsigned char* lds, int which, int rank, int nranks) {
    const int lane = threadIdx.x & 63, wave = threadIdx.x >> 6;
    LAS float* scr = (LAS float*)(lds + wave * 16384);
    const int nitems = which ? 44 * 32 : 16 * 176;
    for (int it = rank * NWAVES + wave; it < nitems; it += nranks * NWAVES) {
        if (which) transpose_item(a.in[z + 13] + (size_t)DFF * D, DFF, D, (bf16*)(a.ws + WS_WFO + 3 * SZ_WFO), nullptr, 0, it, 32, scr, lane);
        else transpose_item(a.in[z + 12] + (size_t)D * NFI, D, NFI, (bf16*)(a.ws + WS_WFI + 3 * SZ_WFI), a.in[z + 8] + D, 1, it, 176, scr, lane);
    }
}

constexpr int CK_QD = 0, CK_QS = 17408, CK_KI = 34816, CK_KET = 52224, CK_VT = 70656, CK_P = 75264, CK_ST = 84480, CK_SEG = 93184, CK_DEC = 95232,
              CK_OX = 95744, CK_DTS = 103936, CK_DTV = 104192, CK_GS = 104448;
constexpr int LQ = 136, LT = 72;
typedef short bf16x8_t __attribute__((ext_vector_type(8)));

__device__ __forceinline__ f32x4 mma_tile(const LAS bf16* F, int ldf, const LAS bf16* Sx, int lds_, int kc, f32x4 acc, int lane) {
    const int r = lane & 15, q = lane >> 4;
    const LAS bf16* fp = F + r * ldf + 8 * q; const LAS bf16* sp = Sx + r * lds_ + 8 * q;
    for (int k = 0; k < kc; k += 32) {
        const bf16x8_t fa = *(const LAS bf16x8_t*)(fp + k), sb = *(const LAS bf16x8_t*)(sp + k);
        acc = __builtin_amdgcn_mfma_f32_16x16x32_bf16(fa, sb, acc, 0, 0, 0);
    }
    return acc;
}

template <int TYPE>
__device__ __forceinline__ void chunk_unit(const Args& a, int z, int b, int h, int s, LAS unsigned char* lds) {
    constexpr int V = (TYPE == 0) ? 128 : (TYPE == 1) ? 64 : 256;
    constexpr int H = (TYPE == 1) ? 8 : 4;
    const int tid = threadIdx.x, lane = tid & 63, wave = tid >> 6, r = lane & 15, q = lane >> 4;
    LAS bf16* Qd = (LAS bf16*)(lds + CK_QD); LAS bf16* Qs = (TYPE == 1) ? (LAS bf16*)(lds + CK_QS) : Qd; LAS bf16* Ki = (LAS bf16*)(lds + CK_KI);
    LAS bf16* KeT = (LAS bf16*)(lds + CK_KET); LAS bf16* VT = (LAS bf16*)(lds + CK_VT); LAS bf16* P = (LAS bf16*)(lds + CK_P); LAS bf16* ST = (LAS bf16*)(lds + CK_ST);
    LAS float* SEG = (LAS float*)(lds + CK_SEG); LAS float* DEC = (LAS float*)(lds + CK_DEC); LAS float* OX = (LAS float*)(lds + CK_OX);
    LAS float* DTS = (LAS float*)(lds + CK_DTS); LAS float* DTV = (LAS float*)(lds + CK_DTV); LAS float* GS = (LAS float*)(lds + CK_GS);
    unsigned char* ws = a.ws;
    const bf16* PJ = (const bf16*)(ws + WS_PROJ);
    const float* LF = (const float*)(ws + WS_LF); const float* DT = (const float*)(ws + WS_DT); const float* GK = (const float*)(ws + WS_GK);
    bf16* OG = (bf16*)(ws + WS_OG);
    const int kl = tid & 127, seg = tid >> 7;
    const int vl = tid & 31, tq = tid >> 5;
    const int g = h >> 2;
    float a_h = 0.f, d_h = 0.f;
    if (TYPE == 1) { a_h = -__expf(a.in[z + 21][h]); d_h = a.in[z + 22][h]; }
    f32x4 sacc[2] = {(f32x4){0.f, 0.f, 0.f, 0.f}, (f32x4){0.f, 0.f, 0.f, 0.f}};
    __syncthreads();
    for (int e = tid; e < 32 * LQ / 2; e += 512) ((LAS unsigned*)ST)[e] = 0u;
    const int colbase = (TYPE == 0) ? h * 128 + s * 32 : (TYPE == 1) ? 512 + h * 64 + s * 32 : h * 256 + s * 32;
    const int tb = 16 * seg;
    constexpr int PP = (TYPE == 2) ? PG : PA;
    struct Raw { float lf[16]; unsigned q[16], k[16], v[4]; float dt; };
    const bf16* CV = (const bf16*)(ws + WS_XB);
    auto load_raw = [&](Raw& w, int n_) {
        const int row0_ = b * 2048 + n_ * 64;
#pragma unroll
        for (int i = 0; i < 16; ++i) { const size_t R = (size_t)(row0_ + tb + i);
            if (TYPE != 1) { w.lf[i] = LF[R * 512 + h * 128 + kl]; w.q[i] = PJ[R * PP + h * 128 + kl]; if (TYPE == 2) w.k[i] = PJ[R * PP + 512 + h * 128 + kl]; }
            else { w.q[i] = CV[R * 1024 + 768 + g * 128 + kl]; w.k[i] = CV[R * 1024 + 512 + g * 128 + kl]; } }
#pragma unroll
        for (int i = 0; i < 4; ++i) { const size_t R = (size_t)(row0_ + 4 * tq + i);
            w.v[i] = (TYPE == 1) ? CV[R * 1024 + h * 64 + s * 32 + vl] : PJ[R * PP + 1024 + h * V + s * 32 + vl]; }
        if (TYPE == 1) w.dt = (tid < 64) ? DT[(size_t)(row0_ + tid) * 8 + h] : 0.f;
    };
    Raw rc, rn;
    load_raw(rc, 0);
    for (int n = 0; n < 32; ++n) {
        const int row0 = b * 2048 + n * 64;
        if (n + 1 < 32) load_raw(rn, n + 1);
        float glast, goff;
        if (TYPE != 1) {
            float run = 0.f;
#pragma unroll
            for (int i = 0; i < 16; ++i) run += rc.lf[i];
            SEG[seg * 128 + kl] = run;
            __syncthreads();
            const float s0 = SEG[kl], s1 = SEG[128 + kl], s2 = SEG[256 + kl], s3 = SEG[384 + kl];
            goff = (seg > 0 ? s0 : 0.f) + (seg > 1 ? s1 : 0.f) + (seg > 2 ? s2 : 0.f);
            glast = (s0 + s1) + (s2 + s3);
        } else {
            if (tid < 64) { DTS[tid] = rc.dt * a_h; DTV[tid] = rc.dt; }
            __syncthreads();
            float off = 0.f, tot = 0.f;
            for (int t = 0; t < 64; t += 4) { const f32x4 d4 = *(const LAS f32x4*)(DTS + t); const float d = (d4[0] + d4[1]) + (d4[2] + d4[3]); tot += d; if (t < tb) off += d; }
            glast = tot; goff = off;
        }
        {
            const float eglast = __expf(glast);
            unsigned kew[8];
            float grun = goff;
#pragma unroll
            for (int i = 0; i < 16; i += 2) {
                float q0, q1, k0, k1, g0, g1;
                q0 = __uint_as_float(rc.q[i] << 16); q1 = __uint_as_float(rc.q[i + 1] << 16);
                if (TYPE == 0) { k0 = 1.f - __expf(rc.lf[i]); k1 = 1.f - __expf(rc.lf[i + 1]); }
                else { k0 = __uint_as_float(rc.k[i] << 16); k1 = __uint_as_float(rc.k[i + 1] << 16); }
                if (TYPE != 1) { grun += rc.lf[i]; g0 = grun; grun += rc.lf[i + 1]; g1 = grun; }
                else { grun += DTS[tb + i]; g0 = grun; grun += DTS[tb + i + 1]; g1 = grun; if (kl == 0) { GS[tb + i] = g0; GS[tb + i + 1] = g1; } }
                const float e0 = __expf(g0), e1 = __expf(g1);
                const int t = tb + i;
                if (TYPE == 1) {
                    const unsigned cq = pk2(q0, q1), ck = pk2(k0, k1);
                    Qs[t * LQ + kl] = (bf16)(cq & 0xffffu); Qs[(t + 1) * LQ + kl] = (bf16)(cq >> 16);
                    Ki[t * LQ + kl] = (bf16)(ck & 0xffffu); Ki[(t + 1) * LQ + kl] = (bf16)(ck >> 16);
                    kew[i >> 1] = pk2(k0 * __expf(glast - g0), k1 * __expf(glast - g1));
                } else {
                    const float i0 = __builtin_amdgcn_rcpf(e0), i1 = __builtin_amdgcn_rcpf(e1);
                    const unsigned kk = pk2(k0 * i0, k1 * i1);
                    Ki[t * LQ + kl] = (bf16)(kk & 0xffffu); Ki[(t + 1) * LQ + kl] = (bf16)(kk >> 16);
                    kew[i >> 1] = pk2(k0 * (eglast * i0), k1 * (eglast * i1));
                }
                const unsigned qq = pk2(q0 * e0, q1 * e1);
                Qd[t * LQ + kl] = (bf16)(qq & 0xffffu); Qd[(t + 1) * LQ + kl] = (bf16)(qq >> 16);
            }
            *(LAS v4u*)(KeT + kl * LT + tb) = (v4u){kew[0], kew[1], kew[2], kew[3]};
            *(LAS v4u*)(KeT + kl * LT + tb + 8) = (v4u){kew[4], kew[5], kew[6], kew[7]};
            if (seg == 0) DEC[kl] = eglast;
        }
        {
            if (TYPE != 1) {
                *(LAS v2u*)(VT + vl * LT + 4 * tq) = (v2u){rc.v[0] | (rc.v[1] << 16), rc.v[2] | (rc.v[3] << 16)};
            } else {
                float vv4[4];
#pragma unroll
                for (int i = 0; i < 4; ++i) { const float x = __uint_as_float(rc.v[i] << 16); OX[(4 * tq + i) * 32 + vl] = d_h * x; vv4[i] = x * DTV[4 * tq + i]; }
                *(LAS v2u*)(VT + vl * LT + 4 * tq) = (v2u){pk2(vv4[0], vv4[1]), pk2(vv4[2], vv4[3])};
            }
        }
        __syncthreads();
#pragma unroll
        for (int u2 = 0; u2 < 2; ++u2) {
            const int t = 2 * wave + u2, ti = t >> 2, tj = t & 3;
            v2u w = (v2u){0u, 0u};
            if (tj <= ti) {
                f32x4 acc = (f32x4){0.f, 0.f, 0.f, 0.f};
                acc = mma_tile(Ki + tj * 16 * LQ, LQ, Qs + ti * 16 * LQ, LQ, 128, acc, lane);
                const int i = 16 * ti + r, j0 = 16 * tj + 4 * q;
                float pv[4];
#pragma unroll
                for (int e = 0; e < 4; ++e) { float x = acc[e];
                    if (TYPE == 1) x *= __expf(fminf(GS[i] - GS[j0 + e], 0.f));
                    pv[e] = (j0 + e <= i) ? x : 0.f; }
                w = (v2u){pk2(pv[0], pv[1]), pk2(pv[2], pv[3])};
            }
            *(LAS v2u*)(P + (16 * ti + r) * LT + 16 * tj + 4 * q) = w;
        }
        __syncthreads();
        {
            const int ti = wave >> 1, tv = wave & 1;
            f32x4 acc = (f32x4){0.f, 0.f, 0.f, 0.f};
            acc = mma_tile(VT + tv * 16 * LT, LT, P + ti * 16 * LT, LT, (ti < 2) ? 32 : 64, acc, lane);
            acc = mma_tile(ST + tv * 16 * LQ, LQ, Qd + ti * 16 * LQ, LQ, 128, acc, lane);
            const int i = 16 * ti + r, v0 = 16 * tv + 4 * q;
            if (TYPE == 1) { const f32x4 ox = *(const LAS f32x4*)(OX + i * 32 + v0); acc = acc + ox; }
            *(v2u*)(OG + (size_t)(row0 + i) * D + colbase + v0) = (v2u){pk2(acc[0], acc[1]), pk2(acc[2], acc[3])};
        }
#pragma unroll
        for (int u2 = 0; u2 < 2; ++u2) {
            const int ti = 2 * wave + u2, vt = ti >> 3, kt = ti & 7;
            const f32x4 dc = *(const LAS f32x4*)(DEC + 16 * kt + 4 * q);
            sacc[u2] = sacc[u2] * dc;
            sacc[u2] = mma_tile(KeT + kt * 16 * LT, LT, VT + vt * 16 * LT, LT, 64, sacc[u2], lane);
        }
        __syncthreads();
#pragma unroll
        for (int u2 = 0; u2 < 2; ++u2) {
            const int ti = 2 * wave + u2, vt = ti >> 3, kt = ti & 7;
            *(LAS v2u*)(ST + (16 * vt + r) * LQ + 16 * kt + 4 * q) = (v2u){pk2(sacc[u2][0], sacc[u2][1]), pk2(sacc[u2][2], sacc[u2][3])};
        }
        rc = rn;
    }
#pragma unroll
    for (int u2 = 0; u2 < 2; ++u2) {
        const int ti = 2 * wave + u2, vt = ti >> 3, kt = ti & 7;
        const int k0 = 16 * kt + 4 * q, v = 16 * vt + r;
        if (TYPE == 1) {
            *(f32x4*)(a.out + O_SP + ((size_t)(b * 8 + h) * 64 + s * 32 + v) * 128 + k0) = sacc[u2];
        } else {
            float* dp = a.out + (TYPE == 0 ? O_HP : O_GP) + (size_t)(b * H + h) * 128 * V + s * 32 + v;
#pragma unroll
            for (int e = 0; e < 4; ++e) dp[(size_t)(k0 + e) * V] = sacc[u2][e];
        }
    }
    __syncthreads();
}

constexpr int RECA = 36352, RECP = 9216;
constexpr size_t WS_PREA = WS_END;
constexpr size_t WS_PREP_V = WS_WFI, WS_PREP_S = WS_WFO;
constexpr size_t WS_NEED = WS_PREA + (size_t)1536 * RECA;

template <int TYPE>
__device__ __forceinline__ void pre_unit(const Args& a, int z, int b, int h, int n, int rec, LAS unsigned char* lds) {
    const int tid = threadIdx.x, lane = tid & 63, wave = __builtin_amdgcn_readfirstlane(tid >> 6), r = lane & 15, q = lane >> 4;
    LAS bf16* Qd = (LAS bf16*)(lds + CK_QD); LAS bf16* Qs = (LAS bf16*)(lds + CK_QS); LAS bf16* Ki = (LAS bf16*)(lds + CK_KI);
    LAS bf16* KeT = (LAS bf16*)(lds + CK_KET); LAS bf16* P = (LAS bf16*)(lds + CK_P);
    LAS float* SEG = (LAS float*)(lds + CK_SEG); LAS float* DEC = (LAS float*)(lds + CK_DEC);
    unsigned char* ws = a.ws;
    const bf16* PJ = (const bf16*)(ws + WS_PROJ); const float* LF = (const float*)(ws + WS_LF); const bf16* CV = (const bf16*)(ws + WS_XB);
    const int kl = tid & 127, seg = tid >> 7, tb = 16 * seg;
    constexpr int PP = (TYPE == 2) ? PG : PA;
    const int row0 = b * 2048 + n * 64;
    float lf[16]; unsigned rq[16], rk[16];
#pragma unroll
    for (int i = 0; i < 16; ++i) { const size_t R = (size_t)(row0 + tb + i);
        if (TYPE == 0) { lf[i] = LF[R * 512 + h * 128 + kl]; rq[i] = PJ[R * PP + h * 128 + kl]; }
        else if (TYPE == 2) { rq[i] = PJ[R * PP + h * 128 + kl]; rk[i] = PJ[R * PP + 512 + h * 128 + kl]; } }
    if (TYPE == 2) {
        const float* GK = (const float*)(ws + WS_GK);
        float wg[16];
#pragma unroll
        for (int r2 = 0; r2 < 16; ++r2) wg[r2] = a.in[z + 25][r2 * 512 + h * 128 + kl];
        const float bg = a.in[z + 26][h * 128 + kl];
#pragma unroll
        for (int i = 0; i < 16; ++i) { const size_t R = (size_t)(row0 + tb + i);
            const f32x4 g0 = *(const f32x4*)(GK + R * 16), g1 = *(const f32x4*)(GK + R * 16 + 4), g2 = *(const f32x4*)(GK + R * 16 + 8), g3 = *(const f32x4*)(GK + R * 16 + 12);
            float x = bg;
#pragma unroll
            for (int j = 0; j < 4; ++j) x += g0[j] * wg[j] + g1[j] * wg[4 + j] + g2[j] * wg[8 + j] + g3[j] * wg[12 + j];
            lf[i] = -softplus_f(-x) * (1.f / 16.f); }
    }
    if (TYPE == 1) {
        float rb[19], rcc[19];
#pragma unroll
        for (int i = 0; i < 19; ++i) { const int tt = n * 64 + tb - 3 + i;
            if (tt >= 0) { const size_t R2 = (size_t)(b * 2048 + tt); rb[i] = bf2f(PJ[R2 * PA + 2560 + 512 + h * 128 + kl]); rcc[i] = bf2f(PJ[R2 * PA + 2560 + 768 + h * 128 + kl]); }
            else { rb[i] = 0.f; rcc[i] = 0.f; } }
        float cwB[4], cwC[4];
#pragma unroll
        for (int w = 0; w < 4; ++w) { cwB[w] = a.in[z + 18][w * 1024 + 512 + h * 128 + kl]; cwC[w] = a.in[z + 18][w * 1024 + 768 + h * 128 + kl]; }
        const float cbB = a.in[z + 19][512 + h * 128 + kl], cbC = a.in[z + 19][768 + h * 128 + kl];
#pragma unroll
        for (int i = 0; i < 16; i += 2) { float ab0 = cbB, ac0 = cbC, ab1 = cbB, ac1 = cbC;
#pragma unroll
            for (int w = 0; w < 4; ++w) { ab0 += rb[i + w] * cwB[w]; ac0 += rcc[i + w] * cwC[w]; ab1 += rb[i + 1 + w] * cwB[w]; ac1 += rcc[i + 1 + w] * cwC[w]; }
            const unsigned pb = pk2(silu_f(ab0), silu_f(ab1)), pc = pk2(silu_f(ac0), silu_f(ac1));
            rk[i] = pb & 0xffffu; rk[i + 1] = pb >> 16; rq[i] = pc & 0xffffu; rq[i + 1] = pc >> 16; }
        {
            const int xc = h * 256 + (tid & 255), t0x = 32 * (tid >> 8);
            bf16* CVw = (bf16*)(ws + WS_XB);
            float cwX[4];
#pragma unroll
            for (int w = 0; w < 4; ++w) cwX[w] = a.in[z + 18][w * 1024 + xc];
            const float cbX = a.in[z + 19][xc];
            float w3[3];
#pragma unroll
            for (int j = 0; j < 3; ++j) { const int tt = n * 64 + t0x - 3 + j; w3[j] = (tt >= 0) ? bf2f(PJ[(size_t)(b * 2048 + tt) * PA + 2560 + xc]) : 0.f; }
            for (int t8 = 0; t8 < 32; t8 += 8) {
                float nw[8];
#pragma unroll
                for (int j = 0; j < 8; ++j) nw[j] = bf2f(PJ[(size_t)(row0 + t0x + t8 + j) * PA + 2560 + xc]);
#pragma unroll
                for (int j = 0; j < 8; ++j) { const float ax = cbX + w3[0] * cwX[0] + w3[1] * cwX[1] + w3[2] * cwX[2] + nw[j] * cwX[3];
                    CVw[(size_t)(row0 + t0x + t8 + j) * 1024 + xc] = (bf16)(pk2(silu_f(ax), 0.f) & 0xffffu);
                    w3[0] = w3[1]; w3[1] = w3[2]; w3[2] = nw[j]; }
            }
        }
    }
    if (TYPE != 1) {
        float run = 0.f;
#pragma unroll
        for (int i = 0; i < 16; ++i) run += lf[i];
        SEG[seg * 128 + kl] = run;
        __syncthreads();
        const float s0 = SEG[kl], s1 = SEG[128 + kl], s2 = SEG[256 + kl], s3 = SEG[384 + kl];
        const float goff = (seg > 0 ? s0 : 0.f) + (seg > 1 ? s1 : 0.f) + (seg > 2 ? s2 : 0.f);
        const float glast = (s0 + s1) + (s2 + s3), eglast = __expf(glast);
        unsigned kew[8]; float grun = goff;
#pragma unroll
        for (int i = 0; i < 16; i += 2) {
            const float q0 = __uint_as_float(rq[i] << 16), q1 = __uint_as_float(rq[i + 1] << 16);
            float k0, k1;
            if (TYPE == 0) { k0 = 1.f - __expf(lf[i]); k1 = 1.f - __expf(lf[i + 1]); } else { k0 = __uint_as_float(rk[i] << 16); k1 = __uint_as_float(rk[i + 1] << 16); }
            grun += lf[i]; const float g0 = grun; grun += lf[i + 1]; const float g1 = grun;
            const float e0 = __expf(g0), e1 = __expf(g1), i0 = __builtin_amdgcn_rcpf(e0), i1 = __builtin_amdgcn_rcpf(e1);
            const int t = tb + i;
            const unsigned kk = pk2(k0 * i0, k1 * i1), qq = pk2(q0 * e0, q1 * e1);
            Ki[t * LQ + kl] = (bf16)(kk & 0xffffu); Ki[(t + 1) * LQ + kl] = (bf16)(kk >> 16);
            Qd[t * LQ + kl] = (bf16)(qq & 0xffffu); Qd[(t + 1) * LQ + kl] = (bf16)(qq >> 16);
            kew[i >> 1] = pk2(k0 * (eglast * i0), k1 * (eglast * i1));
        }
        *(LAS v4u*)(KeT + kl * LT + tb) = (v4u){kew[0], kew[1], kew[2], kew[3]};
        *(LAS v4u*)(KeT + kl * LT + tb + 8) = (v4u){kew[4], kew[5], kew[6], kew[7]};
        if (seg == 0) DEC[kl] = eglast;
    } else {
        unsigned kew[8];
#pragma unroll
        for (int i = 0; i < 16; i += 2) { const int t = tb + i;
            Qs[t * LQ + kl] = (bf16)rq[i]; Qs[(t + 1) * LQ + kl] = (bf16)rq[i + 1];
            Ki[t * LQ + kl] = (bf16)rk[i]; Ki[(t + 1) * LQ + kl] = (bf16)rk[i + 1];
            kew[i >> 1] = rk[i] | (rk[i + 1] << 16); }
        *(LAS v4u*)(KeT + kl * LT + tb) = (v4u){kew[0], kew[1], kew[2], kew[3]};
        *(LAS v4u*)(KeT + kl * LT + tb + 8) = (v4u){kew[4], kew[5], kew[6], kew[7]};
    }
    __syncthreads();
    {
        LAS bf16* Qx = (TYPE == 1) ? Qs : Qd;
#pragma unroll
        for (int u2 = 0; u2 < 2; ++u2) {
            const int t = 2 * wave + u2, ti = t >> 2, tj = t & 3;
            v2u w = (v2u){0u, 0u};
            if (tj <= ti) {
                f32x4 acc = (f32x4){0.f, 0.f, 0.f, 0.f};
                acc = mma_tile(Ki + tj * 16 * LQ, LQ, Qx + ti * 16 * LQ, LQ, 128, acc, lane);
                const int i = 16 * ti + r, j0 = 16 * tj + 4 * q;
                float pv[4];
#pragma unroll
                for (int e = 0; e < 4; ++e) pv[e] = (TYPE == 1 || j0 + e <= i) ? acc[e] : 0.f;
                w = (v2u){pk2(pv[0], pv[1]), pk2(pv[2], pv[3])};
            }
            *(LAS v2u*)(P + (16 * ti + r) * LT + 16 * tj + 4 * q) = w;
        }
    }
    __syncthreads();
    {
        unsigned char* ra = ws + WS_PREA + (size_t)rec * RECA;
        unsigned char* rp = ws + ((TYPE == 1) ? WS_PREP_S : WS_PREP_V) + (size_t)((TYPE == 1) ? rec - 1024 : rec) * RECP;
        const LAS unsigned char* s0 = lds + ((TYPE == 1) ? CK_QS : CK_QD);
        for (int p = tid; p < 1088; p += 512) *(v4u*)(ra + 16 * p) = *(const LAS v4u*)(s0 + 16 * p);
        for (int p = tid; p < 1152; p += 512) *(v4u*)(ra + 17408 + 16 * p) = *(const LAS v4u*)(lds + CK_KET + 16 * p);
        if (TYPE != 1 && tid < 32) *(v4u*)(ra + 35840 + 16 * tid) = *(const LAS v4u*)(lds + CK_DEC + 16 * tid);
        for (int p = tid; p < 576; p += 512) *(v4u*)(rp + 16 * p) = *(const LAS v4u*)(lds + CK_P + 16 * p);
    }
    __syncthreads();
}

constexpr int S2_QD = 0, S2_KET = 17408, S2_DEC = 35840, S2_P = 36352, S2_VT = 45568, S2_ST = 50176, S2_VT2 = 58880, S2_OX = 63488, S2_GS = 71680, S2_EG = 72192, S2_DTV = 72704, S2_GL = 73216;
template <int TYPE>
__device__ __forceinline__ void seq2_unit(const Args& a, int z, int b, int h, int s, LAS unsigned char* lds) {
    constexpr int V = (TYPE == 0) ? 128 : (TYPE == 1) ? 64 : 256;
    constexpr int H = (TYPE == 1) ? 8 : 4;
    const int tid = threadIdx.x, lane = tid & 63, wave = __builtin_amdgcn_readfirstlane(tid >> 6), r = lane & 15, q = lane >> 4;
    LAS bf16* Qd = (LAS bf16*)(lds + S2_QD); LAS bf16* KeT = (LAS bf16*)(lds + S2_KET); LAS float* DEC = (LAS float*)(lds + S2_DEC);
    LAS bf16* P = (LAS bf16*)(lds + S2_P); LAS bf16* VT = (LAS bf16*)(lds + S2_VT); LAS bf16* ST = (LAS bf16*)(lds + S2_ST); LAS bf16* VT2 = (LAS bf16*)(lds + S2_VT2);
    LAS float* OX = (LAS float*)(lds + S2_OX); LAS float* GS = (LAS float*)(lds + S2_GS); LAS float* EG = (LAS float*)(lds + S2_EG); LAS float* DTV = (LAS float*)(lds + S2_DTV);
    LAS float* GL = (LAS float*)(lds + S2_GL);
    unsigned char* ws = a.ws;
    const bf16* PJ = (const bf16*)(ws + WS_PROJ); const float* DT = (const float*)(ws + WS_DT); const bf16* CV = (const bf16*)(ws + WS_XB);
    bf16* OG = (bf16*)(ws + WS_OG);
    const int vl = tid & 31, tq = tid >> 5;
    constexpr int PP = (TYPE == 2) ? PG : PA;
    float a_h = 0.f, d_h = 0.f;
    if (TYPE == 1) { a_h = -__expf(a.in[z + 21][h]); d_h = a.in[z + 22][h]; }
    const int rec0 = (TYPE == 1) ? 1024 + (b * 2 + (h >> 2)) * 32 : (b * 4 + h) * 32;
    const unsigned char* ra0 = ws + WS_PREA + (size_t)rec0 * RECA;
    const unsigned char* rp0 = ws + ((TYPE == 1) ? WS_PREP_S + (size_t)(rec0 - 1024) * RECP : WS_PREP_V + (size_t)rec0 * RECP);
    constexpr int NA = (TYPE == 1) ? 2240 : 2272;
    struct Pre { v4u a[5]; v4u p[2]; unsigned v[4]; float dt; };
    auto load_pre = [&](Pre& w, int n_) {
        const unsigned char* ra = ra0 + (size_t)n_ * RECA; const unsigned char* rp = rp0 + (size_t)n_ * RECP;
#pragma unroll
        for (int j = 0; j < 5; ++j) { const int p = tid + 512 * j; if (p < NA) w.a[j] = *(const v4u*)(ra + 16 * p); }
        w.p[0] = *(const v4u*)(rp + 16 * tid); if (tid < 64) w.p[1] = *(const v4u*)(rp + 16 * (tid + 512));
        const int row0_ = b * 2048 + n_ * 64;
#pragma unroll
        for (int i = 0; i < 4; ++i) { const size_t R = (size_t)(row0_ + 4 * tq + i);
            w.v[i] = (TYPE == 1) ? CV[R * 1024 + h * 64 + s * 32 + vl] : PJ[R * PP + 1024 + h * V + s * 32 + vl]; }
        if (TYPE == 1) w.dt = (tid < 64) ? DT[(size_t)(row0_ + tid) * 8 + h] : 0.f;
    };
    f32x4 sacc[2] = {(f32x4){0.f, 0.f, 0.f, 0.f}, (f32x4){0.f, 0.f, 0.f, 0.f}};
    __syncthreads();
    for (int e = tid; e < 32 * LQ / 2; e += 512) ((LAS unsigned*)ST)[e] = 0u;
    const int colbase = (TYPE == 0) ? h * 128 + s * 32 : (TYPE == 1) ? 512 + h * 64 + s * 32 : h * 256 + s * 32;
    Pre rc, rn;
    load_pre(rc, 0);
    float dt1 = 0.f, dt2 = 0.f;
    auto scan_into = [&](float dtv, int buf) {
        float x = dtv * a_h;
#pragma unroll
        for (int o = 1; o < 64; o <<= 1) { const float y = __shfl_up(x, o); if (lane >= o) x += y; }
        GS[64 * buf + lane] = x; EG[64 * buf + lane] = __expf(x); DTV[64 * buf + lane] = dtv; if (lane == 63) GL[buf] = x;
    };
    if (TYPE == 1) {
        if (wave == 0) { scan_into(rc.dt, 0); dt1 = DT[(size_t)(b * 2048 + 64 + lane) * 8 + h]; }
        __syncthreads();
    }
    for (int n = 0; n < 32; ++n) {
        const int row0 = b * 2048 + n * 64;
        const int sb = n & 1;
        if (n + 1 < 32) load_pre(rn, n + 1);
        if (TYPE == 1 && wave == 0 && n + 2 < 32) dt2 = DT[(size_t)(b * 2048 + (n + 2) * 64 + lane) * 8 + h];
#pragma unroll
        for (int j = 0; j < 5; ++j) { const int p = tid + 512 * j; if (p < NA) *(LAS v4u*)(lds + 16 * p) = rc.a[j]; }
        if (TYPE != 1) {
            *(LAS v4u*)(lds + S2_P + 16 * tid) = rc.p[0]; if (tid < 64) *(LAS v4u*)(lds + S2_P + 16 * (tid + 512)) = rc.p[1];
            *(LAS v2u*)(VT + vl * LT + 4 * tq) = (v2u){rc.v[0] | (rc.v[1] << 16), rc.v[2] | (rc.v[3] << 16)};
        } else {
            const LAS float* GSb = GS + 64 * sb; const LAS float* DTVb = DTV + 64 * sb;
            const float glast = GL[sb];
#pragma unroll
            for (int jj = 0; jj < 2; ++jj) {
                const int p = tid + 512 * jj;
                if (jj == 0 || tid < 64) {
                    const int i = p / 9, c8 = p - 9 * i; v4u c = rc.p[jj];
                    if (c8 < 8) {
                        const int j0 = 8 * c8; const unsigned cw[4] = {c.x, c.y, c.z, c.w}; unsigned o[4];
                        const float gi = GSb[i];
#pragma unroll
                        for (int e = 0; e < 4; ++e) { const int j = j0 + 2 * e;
                            const float x0 = (j <= i) ? __uint_as_float(cw[e] << 16) * __expf(gi - GSb[j]) : 0.f;
                            const float x1 = (j + 1 <= i) ? __uint_as_float(cw[e] & 0xffff0000u) * __expf(gi - GSb[j + 1]) : 0.f;
                            o[e] = pk2(x0, x1); }
                        c = (v4u){o[0], o[1], o[2], o[3]};
                    }
                    *(LAS v4u*)(lds + S2_P + 16 * p) = c;
                }
            }
            {
                float v1[4], v2[4];
#pragma unroll
                for (int i = 0; i < 4; ++i) { const int t = 4 * tq + i; const float x = __uint_as_float(rc.v[i] << 16); OX[t * 32 + vl] = d_h * x; v1[i] = x * DTVb[t]; v2[i] = v1[i] * __expf(glast - GSb[t]); }
                *(LAS v2u*)(VT + vl * LT + 4 * tq) = (v2u){pk2(v1[0], v1[1]), pk2(v1[2], v1[3])};
                *(LAS v2u*)(VT2 + vl * LT + 4 * tq) = (v2u){pk2(v2[0], v2[1]), pk2(v2[2], v2[3])};
            }
        }
        __syncthreads();
        if (TYPE == 1 && wave == 0 && n + 1 < 32) scan_into(dt1, sb ^ 1);
        {
            const int ti = wave >> 1, tv = wave & 1;
            f32x4 acc = (f32x4){0.f, 0.f, 0.f, 0.f}, acc2 = (f32x4){0.f, 0.f, 0.f, 0.f};
            acc = mma_tile(VT + tv * 16 * LT, LT, P + ti * 16 * LT, LT, (ti < 2) ? 32 : 64, acc, lane);
            acc2 = mma_tile(ST + tv * 16 * LQ, LQ, Qd + ti * 16 * LQ, LQ, 128, acc2, lane);
            const int i = 16 * ti + r, v0 = 16 * tv + 4 * q;
            if (TYPE == 1) { const f32x4 ox = *(const LAS f32x4*)(OX + i * 32 + v0); acc = acc + acc2 * EG[64 * sb + i] + ox; } else acc = acc + acc2;
            *(v2u*)(OG + (size_t)(row0 + i) * D + colbase + v0) = (v2u){pk2(acc[0], acc[1]), pk2(acc[2], acc[3])};
        }
#pragma unroll
        for (int u2 = 0; u2 < 2; ++u2) {
            const int ti = 2 * wave + u2, vt = ti >> 3, kt = ti & 7;
            if (TYPE == 1) { const float dc = __expf(GL[sb]); sacc[u2] = sacc[u2] * dc; }
            else { const f32x4 dc = *(const LAS f32x4*)(DEC + 16 * kt + 4 * q); sacc[u2] = sacc[u2] * dc; }
            sacc[u2] = mma_tile(KeT + kt * 16 * LT, LT, ((TYPE == 1) ? VT2 : VT) + vt * 16 * LT, LT, 64, sacc[u2], lane);
        }
        __syncthreads();
#pragma unroll
        for (int u2 = 0; u2 < 2; ++u2) {
            const int ti = 2 * wave + u2, vt = ti >> 3, kt = ti & 7;
            *(LAS v2u*)(ST + (16 * vt + r) * LQ + 16 * kt + 4 * q) = (v2u){pk2(sacc[u2][0], sacc[u2][1]), pk2(sacc[u2][2], sacc[u2][3])};
        }
        rc = rn; dt1 = dt2;
    }
#pragma unroll
    for (int u2 = 0; u2 < 2; ++u2) {
        const int ti = 2 * wave + u2, vt = ti >> 3, kt = ti & 7;
        const int k0 = 16 * kt + 4 * q, v = 16 * vt + r;
        if (TYPE == 1) {
            *(f32x4*)(a.out + O_SP + ((size_t)(b * 8 + h) * 64 + s * 32 + v) * 128 + k0) = sacc[u2];
        } else {
            float* dp = a.out + (TYPE == 0 ? O_HP : O_GP) + (size_t)(b * H + h) * 128 * V + s * 32 + v;
#pragma unroll
            for (int e = 0; e < 4; ++e) dp[(size_t)(k0 + e) * V] = sacc[u2][e];
        }
    }
    __syncthreads();
}

template <int TYPE>
__device__ __forceinline__ void samp_unit(const Args& a, int z, int sx, int h, int s, LAS float* W, int lane) {
    constexpr int V = (TYPE == 0) ? 128 : (TYPE == 1) ? 64 : 256;
    constexpr int H = (TYPE == 1) ? 8 : 4;
    const int v = lane & 31, kh = lane >> 5;
    const int row0 = TP + sx * 4;
    unsigned char* ws = a.ws;
    const bf16* PJ = (const bf16*)(ws + WS_PROJ);
    const float* LF = (const float*)(ws + WS_LF); const float* DT = (const float*)(ws + WS_DT); const float* GK = (const float*)(ws + WS_GK);
    bf16* OG = (bf16*)(ws + WS_OG);
    LAS float* Wq = W; LAS float* Wk = W + 512; LAS float* Wf = W + 1024;
    float S[64];
    if (TYPE == 1) {
        const float* sp = a.in[z + 3] + ((size_t)(sx * 8 + h) * 64 + s * 32 + v) * 128 + 64 * kh;
#pragma unroll
        for (int j = 0; j < 16; ++j) { const f32x4 x = *(const f32x4*)(sp + 4 * j); S[4 * j] = x[0]; S[4 * j + 1] = x[1]; S[4 * j + 2] = x[2]; S[4 * j + 3] = x[3]; }
    } else {
        const float* sp = a.in[z + (TYPE == 0 ? 2 : 5)] + (size_t)(sx * H + h) * 128 * V + (size_t)(64 * kh) * V + s * 32 + v;
#pragma unroll
        for (int i = 0; i < 64; ++i) S[i] = sp[(size_t)i * V];
    }
    float vt[4], xsk[4] = {0.f, 0.f, 0.f, 0.f};
    if (TYPE == 0) {
#pragma unroll
        for (int t = 0; t < 4; ++t) { const size_t R = (size_t)(row0 + t);
#pragma unroll
            for (int c = 0; c < 2; ++c) { const int kk = lane + 64 * c; const float f = __expf(LF[R * 512 + h * 128 + kk]);
                Wq[t * 128 + kk] = bf2f(PJ[R * PA + h * 128 + kk]); Wk[t * 128 + kk] = 1.f - f; Wf[t * 128 + kk] = f; }
            vt[t] = bf2f(PJ[R * PA + 1024 + h * 128 + s * 32 + v]); }
    } else if (TYPE == 2) {
#pragma unroll
        for (int c = 0; c < 2; ++c) { const int kk = lane + 64 * c;
            float wg[16];
#pragma unroll
            for (int r = 0; r < 16; ++r) wg[r] = a.in[z + 25][r * 512 + h * 128 + kk];
            const float bg = a.in[z + 26][h * 128 + kk];
#pragma unroll
            for (int t = 0; t < 4; ++t) { const size_t R = (size_t)(row0 + t); float x = bg;
#pragma unroll
                for (int r = 0; r < 16; ++r) x += GK[R * 16 + r] * wg[r];
                Wf[t * 128 + kk] = __expf(-softplus_f(-x) * (1.f / 16.f));
                Wq[t * 128 + kk] = bf2f(PJ[R * PG + h * 128 + kk]); Wk[t * 128 + kk] = bf2f(PJ[R * PG + 512 + h * 128 + kk]); } }
#pragma unroll
        for (int t = 0; t < 4; ++t) vt[t] = bf2f(PJ[(size_t)(row0 + t) * PG + 1024 + h * 256 + s * 32 + v]);
    } else {
        const int g = h >> 2;
        const float* cst = a.in[z + 4] + (size_t)sx * 3 * 1024;
        const float a_h = -__expf(a.in[z + 21][h]), d_h = a.in[z + 22][h];
        float dtv[4];
#pragma unroll
        for (int t = 0; t < 4; ++t) dtv[t] = DT[(size_t)(row0 + t) * 8 + h];
#pragma unroll
        for (int c = 0; c < 2; ++c) { const int kk = lane + 64 * c;
#pragma unroll
            for (int bc = 0; bc < 2; ++bc) { const int ch = (bc ? 768 : 512) + g * 128 + kk;
                float raw[7];
#pragma unroll
                for (int j = 0; j < 7; ++j) raw[j] = (j < 3) ? cst[j * 1024 + ch] : bf2f(PJ[(size_t)(row0 + j - 3) * PA + 2560 + ch]);
                const float cb = a.in[z + 19][ch];
#pragma unroll
                for (int t = 0; t < 4; ++t) { float acc = cb;
#pragma unroll
                    for (int w = 0; w < 4; ++w) acc += raw[t + w] * a.in[z + 18][w * 1024 + ch];
                    (bc ? Wq : Wk)[t * 128 + kk] = silu_f(acc); } }
#pragma unroll
            for (int t = 0; t < 4; ++t) Wf[t * 128 + kk] = __expf(dtv[t] * a_h); }
        { const int ch = h * 64 + s * 32 + v; float raw[7];
#pragma unroll
            for (int j = 0; j < 7; ++j) raw[j] = (j < 3) ? cst[j * 1024 + ch] : bf2f(PJ[(size_t)(row0 + j - 3) * PA + 2560 + ch]);
            const float cb = a.in[z + 19][ch];
#pragma unroll
            for (int t = 0; t < 4; ++t) { float acc = cb;
#pragma unroll
                for (int w = 0; w < 4; ++w) acc += raw[t + w] * a.in[z + 18][w * 1024 + ch];
                const float x = silu_f(acc); vt[t] = x * dtv[t]; xsk[t] = d_h * x; } }
    }
    asm volatile("s_waitcnt lgkmcnt(0)" ::: "memory"); __builtin_amdgcn_wave_barrier();
    const int colbase = (TYPE == 0) ? h * 128 + s * 32 : (TYPE == 1) ? 512 + h * 64 + s * 32 : h * 256 + s * 32;
#pragma unroll
    for (int t = 0; t < 4; ++t) {
        float p = 0.f;
#pragma unroll
        for (int j = 0; j < 16; ++j) {
            const f32x4 q4 = *(const LAS f32x4*)(Wq + t * 128 + 64 * kh + 4 * j), k4 = *(const LAS f32x4*)(Wk + t * 128 + 64 * kh + 4 * j), f4 = *(const LAS f32x4*)(Wf + t * 128 + 64 * kh + 4 * j);
#pragma unroll
            for (int e = 0; e < 4; ++e) { S[4 * j + e] = f4[e] * S[4 * j + e] + k4[e] * vt[t]; p += q4[e] * S[4 * j + e]; }
        }
        p += __shfl_xor(p, 32);
        p += xsk[t];
        const float pn = __shfl_down(p, 1);
        if (lane < 32 && (lane & 1) == 0) *(unsigned*)(OG + (size_t)(row0 + t) * D + colbase + v) = pk2(p, pn);
    }
    asm volatile("s_waitcnt lgkmcnt(0)" ::: "memory"); __builtin_amdgcn_wave_barrier();
    if (TYPE == 1) {
        float* dp = a.out + O_SS + ((size_t)(sx * 8 + h) * 64 + s * 32 + v) * 128 + 64 * kh;
#pragma unroll
        for (int j = 0; j < 16; ++j) *(f32x4*)(dp + 4 * j) = (f32x4){S[4 * j], S[4 * j + 1], S[4 * j + 2], S[4 * j + 3]};
    } else {
        float* dp = a.out + (TYPE == 0 ? O_HS : O_GS) + (size_t)(sx * H + h) * 128 * V + (size_t)(64 * kh) * V + s * 32 + v;
#pragma unroll
        for (int i = 0; i < 64; ++i) dp[(size_t)i * V] = S[i];
    }
}

__device__ __forceinline__ void phase_ssd_conv(const Args& a, int z) {
    const int c = 2 * threadIdx.x;
    const bf16* PJ = (const bf16*)(a.ws + WS_PROJ); bf16* CV = (bf16*)(a.ws + WS_XB);
    float cw0[4], cw1[4];
#pragma unroll
    for (int w = 0; w < 4; ++w) { cw0[w] = a.in[z + 18][w * 1024 + c]; cw1[w] = a.in[z + 18][w * 1024 + c + 1]; }
    const float cb0 = a.in[z + 19][c], cb1 = a.in[z + 19][c + 1];
    for (int strip = blockIdx.x; strip < 256; strip += gridDim.x) {
        const int b = strip >> 5, t0 = (strip & 31) * 64;
        unsigned w3[3];
#pragma unroll
        for (int j = 0; j < 3; ++j) { const int t = t0 - 3 + j; w3[j] = (t >= 0) ? *(const unsigned*)(PJ + (size_t)(b * 2048 + t) * PA + 2560 + c) : 0u; }
        for (int tt = 0; tt < 64; tt += 8) {
            unsigned nw[8];
#pragma unroll
            for (int j = 0; j < 8; ++j) nw[j] = *(const unsigned*)(PJ + (size_t)(b * 2048 + t0 + tt + j) * PA + 2560 + c);
#pragma unroll
            for (int j = 0; j < 8; ++j) {
                const unsigned r0 = w3[0], r1 = w3[1], r2 = w3[2], r3 = nw[j];
                const float a0 = cb0 + __uint_as_float(r0 << 16) * cw0[0] + __uint_as_float(r1 << 16) * cw0[1] + __uint_as_float(r2 << 16) * cw0[2] + __uint_as_float(r3 << 16) * cw0[3];
                const float a1 = cb1 + __uint_as_float(r0 & 0xffff0000u) * cw1[0] + __uint_as_float(r1 & 0xffff0000u) * cw1[1] + __uint_as_float(r2 & 0xffff0000u) * cw1[2] + __uint_as_float(r3 & 0xffff0000u) * cw1[3];
                *(unsigned*)(CV + (size_t)(b * 2048 + t0 + tt + j) * 1024 + c) = pk2(silu_f(a0), silu_f(a1));
                w3[0] = r1; w3[1] = r2; w3[2] = r3;
            }
        }
    }
}

__device__ __forceinline__ void phase_gla_lf(const Args& a, int z) {
    const int c = threadIdx.x;
    float wg[16];
#pragma unroll
    for (int r = 0; r < 16; ++r) wg[r] = a.in[z + 25][r * 512 + c];
    const float bg = a.in[z + 26][c];
    const float* GK = (const float*)(a.ws + WS_GK); float* LF = (float*)(a.ws + WS_LF);
    for (int R = blockIdx.x; R < T; R += gridDim.x) {
        const f32x4 g0 = *(const f32x4*)(GK + (size_t)R * 16), g1 = *(const f32x4*)(GK + (size_t)R * 16 + 4), g2 = *(const f32x4*)(GK + (size_t)R * 16 + 8), g3 = *(const f32x4*)(GK + (size_t)R * 16 + 12);
        float x = bg;
#pragma unroll
        for (int j = 0; j < 4; ++j) x += g0[j] * wg[j] + g1[j] * wg[4 + j] + g2[j] * wg[8 + j] + g3[j] * wg[12 + j];
        LF[(size_t)R * 512 + c] = -softplus_f(-x) * (1.f / 16.f);
    }
}

template <int TYPE>
__device__ __forceinline__ void samp_unit_v(const Args& a, int z, int sx, int h, int s, LAS float* W, int lane) {
    constexpr int V = (TYPE == 0) ? 128 : 256;
    constexpr int PP = (TYPE == 0) ? PA : PG;
    const int v4 = lane & 7, kg = lane >> 3;
    const int row0 = TP + sx * 4;
    unsigned char* ws = a.ws;
    const bf16* PJ = (const bf16*)(ws + WS_PROJ);
    const float* LF = (const float*)(ws + WS_LF); const float* GK = (const float*)(ws + WS_GK);
    bf16* OG = (bf16*)(ws + WS_OG);
    LAS float* Wq = W; LAS float* Wk = W + 512; LAS float* Wf = W + 1024;
    f32x4 S[16];
    const float* sp = a.in[z + (TYPE == 0 ? 2 : 5)] + (size_t)(sx * 4 + h) * 128 * V + (size_t)(16 * kg) * V + s * 32 + 4 * v4;
#pragma unroll
    for (int i = 0; i < 16; ++i) S[i] = *(const f32x4*)(sp + (size_t)i * V);
    f32x4 vt[4];
    if (TYPE == 0) {
#pragma unroll
        for (int t = 0; t < 4; ++t) { const size_t R = (size_t)(row0 + t);
#pragma unroll
            for (int c = 0; c < 2; ++c) { const int kk = lane + 64 * c; const float f = __expf(LF[R * 512 + h * 128 + kk]);
                Wq[t * 128 + kk] = bf2f(PJ[R * PA + h * 128 + kk]); Wk[t * 128 + kk] = 1.f - f; Wf[t * 128 + kk] = f; } }
    } else {
#pragma unroll
        for (int c = 0; c < 2; ++c) { const int kk = lane + 64 * c;
            float wg[16];
#pragma unroll
            for (int r = 0; r < 16; ++r) wg[r] = a.in[z + 25][r * 512 + h * 128 + kk];
            const float bg = a.in[z + 26][h * 128 + kk];
#pragma unroll
            for (int t = 0; t < 4; ++t) { const size_t R = (size_t)(row0 + t); float x = bg;
#pragma unroll
                for (int r = 0; r < 16; ++r) x += GK[R * 16 + r] * wg[r];
                Wf[t * 128 + kk] = __expf(-softplus_f(-x) * (1.f / 16.f));
                Wq[t * 128 + kk] = bf2f(PJ[R * PG + h * 128 + kk]); Wk[t * 128 + kk] = bf2f(PJ[R * PG + 512 + h * 128 + kk]); } }
    }
#pragma unroll
    for (int t = 0; t < 4; ++t) { const v2u w = *(const v2u*)(PJ + (size_t)(row0 + t) * PP + 1024 + h * V + s * 32 + 4 * v4);
        vt[t] = (f32x4){__uint_as_float(w.x << 16), __uint_as_float(w.x & 0xffff0000u), __uint_as_float(w.y << 16), __uint_as_float(w.y & 0xffff0000u)}; }
    asm volatile("s_waitcnt lgkmcnt(0)" ::: "memory"); __builtin_amdgcn_wave_barrier();
    const int colbase = (TYPE == 0) ? h * 128 + s * 32 : h * 256 + s * 32;
#pragma unroll
    for (int t = 0; t < 4; ++t) {
        f32x4 p = (f32x4){0.f, 0.f, 0.f, 0.f};
#pragma unroll
        for (int j = 0; j < 4; ++j) {
            const f32x4 q4 = *(const LAS f32x4*)(Wq + t * 128 + 16 * kg + 4 * j), k4 = *(const LAS f32x4*)(Wk + t * 128 + 16 * kg + 4 * j), f4 = *(const LAS f32x4*)(Wf + t * 128 + 16 * kg + 4 * j);
#pragma unroll
            for (int e = 0; e < 4; ++e) { S[4 * j + e] = S[4 * j + e] * f4[e] + vt[t] * k4[e]; p = p + S[4 * j + e] * q4[e]; }
        }
#pragma unroll
        for (int e = 0; e < 4; ++e) { float x = p[e]; x += __shfl_xor(x, 8); x += __shfl_xor(x, 16); x += __shfl_xor(x, 32); p[e] = x; }
        if (lane < 8) *(v2u*)(OG + (size_t)(row0 + t) * D + colbase + 4 * v4) = (v2u){pk2(p[0], p[1]), pk2(p[2], p[3])};
    }
    asm volatile("s_waitcnt lgkmcnt(0)" ::: "memory"); __builtin_amdgcn_wave_barrier();
    float* dp = a.out + (TYPE == 0 ? O_HS : O_GS) + (size_t)(sx * 4 + h) * 128 * V + (size_t)(16 * kg) * V + s * 32 + 4 * v4;
#pragma unroll
    for (int i = 0; i < 16; ++i) *(f32x4*)(dp + (size_t)i * V) = S[i];
}

__device__ __forceinline__ void phase_mix_pre0(const Args& a, int z, LAS unsigned char* lds) {
    for (int u = blockIdx.x; u < 1536; u += gridDim.x) {
        if (u < 1024) pre_unit<0>(a, z, u >> 7, (u >> 5) & 3, u & 31, u, lds);
        else { const int v = u - 1024; pre_unit<1>(a, z, v >> 6, (v >> 5) & 1, v & 31, u, lds); }
    }
}
__device__ __forceinline__ void phase_mix_pre1(const Args& a, int z, LAS unsigned char* lds) {
    for (int u = blockIdx.x; u < 1024; u += gridDim.x) pre_unit<2>(a, z, u >> 7, (u >> 5) & 3, u & 31, u, lds);
}
__device__ __forceinline__ void phase_mix0(const Args& a, int z, LAS unsigned char* lds) {
    for (int u = blockIdx.x; u < 128; u += gridDim.x) seq2_unit<0>(a, z, u >> 4, (u >> 2) & 3, u & 3, lds);
    for (int u = blockIdx.x; u < 256; u += gridDim.x) if (u >= 128) { const int v = u - 128; seq2_unit<1>(a, z, v >> 4, (v >> 1) & 7, v & 1, lds); }
    const int lane = threadIdx.x & 63, wave = __builtin_amdgcn_readfirstlane(threadIdx.x >> 6);
    LAS float* W = (LAS float*)(lds + wave * 6144);
    const int gw = blockIdx.x * NWAVES + wave, NGW = gridDim.x * NWAVES;
    for (int v = gw; v < 2048; v += NGW) samp_unit_v<0>(a, z, v >> 4, (v >> 2) & 3, v & 3, W, lane);
    for (int v = gw; v < 2048; v += NGW) samp_unit<1>(a, z, v >> 4, (v >> 1) & 7, v & 1, W, lane);
}
__device__ __forceinline__ void phase_mix1(const Args& a, int z, LAS unsigned char* lds) {
    for (int u = blockIdx.x; u < 256; u += gridDim.x) seq2_unit<2>(a, z, u >> 5, (u >> 3) & 3, u & 7, lds);
    const int lane = threadIdx.x & 63, wave = __builtin_amdgcn_readfirstlane(threadIdx.x >> 6);
    LAS float* W = (LAS float*)(lds + wave * 6144);
    const int gw = blockIdx.x * NWAVES + wave, NGW = gridDim.x * NWAVES;
    for (int v = gw; v < 4096; v += NGW) samp_unit_v<2>(a, z, v >> 5, (v >> 3) & 3, v & 7, W, lane);
}

struct CapOrder {
    int c; unsigned* cnt;
    __device__ __forceinline__ bool next(int i, pg8::Unit& u) const {
        int ii = i;
        if (c >= 128 && c < 172) { if (i == 0) { const int s = c - 128; u.pm = 64 + s / 22; u.pn = s % 22; return true; } ii = i - 1; }
        const int cap = (c >= 248) ? 3 : ((c >= 128 && c < 172) ? 5 : 6);
        if (ii >= cap) return false;
        int idx;
        if (ii < 3) idx = ii * 256 + c; else if (ii < 5) idx = 768 + (ii - 3) * 248 + c; else idx = 1264 + (c < 128 ? c : c - 44);
        if (idx >= 1408) return false;
        const int xcd = idx & 7, off = idx >> 3, wgid = xcd * 176 + off;
        const int gid = wgid / 176, w2 = wgid - gid * 176;
        u.pm = gid * 8 + (w2 & 7); u.pn = w2 >> 3; return true;
    }
    __device__ __forceinline__ void a_ready(const pg8::Unit&) const {}
    __device__ __forceinline__ void done(const pg8::Unit& u) const {
        if (u.pm >= 64) { asm volatile("s_waitcnt vmcnt(0)" ::: "memory");
            if ((threadIdx.x & 63) == 0) __hip_atomic_fetch_add(cnt, 1u, __ATOMIC_RELAXED, __HIP_MEMORY_SCOPE_AGENT); }
    }
};
struct OneUnit {
    int pm, pn;
    __device__ __forceinline__ bool next(int i, pg8::Unit& u) const { if (i != 0) return false; u.pm = pm; u.pn = pn; return true; }
    __device__ __forceinline__ void a_ready(const pg8::Unit&) const {}
    __device__ __forceinline__ void done(const pg8::Unit&) const {}
};
__device__ __forceinline__ void wait_count(unsigned* cnt, unsigned need) {
    if (threadIdx.x == 0) { unsigned sp = 0; while (__hip_atomic_load(cnt, __ATOMIC_RELAXED, __HIP_MEMORY_SCOPE_AGENT) < need && ++sp < (1u << 22)) __builtin_amdgcn_s_sleep(2); }
    __builtin_amdgcn_fence(__ATOMIC_ACQUIRE, "agent"); asm volatile("s_waitcnt vmcnt(0)" ::: "memory");
    __syncthreads();
    __builtin_amdgcn_fence(__ATOMIC_ACQUIRE, "agent"); asm volatile("s_waitcnt vmcnt(0)" ::: "memory");
}

template <int LAYER>
__device__ __forceinline__ void post_row(const Args& a, int R, int lane, const float (&wn)[16]) {
    const bf16* PJ = (const bf16*)(a.ws + WS_PROJ); bf16* OG = (bf16*)(a.ws + WS_OG);
    const int c = 16 * lane;
    {
        const v4u o0 = *(const v4u*)(OG + (size_t)R * D + c), o1 = *(const v4u*)(OG + (size_t)R * D + c + 8);
        const bf16* gp = (LAYER == 0) ? PJ + (size_t)R * PA + 1536 + c : PJ + (size_t)R * PG + 2048 + c;
        const v4u g0 = *(const v4u*)gp, g1 = *(const v4u*)(gp + 8);
        float o[16], gt[16];
        const unsigned ow[8] = {o0.x, o0.y, o0.z, o0.w, o1.x, o1.y, o1.z, o1.w}, gw8[8] = {g0.x, g0.y, g0.z, g0.w, g1.x, g1.y, g1.z, g1.w};
#pragma unroll
        for (int j = 0; j < 8; ++j) { o[2 * j] = __uint_as_float(ow[j] << 16); o[2 * j + 1] = __uint_as_float(ow[j] & 0xffff0000u);
            gt[2 * j] = __uint_as_float(gw8[j] << 16); gt[2 * j + 1] = __uint_as_float(gw8[j] & 0xffff0000u); }
        const bool pre_gate = (LAYER == 0) && (lane >= 32);
        float ss = 0.f;
#pragma unroll
        for (int j = 0; j < 16; ++j) { if (pre_gate) o[j] *= gt[j]; ss += o[j] * o[j]; }
        ss += __shfl_xor(ss, 1); ss += __shfl_xor(ss, 2); ss += __shfl_xor(ss, 4);
        const float t8 = __shfl_xor(ss, 8);
        const bool wide = (LAYER == 1) || (lane >= 32);
        if (wide) ss += t8;
        const float rstd = rsqrtf(ss * (wide ? (1.f / 256.f) : (1.f / 128.f)) + EPS);
        unsigned r[8];
#pragma unroll
        for (int j = 0; j < 8; ++j) {
            float y0 = o[2 * j] * rstd * wn[2 * j], y1 = o[2 * j + 1] * rstd * wn[2 * j + 1];
            if (!pre_gate) { y0 *= gt[2 * j]; y1 *= gt[2 * j + 1]; }
            r[j] = pk2(y0, y1);
        }
        if (R >= TP) {
            unsigned long long* p8 = (unsigned long long*)(OG + (size_t)R * D + c);
#pragma unroll
            for (int j = 0; j < 4; ++j) __hip_atomic_store(p8 + j, (unsigned long long)r[2 * j] | ((unsigned long long)r[2 * j + 1] << 32), __ATOMIC_RELAXED, __HIP_MEMORY_SCOPE_AGENT);
        } else { *(v4u*)(OG + (size_t)R * D + c) = (v4u){r[0], r[1], r[2], r[3]}; *(v4u*)(OG + (size_t)R * D + c + 8) = (v4u){r[4], r[5], r[6], r[7]}; }
    }
}
template <int LAYER>
__device__ __forceinline__ void phase_post(const Args& a, int z, LAS unsigned char* lds, unsigned* cnt) {
    const int tid = threadIdx.x, lane = tid & 63, wave = tid >> 6;
    const int gw = blockIdx.x * NWAVES + wave, NGW = gridDim.x * NWAVES;
    const bf16* PJ = (const bf16*)(a.ws + WS_PROJ);
    const int c = 16 * lane;
    float wn[16];
    if (LAYER == 0) {
#pragma unroll
        for (int j = 0; j < 16; ++j) wn[j] = (lane < 32) ? a.in[z + 17][(c + j) & 127] : a.in[z + 23][c - 512 + j];
    } else {
#pragma unroll
        for (int j = 0; j < 16; ++j) wn[j] = a.in[z + 27][(c + j) & 255];
    }
    bool did = false;
    for (int R = TP + gw; R < T; R += NGW) { post_row<LAYER>(a, R, lane, wn); did = true; }
    if (did) { asm volatile("s_waitcnt vmcnt(0)" ::: "memory");
        if (lane == 0) __hip_atomic_fetch_add(cnt, 1u, __ATOMIC_RELAXED, __HIP_MEMORY_SCOPE_AGENT); }
    const int nsamp_waves = (T - TP) < NGW ? (T - TP) : NGW;
    if (blockIdx.x >= 248) {
        wait_count(cnt, (unsigned)nsamp_waves);
        pg8::Gemm g{(const bf16*)(a.ws + WS_OG), (const bf16*)(a.ws + (LAYER == 0 ? WS_WAO : WS_WGO)), T, D, D};
        OneUnit S{64 + ((int)blockIdx.x - 248) / 4, ((int)blockIdx.x - 248) % 4};
        Epi<1, 1> E{a.ws, a.out, a.out, a.out + (size_t)TP * D, a.in[16], a.in[20]};
        pg8::gemm_phase<Epi<1, 1>, OneUnit, true, true>(lds, g, S, E);
        return;
    }
    for (int R = gw; R < TP; R += 248 * NWAVES) post_row<LAYER>(a, R, lane, wn);
    prep_late(a, z, lds, LAYER, (int)blockIdx.x, 248);
    if (LAYER == 0) {
        const int gt_ = blockIdx.x * 512 + tid, NT = 248 * 512;
        for (int e = gt_; e < 136 * 3072; e += NT) {
            const int sq = e / 3072, r = (e / 1024) % 3, ch = e & 1023;
            const int row = (sq < 8) ? sq * 2048 + 2045 + r : TP + (sq - 8) * 4 + 1 + r;
            const float v = bf2f(PJ[(size_t)row * PA + 2560 + ch]);
            if (sq < 8) a.out[O_CP + e] = v; else a.out[O_CS + (e - 8 * 3072)] = v;
        }
    }
}

__device__ __forceinline__ void phase_final(const Args& a, int z) {
    const int tid = threadIdx.x, lane = tid & 63, wave = tid >> 6;
    const int gw = blockIdx.x * NWAVES + wave, NGW = gridDim.x * NWAVES;
    const float* SSQ = (const float*)(a.ws + WS_SSQ);
    f32x4 wn[4];
#pragma unroll
    for (int j = 0; j < 4; ++j) wn[j] = *((const f32x4*)a.in[z + (9)] + lane + 64 * j);
    for (int R = gw; R < T; R += 2 * NGW) {
        const int R2 = R + NGW; const bool two = R2 < T;
        f32x4* xr = (f32x4*)(a.out + (size_t)R * D) + lane; f32x4* xr2 = (f32x4*)(a.out + (size_t)(two ? R2 : R) * D) + lane;
        f32x4 v[4], v2[4];
#pragma unroll
        for (int j = 0; j < 4; ++j) { v[j] = xr[64 * j]; v2[j] = xr2[64 * j]; }
        float s = (lane < 16) ? SSQ[(size_t)R * 16 + lane] : 0.f, s2 = (lane < 16) ? SSQ[(size_t)(two ? R2 : R) * 16 + lane] : 0.f;
        s = wave_sum(s); s2 = wave_sum(s2);
        const float rstd = rsqrtf(s * (1.f / 1024.f) + EPS), rstd2 = rsqrtf(s2 * (1.f / 1024.f) + EPS);
#pragma unroll
        for (int j = 0; j < 4; ++j) xr[64 * j] = v[j] * rstd * wn[j];
        if (two) {
#pragma unroll
            for (int j = 0; j < 4; ++j) xr2[64 * j] = v2[j] * rstd2 * wn[j];
        }
    }
}


#define GAS __attribute__((address_space(1)))
typedef GAS unsigned gu32;
#define RLX_AGENT __ATOMIC_RELAXED, __HIP_MEMORY_SCOPE_AGENT
#define XB_TMO      128
#define XB_XCNT(j)  (256  + 64 * (j))
#define XB_XSUB(j)  (1280 + 64 * (j))
#define XB_XGEN(j)  (2304 + 64 * (j))
#define XB_TOP      3328
#define XB_TOPGEN   3392
#define XCD_BAR_WORDS 3456
#define XB_SPIN_CAP (1u << 18)

__device__ __forceinline__ unsigned xb_ld(unsigned* p)              { return __hip_atomic_load(p, __ATOMIC_RELAXED, __HIP_MEMORY_SCOPE_AGENT); }
__device__ __forceinline__ unsigned xb_add(unsigned* p, unsigned v) { return __hip_atomic_fetch_add(p, v, __ATOMIC_RELAXED, __HIP_MEMORY_SCOPE_AGENT); }
__device__ __forceinline__ unsigned xb_xcc_id() { return (unsigned)__builtin_amdgcn_s_getreg((3 << 11) | 20) & 0xFu; }
#define XB_SPIN(cond, bar) do { unsigned _sp = 0; while (cond) { __builtin_amdgcn_s_sleep(1); \
    if ((++_sp & 255u) == 0u) { if (xb_ld(&(bar)[XB_TMO])) break; if (_sp > XB_SPIN_CAP) { atomicAdd(&(bar)[XB_TMO], 1u); break; } } } } while (0)

struct XcdBarrier {
    unsigned* bar; unsigned x;
    volatile LAS unsigned* st;
};

__device__ __forceinline__ XcdBarrier xcd_barrier_post(unsigned* bar, volatile LAS unsigned* st) {
    XcdBarrier b; b.bar = bar; b.x = xb_xcc_id(); b.st = st;
    if (threadIdx.x == 0) (void)xb_add(&bar[XB_XCNT(b.x)], 1u);
    return b;
}
__device__ __forceinline__ void xcd_barrier_complete(unsigned* bar, unsigned x, unsigned& nloc, unsigned& nx) {
    const unsigned G = gridDim.x * gridDim.y * gridDim.z;
    unsigned sum, cnt, mine, sp = 0u;
    for (;;) {
        sum = 0u; cnt = 0u; mine = 0u;
#pragma unroll
        for (unsigned j = 0; j < 16; ++j) { const unsigned c = xb_ld(&bar[XB_XCNT(j)]); sum += c; cnt += (c > 0u) ? 1u : 0u; mine = (j == x) ? c : mine; }
        if (sum == G) break;
        __builtin_amdgcn_s_sleep(1);
        if ((++sp & 255u) == 0u) { if (xb_ld(&bar[XB_TMO])) break; if (sp > XB_SPIN_CAP) { atomicAdd(&bar[XB_TMO], 1u); break; } }
    }
    nloc = mine > 0u ? mine : 1u; nx = cnt > 0u ? cnt : 1u;
}

__device__ __forceinline__ void xcd_barrier(const XcdBarrier& b) {
    asm volatile("s_waitcnt vmcnt(0)" ::: "memory");
    __syncthreads();
    if (threadIdx.x == 0) {
        unsigned* bar = b.bar;
        __builtin_amdgcn_s_waitcnt(0);
        unsigned nloc = b.st[0], nx = b.st[1];
        if (nloc == 0u) { xcd_barrier_complete(bar, b.x, nloc, nx); b.st[0] = nloc; b.st[1] = nx; }
        const unsigned old = xb_add(&bar[XB_XSUB(b.x)], 1u);
        const unsigned gen = old / nloc;
        if (old + 1u == (gen + 1u) * nloc) {
            __builtin_amdgcn_fence(__ATOMIC_RELEASE, "agent");
            asm volatile("s_waitcnt vmcnt(0)" ::: "memory");
            const unsigned og = xb_add(&bar[XB_TOP], 1u);
            const unsigned tg = og / nx;
            if (og + 1u == (tg + 1u) * nx) xb_add(&bar[XB_TOPGEN], 1u);
            else XB_SPIN(xb_ld(&bar[XB_TOPGEN]) == tg, bar);
            __builtin_amdgcn_fence(__ATOMIC_ACQUIRE, "agent");
            xb_add(&bar[XB_XGEN(b.x)], 1u);
            asm volatile("s_waitcnt vmcnt(0)" ::: "memory");
        } else {
            XB_SPIN(xb_ld(&bar[XB_XGEN(b.x)]) == gen, bar);
            __builtin_amdgcn_fence(__ATOMIC_ACQUIRE, "agent");
            asm volatile("s_waitcnt vmcnt(0)" ::: "memory");
        }
    }
    __syncthreads();
}


__global__ void __launch_bounds__(NWAVES * 64, 2) fwd_megakernel(Args args) {
    extern __shared__ __attribute__((aligned(16))) unsigned char lds_raw[];
    LAS unsigned char* lds = (LAS unsigned char*)lds_raw;
    cg::grid_group grid = cg::this_grid();
    const int lo = args.ph_lo, hi = args.ph_hi;
    if (hi < 0) grid.sync();
    unsigned char* ws = args.ws;
    const int z = 0;
    for (int u = threadIdx.x; u < 64; u += NWAVES * 64) ((LAS unsigned*)(lds + 131072))[u] = 0u;
    __syncthreads();
    XcdBarrier bar; bar.bar = (unsigned*)(ws + WS_CTL) + 4096; bar.x = 0; bar.st = nullptr;
    if (hi - lo > 1) bar = xcd_barrier_post((unsigned*)(ws + WS_CTL) + 4096, (volatile LAS unsigned*)(lds + 131072 + 32));
#define IN_PH(k) (lo <= (k) && (k) < hi)
#define SEAM(k) do { if (IN_PH(k) && IN_PH((k) + 1)) xcd_barrier(bar); } while (0)
#define GEMM_PH(k, MODE, SUB, AOFF, BOFF, NN, KK, RP, RS) do { if (IN_PH(k)) { \
        pg8::Gemm g{(const bf16*)(ws + (AOFF)), (const bf16*)(ws + (BOFF)), T, (NN), (KK)}; \
        pg8::StaticOrder S; S.init(T, (NN), (int)gridDim.x, (int)blockIdx.x); \
        Epi<MODE, SUB> E{ws, args.out, (RP), (RS), args.in[16], args.in[20]}; \
        pg8::gemm_phase<Epi<MODE, SUB>, pg8::StaticOrder, true, true>(lds, g, S, E); } SEAM(k); } while (0)
#define GEMM_PHP(k, MODE, SUB, AOFF, BOFF, NN, KK, RP, RS) do { if (IN_PH(k)) { \
        pg8::Gemm g{(const bf16*)(ws + (AOFF)), (const bf16*)(ws + (BOFF)), TP, (NN), (KK)}; \
        pg8::StaticOrder S; S.init(TP, (NN), (int)gridDim.x, (int)blockIdx.x); \
        Epi<MODE, SUB> E{ws, args.out, (RP), (RS), args.in[16], args.in[20]}; \
        pg8::gemm_phase<Epi<MODE, SUB>, pg8::StaticOrder, true, true>(lds, g, S, E); } SEAM(k); } while (0)
#define FFN_IN_PH(k, FI, RP, RS) do { if (IN_PH(k)) { \
        unsigned* cnt = (unsigned*)(ws + WS_CTL) + 16384 + 64 * (FI); \
        { pg8::Gemm g{(const bf16*)(ws + WS_XB), (const bf16*)(ws + WS_WFI + (FI) * SZ_WFI), T, NFI, D}; \
          CapOrder S{(int)blockIdx.x, cnt}; Epi<0, 0> E{ws, args.out, XR, XRS, args.in[16], args.in[20]}; \
          pg8::gemm_phase<Epi<0, 0>, CapOrder, true, true>(lds, g, S, E); } \
        if (blockIdx.x >= 248) { wait_count(cnt, 44u * 8u); \
          pg8::Gemm g2{(const bf16*)(ws + WS_ACT), (const bf16*)(ws + WS_WFO + (FI) * SZ_WFO), T, D, DFF}; \
          OneUnit S2{64 + ((int)blockIdx.x - 248) / 4, ((int)blockIdx.x - 248) % 4}; Epi<1, 0> E2{ws, args.out, (RP), (RS), args.in[16], args.in[20]}; \
          pg8::gemm_phase<Epi<1, 0>, OneUnit, true, true>(lds, g2, S2, E2); } \
        } SEAM(k); } while (0)
#define FFN_OUT_PH(k, FO, RP, RS) do { if (IN_PH(k)) { \
        pg8::Gemm g{(const bf16*)(ws + WS_ACT), (const bf16*)(ws + WS_WFO + (FO) * SZ_WFO), TP, D, DFF}; \
        pg8::StaticOrder S; S.init(TP, D, (int)gridDim.x, (int)blockIdx.x); \
        Epi<1, 0> E{ws, args.out, (RP), (RS), args.in[16], args.in[20]}; \
        pg8::gemm_phase<Epi<1, 0>, pg8::StaticOrder, true, true>(lds, g, S, E); } SEAM(k); } while (0)
    float* const XR = args.out; float* const XRS = args.out + (size_t)TP * D;
    if (IN_PH(PH_PREP)) phase_prep(args, z, lds);
    SEAM(PH_PREP);
    FFN_IN_PH(PH_L0F1I, 0, args.in[0], args.in[1]);
    FFN_OUT_PH(PH_L0F1O, 0, args.in[0], args.in[1]);
    GEMM_PH(PH_ABI, 2, 0, WS_XB, WS_WAI, NAB_PAD, D, XR, XRS);
    if (IN_PH(PH_MIX0)) { phase_mix_pre0(args, z, lds); if (hi - lo > 1) xcd_barrier(bar); phase_mix0(args, z, lds); }
    SEAM(PH_MIX0);
    if (IN_PH(PH_POST0)) phase_post<0>(args, z, lds, (unsigned*)(ws + WS_CTL) + 16384 + 64 * 8);
    SEAM(PH_POST0);
    GEMM_PHP(PH_ABO, 1, 1, WS_OG, WS_WAO, D, D, XR, XRS);
    FFN_IN_PH(PH_L0F2I, 1, XR, XRS);
    FFN_OUT_PH(PH_L0F2O, 1, XR, XRS);
    FFN_IN_PH(PH_L1F1I, 2, XR, XRS);
    FFN_OUT_PH(PH_L1F1O, 2, XR, XRS);
    GEMM_PH(PH_GLI, 2, 1, WS_XB, WS_WGI, NGL_PAD, D, XR, XRS);
    if (IN_PH(PH_MIX1)) { phase_mix_pre1(args, z, lds); if (hi - lo > 1) xcd_barrier(bar); phase_mix1(args, z, lds); }
    SEAM(PH_MIX1);
    if (IN_PH(PH_POST1)) phase_post<1>(args, z, lds, (unsigned*)(ws + WS_CTL) + 16384 + 64 * 9);
    SEAM(PH_POST1);
    GEMM_PHP(PH_GLO, 1, 1, WS_OG, WS_WGO, D, D, XR, XRS);
    FFN_IN_PH(PH_L1F2I, 3, XR, XRS);
    if (IN_PH(PH_L1F2O)) {
        pg8::Gemm g{(const bf16*)(ws + WS_ACT), (const bf16*)(ws + WS_WFO + 3 * SZ_WFO), TP, D, DFF};
        pg8::StaticOrder S; S.init(TP, D, (int)gridDim.x, (int)blockIdx.x);
        Epi<1, 2> E{ws, args.out, XR, XRS, args.in[16], args.in[20]};
        pg8::gemm_phase<Epi<1, 2>, pg8::StaticOrder, true, true>(lds, g, S, E); }
    SEAM(PH_L1F2O);
    if (IN_PH(PH_FINAL)) phase_final(args, z);
}

#ifndef ONE_LAUNCH
#define ONE_LAUNCH 1
#endif
extern "C" void kernel_launch(void* const* d_in, const int* in_sizes, int n_in, void* d_out, int out_size, void* d_ws, size_t ws_size, hipStream_t stream) {
    static int grid = 0;
    if (grid == 0) {
        if (n_in != 29 || ws_size < WS_NEED) { fprintf(stderr, "kernel_launch: n_in %d ws %zu (need %zu)\n", n_in, ws_size, (size_t)WS_END); grid = -1; return; }
        int dev = 0, cus = 0, per_cu = 0;
        hipGetDevice(&dev); hipDeviceGetAttribute(&cus, hipDeviceAttributeMultiprocessorCount, dev);
        hipFuncSetAttribute((const void*)fwd_megakernel, hipFuncAttributeMaxDynamicSharedMemorySize, LDS_BYTES);
        if (hipOccupancyMaxActiveBlocksPerMultiprocessor(&per_cu, (const void*)fwd_megakernel, NWAVES * 64, LDS_BYTES) != hipSuccess || per_cu < 1) { fprintf(stderr, "occupancy query failed/0\n"); per_cu = 1; }
        (void)hipGetLastError();
        grid = cus;
        if (grid != 256) { fprintf(stderr, "kernel_launch: built for a 256-CU device, found %d\n", cus); grid = -1; return; }
    }
    if (grid < 0) return;
    Args a{};
    for (int i = 0; i < 29; ++i) a.in[i] = (const float*)d_in[i];
    a.out = (float*)d_out; a.ws = (unsigned char*)d_ws;
    if (hipMemsetAsync((char*)d_ws + WS_CTL, 0, 131072, stream) != hipSuccess) { fprintf(stderr, "memset failed\n"); return; }
#if ONE_LAUNCH
    a.ph_lo = 0; a.ph_hi = N_PH;
    void* kargs[] = {&a};
    hipError_t e = hipLaunchCooperativeKernel((const void*)fwd_megakernel, dim3(grid), dim3(NWAVES * 64), kargs, LDS_BYTES, stream);
    if (e != hipSuccess) fprintf(stderr, "cooperative launch failed: %s\n", hipGetErrorString(e));
#else
    for (int ph = 0; ph < N_PH; ++ph) { a.ph_lo = ph; a.ph_hi = ph + 1; hipLaunchKernelGGL(fwd_megakernel, dim3(grid), dim3(NWAVES * 64), LDS_BYTES, stream, a); }
#endif
}
```

```cpp
#include <hip/hip_runtime.h>
#include <hip/hip_cooperative_groups.h>
#include <cstdio>
#include <cstdint>
namespace cg = cooperative_groups;
namespace pg8 {
#define PG8_LAS __attribute__((address_space(3)))
typedef unsigned short bf16_t;
typedef short bf16x8 __attribute__((ext_vector_type(8)));
typedef float f32x4 __attribute__((ext_vector_type(4)));
typedef unsigned u32x4 __attribute__((ext_vector_type(4)));
constexpr int BM = 256, BK = 64, HALF = 128, HTB = HALF * BK * 2  , STAGE_BYTES = 8 * HTB, NXCD = 8, WGM = 8;

__host__ __device__ __forceinline__ int lds_byte(int r, int c) { const int st = (r >> 4) * 2 + (c >> 5), rr = r & 15, cc = c & 31, ob = rr * 64 + cc * 2; return st * 1024 + (ob ^ (((ob >> 9) & 1) << 5)); }
__host__ __device__ __forceinline__ void stage_rc(int b, int& R, int& C) { const int st = b / 1024, sb = b % 1024, swz = sb ^ (((sb >> 9) & 1) << 5); R = (st >> 1) * 16 + swz / 64; C = (st & 1) * 32 + (swz % 64) / 2; }
__host__ __device__ __forceinline__ int perm32(int rho) { const int n = rho >> 4, i = rho & 15; return 8 * (i >> 2) + 4 * n + (i & 3); }

struct Unit { int pm, pn; };
struct Gemm { const bf16_t* A; const bf16_t* Bt; int M, N, K; };

struct StaticOrder {
    int nM, nN, nwg, G, c;
    __host__ __device__ void init(int M, int N, int G_, int c_) { nM = M / BM; nN = N / BM; nwg = nM * nN; G = G_; c = c_; }
    __host__ __device__ bool next(int i, Unit& u) const {
        const long L = (long)i * G + c; if (L >= nwg) return false;
        int wgid = (int)L; { const int q = nwg / NXCD, r = nwg % NXCD, xcd = wgid % NXCD, off = wgid / NXCD; wgid = (xcd < r ? xcd * (q + 1) : r * (q + 1) + (xcd - r) * q) + off; }
        const int nig = WGM * nN, gid = wgid / nig, fm = gid * WGM, gsz = (nM - fm) < WGM ? (nM - fm) : WGM;
        u.pm = fm + ((wgid % nig) % gsz); u.pn = (wgid % nig) / gsz; return true;
    }
    __device__ __forceinline__ void a_ready(const Unit&) const {}
    __device__ __forceinline__ void done(const Unit&) const {}
};

__device__ __forceinline__ unsigned cvt_pk_bf16(float lo, float hi) { unsigned r; asm volatile("v_cvt_pk_bf16_f32 %0, %1, %2" : "=v"(r) : "v"(lo), "v"(hi)); return r; }
template <class Epi, class Sched, bool ALIGN_EPI = false, bool SP2 = false>
__device__ __forceinline__ void gemm_phase(PG8_LAS unsigned char* lds, const Gemm g, const Sched& S, const Epi& E) {
    const int tid = threadIdx.x, wid = __builtin_amdgcn_readfirstlane(tid >> 6), lane = tid & 63, wr = wid >> 2, wc = wid & 3, fr = lane & 15, fq = lane >> 4;
    const int K = g.K, nt = K / BK;
    unsigned voffA[2], voffB[2];
#pragma unroll
    for (int i = 0; i < 2; ++i) { int R, C; stage_rc(tid * 16 + i * 8192, R, C); const int Rb = Epi::PERM ? ((R & ~31) + perm32(R & 31)) : R;
        voffA[i] = (unsigned)(R * K + C) * 2u; voffB[i] = (unsigned)(Rb * K + C) * 2u; }
    const size_t kstep = (size_t)(BK * 2);
    const size_t hstep = (size_t)HALF * K * 2;
    const size_t tstep = 2 * hstep;
    const unsigned ldsw = (unsigned)wid * 1024u;
    const int aoff = lds_byte(wr * 64 + fr, fq * 8), boff = lds_byte(wc * 32 + fr, fq * 8);
#define PG8_SA(b, h) (((b) * 2 + (h)) * HTB)
#define PG8_SB(b, h) ((4 + (b) * 2 + (h)) * HTB)
#define PG8_STAGE(bufoff, gbase, voff) do { _Pragma("unroll") for (int _i = 0; _i < 2; ++_i) \
        __builtin_amdgcn_global_load_lds((const unsigned*)((const char*)(gbase) + (voff)[_i]), (PG8_LAS unsigned*)(lds + (bufoff) + ldsw + _i * 8192), 16, 0, 0); } while (0)
#define PG8_LDA(dst, b, h) do { _Pragma("unroll") for (int m = 0; m < 4; ++m) _Pragma("unroll") for (int k = 0; k < 2; ++k) dst[m][k] = *(const PG8_LAS bf16x8*)(lds + PG8_SA(b, h) + aoff + m * 2048 + k * 1024); } while (0)
#define PG8_LDB(dst, b, h) do { _Pragma("unroll") for (int n = 0; n < 2; ++n) _Pragma("unroll") for (int k = 0; k < 2; ++k) dst[n][k] = *(const PG8_LAS bf16x8*)(lds + PG8_SB(b, h) + boff + n * 2048 + k * 1024); } while (0)
#define PG8_MMA(ai, bj, At, Bt) do { __builtin_amdgcn_s_setprio(1); _Pragma("unroll") for (int m = 0; m < 4; ++m) _Pragma("unroll") for (int n = 0; n < 2; ++n) _Pragma("unroll") for (int k = 0; k < 2; ++k) \
        acc[ai][bj][m][n] = __builtin_amdgcn_mfma_f32_16x16x32_bf16(Bt[n][k], At[m][k], acc[ai][bj][m][n], 0, 0, 0); __builtin_amdgcn_s_setprio(0); } while (0)
#define PG8_WAIT_V(n) asm volatile("s_waitcnt vmcnt(" #n ")" ::: "memory")
#define PG8_WAIT_L(n) asm volatile("s_waitcnt lgkmcnt(" #n ")" ::: "memory")
#define PG8_BAR __builtin_amdgcn_s_barrier()
#define PG8_SCHED __builtin_amdgcn_sched_barrier(0)
    Unit cur, nxt; int ui = 0;
    if (!S.next(0, cur)) return;
    f32x4 acc[2][2][4][2];
#pragma unroll
    for (int a = 0; a < 2; ++a)
#pragma unroll
        for (int b = 0; b < 2; ++b)
#pragma unroll
            for (int m = 0; m < 4; ++m)
#pragma unroll
                for (int n = 0; n < 2; ++n) acc[a][b][m][n] = (f32x4){0.f, 0.f, 0.f, 0.f};
    bf16x8 At[4][2], B0[2][2], B1[2][2];
    const char* cA = (const char*)g.A + (size_t)cur.pm * tstep; const char* cB = (const char*)g.Bt + (size_t)cur.pn * tstep;
    S.a_ready(cur);
    if constexpr (SP2) {
        PG8_STAGE(PG8_SB(0, 0), cB, voffB); PG8_STAGE(PG8_SB(0, 1), cB + hstep, voffB); PG8_STAGE(PG8_SA(0, 0), cA, voffA); PG8_STAGE(PG8_SA(0, 1), cA + hstep, voffA);
        if (wr == 1) PG8_BAR;
        PG8_WAIT_V(2); PG8_BAR;
        PG8_STAGE(PG8_SB(1, 0), cB + kstep, voffB); PG8_STAGE(PG8_SA(1, 0), cA + kstep, voffA); PG8_STAGE(PG8_SB(1, 1), cB + hstep + kstep, voffB);
        PG8_WAIT_V(6); PG8_BAR;
    } else {
        PG8_STAGE(PG8_SB(0, 0), cB, voffB); PG8_STAGE(PG8_SA(0, 0), cA, voffA); PG8_STAGE(PG8_SB(0, 1), cB + hstep, voffB); PG8_STAGE(PG8_SA(0, 1), cA + hstep, voffA);
        if (wr == 1) PG8_BAR;
        PG8_WAIT_V(4); PG8_BAR;
        PG8_STAGE(PG8_SB(1, 0), cB + kstep, voffB); PG8_STAGE(PG8_SA(1, 0), cA + kstep, voffA); PG8_STAGE(PG8_SB(1, 1), cB + hstep + kstep, voffB);
        PG8_WAIT_V(6); PG8_BAR;
    }
    for (;;) {
        const bool has_next = S.next(ui + 1, nxt);
        const char* nA = has_next ? (const char*)g.A + (size_t)nxt.pm * tstep : cA; const char* nB = has_next ? (const char*)g.Bt + (size_t)nxt.pn * tstep : cB;
        for (int t = 0; t < nt; t += 2) {
            const bool last = (t == nt - 2);
            const char* a1 = cA + (size_t)(t + 1) * kstep;
            const char* a2 = last ? nA : cA + (size_t)(t + 2) * kstep; const char* b2 = last ? nB : cB + (size_t)(t + 2) * kstep;
            const char* a3 = a2 + kstep; const char* b3 = b2 + kstep;
            if (last && has_next) S.a_ready(nxt);
            if constexpr (SP2) {
            PG8_LDB(B0, 0, 0); PG8_LDB(B1, 0, 1); PG8_SCHED; PG8_LDA(At, 0, 0); PG8_STAGE(PG8_SA(1, 1), a1 + hstep, voffA);
            PG8_WAIT_V(8); PG8_WAIT_L(0); PG8_BAR; PG8_MMA(0, 0, At, B0); PG8_MMA(0, 1, At, B1); PG8_BAR; PG8_SCHED;
            PG8_LDA(At, 0, 1); PG8_STAGE(PG8_SB(0, 0), b2, voffB); PG8_STAGE(PG8_SB(0, 1), b2 + hstep, voffB); PG8_STAGE(PG8_SA(0, 0), a2, voffA);
            PG8_WAIT_V(8); PG8_WAIT_L(0); PG8_BAR; PG8_MMA(1, 0, At, B0); PG8_MMA(1, 1, At, B1); PG8_BAR; PG8_SCHED;
            PG8_LDB(B0, 1, 0); PG8_LDB(B1, 1, 1); PG8_SCHED; PG8_LDA(At, 1, 0); PG8_STAGE(PG8_SA(0, 1), a2 + hstep, voffA);
            PG8_WAIT_V(8); PG8_WAIT_L(0); PG8_BAR; PG8_MMA(0, 0, At, B0); PG8_MMA(0, 1, At, B1); PG8_BAR; PG8_SCHED;
            PG8_LDA(At, 1, 1); PG8_STAGE(PG8_SB(1, 0), b3, voffB); PG8_STAGE(PG8_SB(1, 1), b3 + hstep, voffB); PG8_STAGE(PG8_SA(1, 0), a3, voffA);
            PG8_WAIT_V(8); PG8_WAIT_L(0); PG8_BAR; PG8_MMA(1, 0, At, B0); PG8_MMA(1, 1, At, B1); PG8_BAR; PG8_SCHED;
            } else {
            PG8_LDB(B0, 0, 0); PG8_SCHED; PG8_LDA(At, 0, 0); PG8_STAGE(PG8_SA(1, 1), a1 + hstep, voffA);
            PG8_WAIT_L(8); PG8_BAR; PG8_WAIT_L(0); PG8_MMA(0, 0, At, B0); PG8_BAR; PG8_SCHED;
            PG8_LDB(B1, 0, 1); PG8_STAGE(PG8_SB(0, 0), b2, voffB);
            PG8_BAR; PG8_WAIT_L(0); PG8_MMA(0, 1, At, B1); PG8_BAR;
            PG8_LDA(At, 0, 1); PG8_STAGE(PG8_SA(0, 0), a2, voffA);
            PG8_BAR; PG8_WAIT_L(0); PG8_MMA(1, 0, At, B0); PG8_BAR; PG8_SCHED;
            PG8_STAGE(PG8_SB(0, 1), b2 + hstep, voffB);
            PG8_WAIT_V(6); PG8_BAR; PG8_MMA(1, 1, At, B1); PG8_BAR;
            PG8_LDB(B0, 1, 0); PG8_SCHED; PG8_LDA(At, 1, 0); PG8_STAGE(PG8_SA(0, 1), a2 + hstep, voffA);
            PG8_WAIT_L(8); PG8_BAR; PG8_WAIT_L(0); PG8_MMA(0, 0, At, B0); PG8_BAR; PG8_SCHED;
            PG8_LDB(B1, 1, 1); PG8_STAGE(PG8_SB(1, 0), b3, voffB);
            PG8_BAR; PG8_WAIT_L(0); PG8_MMA(0, 1, At, B1); PG8_BAR;
            PG8_LDA(At, 1, 1); PG8_STAGE(PG8_SA(1, 0), a3, voffA);
            PG8_BAR; PG8_WAIT_L(0); PG8_MMA(1, 0, At, B0); PG8_BAR; PG8_SCHED;
            PG8_STAGE(PG8_SB(1, 1), b3 + hstep, voffB);
            PG8_WAIT_V(6); PG8_BAR; PG8_MMA(1, 1, At, B1); PG8_BAR;
            }
        }
        if constexpr (ALIGN_EPI) { if (wr == 0) PG8_BAR; }
        if constexpr (!Epi::AFTER_DRAIN) { E(acc, cur, wr, wc, fr, fq); S.done(cur); }
        if (!has_next) break;
#pragma unroll
        for (int a = 0; a < 2; ++a)
#pragma unroll
            for (int b = 0; b < 2; ++b)
#pragma unroll
                for (int m = 0; m < 4; ++m)
#pragma unroll
                    for (int n = 0; n < 2; ++n) acc[a][b][m][n] = (f32x4){0.f, 0.f, 0.f, 0.f};
        cur = nxt; cA = nA; cB = nB; ++ui;
        if constexpr (ALIGN_EPI) { if (wr == 1) PG8_BAR; }
    }
    PG8_WAIT_V(0);
    if constexpr (!ALIGN_EPI) { if (wr == 0) PG8_BAR; }
    PG8_BAR;
    if constexpr (Epi::AFTER_DRAIN) { E.fused(acc, cur, wr, wc, fr, fq, lds, wid, lane); S.done(cur); }
#undef PG8_SA
#undef PG8_SB
#undef PG8_STAGE
#undef PG8_LDA
#undef PG8_LDB
#undef PG8_MMA
#undef PG8_WAIT_V
#undef PG8_WAIT_L
#undef PG8_BAR
#undef PG8_SCHED
}
}

#define LAS __attribute__((address_space(3)))
typedef unsigned short bf16;
typedef unsigned v4u __attribute__((ext_vector_type(4)));
typedef unsigned v2u __attribute__((ext_vector_type(2)));
typedef float f32x4 __attribute__((ext_vector_type(4)));

constexpr int T = 16896, TP = 16384, D = 1024, DFF = 2816, NFI = 5632;
constexpr int NAB = 3592, NAB_PAD = 3840, PA = 3584;
constexpr int NGL = 3088, NGL_PAD = 3328, PG = 3072;
constexpr float EPS = 1e-6f;
constexpr int NWAVES = 8;
constexpr int LDS_BYTES = 147456;

constexpr size_t O_HP = 17301504, O_HS = 17825792, O_SP = 26214400, O_SS = 26738688, O_CP = 35127296, O_CS = 35151872, O_GP = 35545088, O_GS = 36593664;

constexpr size_t MiB = 1u << 20;
constexpr size_t SZ_WFI = (size_t)NFI * D * 2, SZ_WFO = (size_t)D * DFF * 2;
constexpr size_t WS_CTL = 0;
constexpr size_t WS_WFI = 1 * MiB;
constexpr size_t WS_WFO = WS_WFI + 4 * SZ_WFI;
constexpr size_t WS_WAI = WS_WFO + 4 * SZ_WFO;
constexpr size_t WS_WAO = WS_WAI + (size_t)NAB_PAD * D * 2;
constexpr size_t WS_WGI = WS_WAO + (size_t)D * D * 2;
constexpr size_t WS_WGO = WS_WGI + (size_t)NGL_PAD * D * 2;
constexpr size_t WS_XB  = WS_WGO + (size_t)D * D * 2;
constexpr size_t WS_SSQ = WS_XB + (size_t)T * D * 2;
constexpr size_t WS_BIG = WS_SSQ + (size_t)T * 16 * 4;
constexpr size_t WS_ACT = WS_BIG;
constexpr size_t WS_PROJ = WS_BIG;
constexpr size_t WS_LF = WS_PROJ + (size_t)T * PA * 2;
constexpr size_t WS_DT = WS_LF + (size_t)T * 512 * 4;
constexpr size_t WS_GK = WS_DT + (size_t)T * 8 * 4;
constexpr size_t WS_OG = WS_GK + (size_t)T * 16 * 4;
constexpr size_t WS_END = WS_OG + (size_t)T * D * 2;

enum { PH_PREP = 0, PH_L0F1I, PH_L0F1O, PH_ABI, PH_MIX0, PH_POST0, PH_ABO, PH_L0F2I, PH_L0F2O,
       PH_L1F1I, PH_L1F1O, PH_GLI, PH_MIX1, PH_POST1, PH_GLO, PH_L1F2I, PH_L1F2O, PH_FINAL, N_PH };

struct Args { const float* in[29]; float* out; unsigned char* ws; int ph_lo, ph_hi; };

__device__ __forceinline__ float bf2f(bf16 b) { return __uint_as_float(((unsigned)b) << 16); }
typedef float f32x2_t __attribute__((ext_vector_type(2))); typedef __bf16 bf16x2_t __attribute__((ext_vector_type(2)));
__device__ __forceinline__ unsigned pk2(float lo, float hi) { const bf16x2_t v = __builtin_convertvector((f32x2_t){lo, hi}, bf16x2_t); return __builtin_bit_cast(unsigned, v); }
__device__ __forceinline__ f32x2_t silu_mul_pk(f32x2_t g, f32x2_t u) {
    const f32x2_t t = g * (-1.4426950408889634f);
    f32x2_t e; e.x = __builtin_amdgcn_exp2f(t.x); e.y = __builtin_amdgcn_exp2f(t.y);
    const f32x2_t d = e + 1.0f;
    f32x2_t r; r.x = __builtin_amdgcn_rcpf(d.x); r.y = __builtin_amdgcn_rcpf(d.y);
    return (g * r) * u;
}
__device__ __forceinline__ unsigned pk2v(f32x2_t v) { const bf16x2_t b = __builtin_convertvector(v, bf16x2_t); return __builtin_bit_cast(unsigned, b); }
__device__ __forceinline__ float silu_f(float x) { return x * __builtin_amdgcn_rcpf(1.f + __expf(-x)); }
__device__ __forceinline__ float sigmoid_f(float x) { return __builtin_amdgcn_rcpf(1.f + __expf(-x)); }
__device__ __forceinline__ float softplus_f(float x) { return fmaxf(x, 0.f) + log1pf(__expf(-fabsf(x))); }
__device__ __forceinline__ float wave_sum(float v) {
#pragma unroll
    for (int o = 1; o < 64; o <<= 1) v += __shfl_xor(v, o);
    return v;
}
#define LDS_WAIT() asm volatile("s_waitcnt lgkmcnt(0)" ::: "memory")

enum { ACT_NONE = 0, ACT_RAW, ACT_SILU, ACT_QSCALE, ACT_FGATE, ACT_DT, ACT_GK };
constexpr unsigned long long ACTS_AB = 0x2ull | (0x2ull << 4) | (0x4ull << 8) | (0x4ull << 12) | (0x1ull << 16) | (0x1ull << 20) | (0x2ull << 24) | (0x2ull << 28) | (0x2ull << 32) | (0x2ull << 36)
               | (0x1ull << 40) | (0x1ull << 44) | (0x1ull << 48) | (0x1ull << 52) | (0x5ull << 56);
constexpr unsigned long long ACTS_GL = 0x3ull | (0x3ull << 4) | (0x1ull << 8) | (0x1ull << 12) | (0x1ull << 16) | (0x1ull << 20) | (0x1ull << 24) | (0x1ull << 28) | (0x2ull << 32) | (0x2ull << 36)
               | (0x2ull << 40) | (0x2ull << 44) | (0x6ull << 48);
template <int mode  ,
          int sub   >
struct Epi {
    static constexpr bool PERM = true, AFTER_DRAIN = false;
    unsigned char* ws; float* out;
    const float* res_p; const float* res_s;
    const float* lbl; const float* dtb;
    mutable int cpm = -1; mutable float crs[2][4] = {{0.f, 0.f, 0.f, 0.f}, {0.f, 0.f, 0.f, 0.f}};
    __device__ __forceinline__ void operator()(const pg8::f32x4 (&acc)[2][2][4][2], const pg8::Unit& u, int wr, int wc, int fr, int fq) const {
        const int rbase = u.pm * 256 + wr * 64 + fr;
        const int cl = wc * 32 + 8 * fq;
        const float* ssq_in = (const float*)(ws + WS_SSQ);
        bf16* obf = (bf16*)(ws + WS_BIG);
        if (mode == 1) {
            float* xr = out; bf16* xb = (bf16*)(ws + WS_XB); float* ssq_out = (float*)(ws + WS_SSQ);
            const float scale = (sub == 1) ? 1.f : 0.5f;
            const int c00 = u.pn * 256 + cl;
            f32x4 rb[2][4];
            {
                const int row = rbase;
                const float* rp = (row < TP) ? res_p + (size_t)row * D : res_s + (size_t)(row - TP) * D;
                rb[0][0] = *(const f32x4*)(rp + c00); rb[0][1] = *(const f32x4*)(rp + c00 + 4); rb[0][2] = *(const f32x4*)(rp + c00 + 128); rb[0][3] = *(const f32x4*)(rp + c00 + 132);
            }
#pragma unroll
            for (int gi = 0; gi < 8; ++gi) {
                const int ai = gi >> 2, m = gi & 3;
                const int row = rbase + ai * 128 + m * 16;
                if (gi + 1 < 8) {
                    const int rown = rbase + ((gi + 1) >> 2) * 128 + ((gi + 1) & 3) * 16;
                    const float* rp = (rown < TP) ? res_p + (size_t)rown * D : res_s + (size_t)(rown - TP) * D;
                    rb[(gi + 1) & 1][0] = *(const f32x4*)(rp + c00); rb[(gi + 1) & 1][1] = *(const f32x4*)(rp + c00 + 4);
                    rb[(gi + 1) & 1][2] = *(const f32x4*)(rp + c00 + 128); rb[(gi + 1) & 1][3] = *(const f32x4*)(rp + c00 + 132);
                }
                float ss = 0.f;
#pragma unroll
                for (int bj = 0; bj < 2; ++bj) {
                    const int c0 = c00 + bj * 128;
                    const f32x4 x0 = rb[gi & 1][2 * bj] + acc[ai][bj][m][0] * scale, x1 = rb[gi & 1][2 * bj + 1] + acc[ai][bj][m][1] * scale;
                    *(f32x4*)(xr + (size_t)row * D + c0) = x0; *(f32x4*)(xr + (size_t)row * D + c0 + 4) = x1;
                    if (sub != 2) {
                        v4u w; w.x = pk2(x0[0], x0[1]); w.y = pk2(x0[2], x0[3]); w.z = pk2(x1[0], x1[1]); w.w = pk2(x1[2], x1[3]);
                        *(v4u*)(xb + (size_t)row * D + c0) = w; }
                    ss += (x0[0] * x0[0] + x0[1] * x0[1]) + (x0[2] * x0[2] + x0[3] * x0[3]) + (x1[0] * x1[0] + x1[1] * x1[1]) + (x1[2] * x1[2] + x1[3] * x1[3]);
                }
                ss += __shfl_xor(ss, 16); ss += __shfl_xor(ss, 32);
                if (fq == 0) ssq_out[(size_t)row * 16 + u.pn * 4 + wc] = ss;
                asm volatile("" ::: "memory");
            }
            return;
        }
        if (u.pm != cpm) {
            cpm = u.pm;
#pragma unroll
            for (int ai = 0; ai < 2; ++ai)
#pragma unroll
                for (int m = 0; m < 4; ++m) {
                    const int row = rbase + ai * 128 + m * 16;
                    const f32x4 p = *(const f32x4*)(ssq_in + (size_t)row * 16 + 4 * fq);
                    float s = (p[0] + p[1]) + (p[2] + p[3]); s += __shfl_xor(s, 16); s += __shfl_xor(s, 32);
                    crs[ai][m] = rsqrtf(s * (1.f / 1024.f) + EPS);
                }
        }
        float rstd[2][4];
#pragma unroll
        for (int ai = 0; ai < 2; ++ai)
#pragma unroll
            for (int m = 0; m < 4; ++m) rstd[ai][m] = crs[ai][m];
        if (mode == 0) {
            const int hc = u.pn * 128 + cl;
#pragma unroll
            for (int ai = 0; ai < 2; ++ai)
#pragma unroll
                for (int m = 0; m < 4; ++m) {
                    const int row = rbase + ai * 128 + m * 16; const float rs = rstd[ai][m];
                    const f32x4 g0 = acc[ai][0][m][0] * rs, g1 = acc[ai][0][m][1] * rs, u0 = acc[ai][1][m][0] * rs, u1 = acc[ai][1][m][1] * rs;
                    v4u w;
                    w.x = pk2v(silu_mul_pk((f32x2_t){g0[0], g0[1]}, (f32x2_t){u0[0], u0[1]})); w.y = pk2v(silu_mul_pk((f32x2_t){g0[2], g0[3]}, (f32x2_t){u0[2], u0[3]}));
                    w.z = pk2v(silu_mul_pk((f32x2_t){g1[0], g1[1]}, (f32x2_t){u1[0], u1[1]})); w.w = pk2v(silu_mul_pk((f32x2_t){g1[2], g1[3]}, (f32x2_t){u1[2], u1[3]}));
                    if (u.pm >= 64) {
                        unsigned long long* p8 = (unsigned long long*)(obf + (size_t)row * DFF + hc);
                        __hip_atomic_store(p8, (unsigned long long)w.x | ((unsigned long long)w.y << 32), __ATOMIC_RELAXED, __HIP_MEMORY_SCOPE_AGENT);
                        __hip_atomic_store(p8 + 1, (unsigned long long)w.z | ((unsigned long long)w.w << 32), __ATOMIC_RELAXED, __HIP_MEMORY_SCOPE_AGENT);
                    } else *(v4u*)(obf + (size_t)row * DFF + hc) = w;
                    asm volatile("" ::: "memory");
                }
            return;
        }
        const unsigned long long acts = sub ? ACTS_GL : ACTS_AB;
        const int ldo = sub ? PG : PA;
        const int code = (int)((acts >> (4 * u.pn)) & 15ull);
        if (code == ACT_NONE) return;
        if (code == ACT_DT) {
            if (cl == 0) {
                float* aux = (float*)(ws + WS_DT);
#pragma unroll
                for (int ai = 0; ai < 2; ++ai)
#pragma unroll
                    for (int m = 0; m < 4; ++m) {
                        const int row = rbase + ai * 128 + m * 16; const float rs = rstd[ai][m];
                        const f32x4 a0 = acc[ai][0][m][0] * rs, a1 = acc[ai][0][m][1] * rs; f32x4 d0, d1;
#pragma unroll
                        for (int j = 0; j < 4; ++j) { d0[j] = softplus_f(a0[j] + dtb[j]); d1[j] = softplus_f(a1[j] + dtb[4 + j]); }
                        *(f32x4*)(aux + (size_t)row * 8) = d0; *(f32x4*)(aux + (size_t)row * 8 + 4) = d1;
                    }
            }
            return;
        }
        if (code == ACT_GK) {
            if (cl < 16) {
                float* aux = (float*)(ws + WS_GK);
#pragma unroll
                for (int ai = 0; ai < 2; ++ai)
#pragma unroll
                    for (int m = 0; m < 4; ++m) {
                        const int row = rbase + ai * 128 + m * 16; const float rs = rstd[ai][m];
                        *(f32x4*)(aux + (size_t)row * 16 + cl) = acc[ai][0][m][0] * rs; *(f32x4*)(aux + (size_t)row * 16 + cl + 4) = acc[ai][0][m][1] * rs;
                    }
            }
            return;
        }
#pragma unroll
        for (int bj = 0; bj < 2; ++bj) {
            const int c0 = u.pn * 256 + bj * 128 + cl;
            float lbv[8];
            if (code == ACT_FGATE) {
#pragma unroll
                for (int j = 0; j < 8; ++j) { const float l0 = lbl[c0 - 512 + j], l1 = lbl[c0 + j]; lbv[j] = __builtin_amdgcn_rcpf(1.f + __expf(l1 - l0)); }
            }
#pragma unroll
            for (int ai = 0; ai < 2; ++ai)
#pragma unroll
                for (int m = 0; m < 4; ++m) {
                    const int row = rbase + ai * 128 + m * 16; const float rs = rstd[ai][m];
                    const f32x4 a0 = acc[ai][bj][m][0] * rs, a1 = acc[ai][bj][m][1] * rs;
                    float v[8] = {a0[0], a0[1], a0[2], a0[3], a1[0], a1[1], a1[2], a1[3]};
                    if (code == ACT_SILU) {
#pragma unroll
                        for (int j = 0; j < 8; ++j) v[j] = silu_f(v[j]);
                    } else if (code == ACT_QSCALE) {
#pragma unroll
                        for (int j = 0; j < 8; ++j) v[j] *= 0.08838834764831845f;
                    } else if (code == ACT_FGATE) {
                        float* lf = (float*)(ws + WS_LF);
                        f32x4 l0, l1;
#pragma unroll
                        for (int j = 0; j < 8; ++j) {
                            const float f = lbv[j] + (1.f - lbv[j]) * sigmoid_f(v[j]);
                            const float lg = __logf(f);
                            if (j < 4) l0[j] = lg; else l1[j - 4] = lg;
                            v[j] = 1.f - f;
                        }
                        *(f32x4*)(lf + (size_t)row * 512 + (c0 - 512)) = l0; *(f32x4*)(lf + (size_t)row * 512 + (c0 - 512) + 4) = l1;
                    }
                    if (code != ACT_FGATE) {
                        v4u w; w.x = pk2(v[0], v[1]); w.y = pk2(v[2], v[3]); w.z = pk2(v[4], v[5]); w.w = pk2(v[6], v[7]);
                        *(v4u*)(obf + (size_t)row * ldo + c0) = w; }
                    asm volatile("" ::: "memory");
                }
        }
    }
};

__device__ __forceinline__ void transpose_item(const float* __restrict__ W, int K, int N, bf16* __restrict__ WT, const float* __restrict__ scale, int mapmode,
                                               int item, int nblk, LAS float* scr, int lane) {
    const int kb = item / nblk, nb = item - kb * nblk, k0 = 64 * kb, n0 = 32 * nb;
    const int kr = lane >> 3, c4 = lane & 7;
    const bool ok = (n0 + 4 * c4) < N;
    f32x4 v[8];
#pragma unroll
    for (int i = 0; i < 8; ++i) v[i] = ok ? __builtin_nontemporal_load((const f32x4*)(W + (size_t)(k0 + kr + 8 * i) * N + n0 + 4 * c4)) : (f32x4){0.f, 0.f, 0.f, 0.f};
    if (scale) {
#pragma unroll
        for (int i = 0; i < 8; ++i) v[i] = v[i] * scale[k0 + kr + 8 * i];
    }
#pragma unroll
    for (int i = 0; i < 8; ++i) { LAS float* sp = scr + (kr + 8 * i) * 33 + 4 * c4; sp[0] = v[i][0]; sp[1] = v[i][1]; sp[2] = v[i][2]; sp[3] = v[i][3]; }
    LDS_WAIT(); asm volatile("" ::: "memory");
    int drow0 = n0;
    if (mapmode == 1) drow0 = (n0 < DFF) ? (n0 >> 7) * 256 + (n0 & 127) : ((n0 - DFF) >> 7) * 256 + 128 + ((n0 - DFF) & 127);
    const int c = lane & 7;
#pragma unroll
    for (int j = 0; j < 4; ++j) {
        const int nn = (lane >> 3) + 8 * j; const LAS float* s = scr + (8 * c) * 33 + nn;
        v4u o; o.x = pk2(s[0 * 33], s[1 * 33]); o.y = pk2(s[2 * 33], s[3 * 33]); o.z = pk2(s[4 * 33], s[5 * 33]); o.w = pk2(s[6 * 33], s[7 * 33]);
        *(v4u*)(WT + (size_t)(drow0 + nn) * K + k0 + 8 * c) = o;
    }
    LDS_WAIT(); asm volatile("" ::: "memory");
}

__device__ __forceinline__ void phase_prep(const Args& a, int z, LAS unsigned char* lds) {
    const int tid = threadIdx.x, lane = tid & 63, wave = tid >> 6;
    LAS float* scr = (LAS float*)(lds + wave * 16384);
    const int gw = blockIdx.x * NWAVES + wave, NGW = gridDim.x * NWAVES;
    unsigned char* ws = a.ws;
    constexpr int I_FI = 16 * 176, I_FO = 44 * 32, I_AI = 16 * 120, I_AO = 16 * 32, I_GI = 16 * 104, I_GO = 16 * 32;
    constexpr int NITEMS = 4 * I_FI + 4 * I_FO + I_AI + I_AO + I_GI + I_GO;
    for (int it = gw; it < NITEMS; it += NGW) {
        int r = it;
        if (r < 4 * I_FI) { const int i = r / I_FI, l = i >> 1, w2 = i & 1; r -= i * I_FI;
            if (i == 3) continue;
            transpose_item(a.in[z + (w2 ? 12 : 10)] + (size_t)l * D * NFI, D, NFI, (bf16*)(ws + WS_WFI + i * SZ_WFI), a.in[z + (w2 ? 8 : 6)] + l * D, 1, r, 176, scr, lane); continue; }
        r -= 4 * I_FI;
        if (r < 4 * I_FO) { const int i = r / I_FO, l = i >> 1, w2 = i & 1; r -= i * I_FO;
            if (i == 3) continue;
            transpose_item(a.in[z + (w2 ? 13 : 11)] + (size_t)l * DFF * D, DFF, D, (bf16*)(ws + WS_WFO + i * SZ_WFO), nullptr, 0, r, 32, scr, lane); continue; }
        r -= 4 * I_FO;
        if (r < I_AI) { transpose_item(a.in[z + (14)], D, NAB, (bf16*)(ws + WS_WAI), a.in[z + (7)], 0, r, 120, scr, lane); continue; }
        r -= I_AI;
        if (r < I_AO) { transpose_item(a.in[z + (15)], D, D, (bf16*)(ws + WS_WAO), nullptr, 0, r, 32, scr, lane); continue; }
        r -= I_AO;
        if (r < I_GI) { transpose_item(a.in[z + (24)], D, NGL, (bf16*)(ws + WS_WGI), a.in[z + (7)] + D, 0, r, 104, scr, lane); continue; }
        r -= I_GI;
        transpose_item(a.in[z + (28)], D, D, (bf16*)(ws + WS_WGO), nullptr, 0, r, 32, scr, lane);
    }
    bf16* XB = (bf16*)(ws + WS_XB); float* SSQ = (float*)(ws + WS_SSQ);
    for (int m = gw; m < T; m += NGW) {
        const float* src = (m < TP) ? a.in[z + (0)] + (size_t)m * D : a.in[z + (1)] + (size_t)(m - TP) * D;
        const f32x4* xr = (const f32x4*)src + lane;
        unsigned long long* o8 = (unsigned long long*)(XB + (size_t)m * D) + lane;
        float s = 0.f;
#pragma unroll
        for (int j = 0; j < 4; ++j) { const f32x4 v = xr[64 * j]; s += (v[0] * v[0] + v[1] * v[1]) + (v[2] * v[2] + v[3] * v[3]);
            o8[64 * j] = (unsigned long long)pk2(v[0], v[1]) | ((unsigned long long)pk2(v[2], v[3]) << 32); }
        s = wave_sum(s);
        if (lane < 16) SSQ[(size_t)m * 16 + lane] = (lane == 0) ? s : 0.f;
    }
}

__device__ __forceinline__ void prep_late(const Args& a, int z, LAS unsigned char* lds, int which, int rank, int nranks) {
    const int lane = threadIdx.x & 63, wave = threadIdx.x >> 6;
    LAS float* scr = (LAS float*)(lds + wave * 16384);
    constexpr int NFIi = 16 * 176, NALL = 16 * 176 + 44 * 32, HALFI = NALL / 2;
    const int lo = which ? HALFI : 0, hi = which ? NALL : HALFI;
    for (int it = lo + rank * NWAVES + wave; it < hi; it += nranks * NWAVES) {
        if (it >= NFIi) transpose_item(a.in[z + 13] + (size_t)DFF * D, DFF, D, (bf16*)(a.ws + WS_WFO + 3 * SZ_WFO), nullptr, 0, it - NFIi, 32, scr, lane);
        else transpose_item(a.in[z + 12] + (size_t)D * NFI, D, NFI, (bf16*)(a.ws + WS_WFI + 3 * SZ_WFI), a.in[z + 8] + D, 1, it, 176, scr, lane);
    }
}

constexpr int CK_QD = 0, CK_QS = 17408, CK_KI = 34816, CK_KET = 52224, CK_VT = 70656, CK_P = 75264, CK_ST = 84480, CK_SEG = 93184, CK_DEC = 95232,
              CK_OX = 95744, CK_DTS = 103936, CK_DTV = 104192, CK_GS = 104448;
constexpr int LQ = 136, LT = 72;
typedef short bf16x8_t __attribute__((ext_vector_type(8)));

__device__ __forceinline__ f32x4 mma_tile(const LAS bf16* F, int ldf, const LAS bf16* Sx, int lds_, int kc, f32x4 acc, int lane) {
    const int r = lane & 15, q = lane >> 4;
    const LAS bf16* fp = F + r * ldf + 8 * q; const LAS bf16* sp = Sx + r * lds_ + 8 * q;
    for (int k = 0; k < kc; k += 32) {
        const bf16x8_t fa = *(const LAS bf16x8_t*)(fp + k), sb = *(const LAS bf16x8_t*)(sp + k);
        acc = __builtin_amdgcn_mfma_f32_16x16x32_bf16(fa, sb, acc, 0, 0, 0);
    }
    return acc;
}

template <int TYPE>
__device__ __forceinline__ void chunk_unit(const Args& a, int z, int b, int h, int s, LAS unsigned char* lds) {
    constexpr int V = (TYPE == 0) ? 128 : (TYPE == 1) ? 64 : 256;
    constexpr int H = (TYPE == 1) ? 8 : 4;
    const int tid = threadIdx.x, lane = tid & 63, wave = tid >> 6, r = lane & 15, q = lane >> 4;
    LAS bf16* Qd = (LAS bf16*)(lds + CK_QD); LAS bf16* Qs = (TYPE == 1) ? (LAS bf16*)(lds + CK_QS) : Qd; LAS bf16* Ki = (LAS bf16*)(lds + CK_KI);
    LAS bf16* KeT = (LAS bf16*)(lds + CK_KET); LAS bf16* VT = (LAS bf16*)(lds + CK_VT); LAS bf16* P = (LAS bf16*)(lds + CK_P); LAS bf16* ST = (LAS bf16*)(lds + CK_ST);
    LAS float* SEG = (LAS float*)(lds + CK_SEG); LAS float* DEC = (LAS float*)(lds + CK_DEC); LAS float* OX = (LAS float*)(lds + CK_OX);
    LAS float* DTS = (LAS float*)(lds + CK_DTS); LAS float* DTV = (LAS float*)(lds + CK_DTV); LAS float* GS = (LAS float*)(lds + CK_GS);
    unsigned char* ws = a.ws;
    const bf16* PJ = (const bf16*)(ws + WS_PROJ);
    const float* LF = (const float*)(ws + WS_LF); const float* DT = (const float*)(ws + WS_DT); const float* GK = (const float*)(ws + WS_GK);
    bf16* OG = (bf16*)(ws + WS_OG);
    const int kl = tid & 127, seg = tid >> 7;
    const int vl = tid & 31, tq = tid >> 5;
    const int g = h >> 2;
    float a_h = 0.f, d_h = 0.f;
    if (TYPE == 1) { a_h = -__expf(a.in[z + 21][h]); d_h = a.in[z + 22][h]; }
    f32x4 sacc[2] = {(f32x4){0.f, 0.f, 0.f, 0.f}, (f32x4){0.f, 0.f, 0.f, 0.f}};
    __syncthreads();
    for (int e = tid; e < 32 * LQ / 2; e += 512) ((LAS unsigned*)ST)[e] = 0u;
    const int colbase = (TYPE == 0) ? h * 128 + s * 32 : (TYPE == 1) ? 512 + h * 64 + s * 32 : h * 256 + s * 32;
    const int tb = 16 * seg;
    constexpr int PP = (TYPE == 2) ? PG : PA;
    struct Raw { float lf[16]; unsigned q[16], k[16], v[4]; float dt; };
    const bf16* CV = (const bf16*)(ws + WS_XB);
    auto load_raw = [&](Raw& w, int n_) {
        const int row0_ = b * 2048 + n_ * 64;
#pragma unroll
        for (int i = 0; i < 16; ++i) { const size_t R = (size_t)(row0_ + tb + i);
            if (TYPE != 1) { w.lf[i] = LF[R * 512 + h * 128 + kl]; w.q[i] = PJ[R * PP + h * 128 + kl]; if (TYPE == 2) w.k[i] = PJ[R * PP + 512 + h * 128 + kl]; }
            else { w.q[i] = CV[R * 1024 + 768 + g * 128 + kl]; w.k[i] = CV[R * 1024 + 512 + g * 128 + kl]; } }
#pragma unroll
        for (int i = 0; i < 4; ++i) { const size_t R = (size_t)(row0_ + 4 * tq + i);
            w.v[i] = (TYPE == 1) ? CV[R * 1024 + h * 64 + s * 32 + vl] : PJ[R * PP + 1024 + h * V + s * 32 + vl]; }
        if (TYPE == 1) w.dt = (tid < 64) ? DT[(size_t)(row0_ + tid) * 8 + h] : 0.f;
    };
    Raw rc, rn;
    load_raw(rc, 0);
    for (int n = 0; n < 32; ++n) {
        const int row0 = b * 2048 + n * 64;
        if (n + 1 < 32) load_raw(rn, n + 1);
        float glast, goff;
        if (TYPE != 1) {
            float run = 0.f;
#pragma unroll
            for (int i = 0; i < 16; ++i) run += rc.lf[i];
            SEG[seg * 128 + kl] = run;
            __syncthreads();
            const float s0 = SEG[kl], s1 = SEG[128 + kl], s2 = SEG[256 + kl], s3 = SEG[384 + kl];
            goff = (seg > 0 ? s0 : 0.f) + (seg > 1 ? s1 : 0.f) + (seg > 2 ? s2 : 0.f);
            glast = (s0 + s1) + (s2 + s3);
        } else {
            if (tid < 64) { DTS[tid] = rc.dt * a_h; DTV[tid] = rc.dt; }
            __syncthreads();
            float off = 0.f, tot = 0.f;
            for (int t = 0; t < 64; t += 4) { const f32x4 d4 = *(const LAS f32x4*)(DTS + t); const float d = (d4[0] + d4[1]) + (d4[2] + d4[3]); tot += d; if (t < tb) off += d; }
            glast = tot; goff = off;
        }
        {
            const float eglast = __expf(glast);
            unsigned kew[8];
            float grun = goff;
#pragma unroll
            for (int i = 0; i < 16; i += 2) {
                float q0, q1, k0, k1, g0, g1;
                q0 = __uint_as_float(rc.q[i] << 16); q1 = __uint_as_float(rc.q[i + 1] << 16);
                if (TYPE == 0) { k0 = 1.f - __expf(rc.lf[i]); k1 = 1.f - __expf(rc.lf[i + 1]); }
                else { k0 = __uint_as_float(rc.k[i] << 16); k1 = __uint_as_float(rc.k[i + 1] << 16); }
                if (TYPE != 1) { grun += rc.lf[i]; g0 = grun; grun += rc.lf[i + 1]; g1 = grun; }
                else { grun += DTS[tb + i]; g0 = grun; grun += DTS[tb + i + 1]; g1 = grun; if (kl == 0) { GS[tb + i] = g0; GS[tb + i + 1] = g1; } }
                const float e0 = __expf(g0), e1 = __expf(g1);
                const int t = tb + i;
                if (TYPE == 1) {
                    const unsigned cq = pk2(q0, q1), ck = pk2(k0, k1);
                    Qs[t * LQ + kl] = (bf16)(cq & 0xffffu); Qs[(t + 1) * LQ + kl] = (bf16)(cq >> 16);
                    Ki[t * LQ + kl] = (bf16)(ck & 0xffffu); Ki[(t + 1) * LQ + kl] = (bf16)(ck >> 16);
                    kew[i >> 1] = pk2(k0 * __expf(glast - g0), k1 * __expf(glast - g1));
                } else {
                    const float i0 = __builtin_amdgcn_rcpf(e0), i1 = __builtin_amdgcn_rcpf(e1);
                    const unsigned kk = pk2(k0 * i0, k1 * i1);
                    Ki[t * LQ + kl] = (bf16)(kk & 0xffffu); Ki[(t + 1) * LQ + kl] = (bf16)(kk >> 16);
                    kew[i >> 1] = pk2(k0 * (eglast * i0), k1 * (eglast * i1));
                }
                const unsigned qq = pk2(q0 * e0, q1 * e1);
                Qd[t * LQ + kl] = (bf16)(qq & 0xffffu); Qd[(t + 1) * LQ + kl] = (bf16)(qq >> 16);
            }
            *(LAS v4u*)(KeT + kl * LT + tb) = (v4u){kew[0], kew[1], kew[2], kew[3]};
            *(LAS v4u*)(KeT + kl * LT + tb + 8) = (v4u){kew[4], kew[5], kew[6], kew[7]};
            if (seg == 0) DEC[kl] = eglast;
        }
        {
            if (TYPE != 1) {
                *(LAS v2u*)(VT + vl * LT + 4 * tq) = (v2u){rc.v[0] | (rc.v[1] << 16), rc.v[2] | (rc.v[3] << 16)};
            } else {
                float vv4[4];
#pragma unroll
                for (int i = 0; i < 4; ++i) { const float x = __uint_as_float(rc.v[i] << 16); OX[(4 * tq + i) * 32 + vl] = d_h * x; vv4[i] = x * DTV[4 * tq + i]; }
                *(LAS v2u*)(VT + vl * LT + 4 * tq) = (v2u){pk2(vv4[0], vv4[1]), pk2(vv4[2], vv4[3])};
            }
        }
        __syncthreads();
#pragma unroll
        for (int u2 = 0; u2 < 2; ++u2) {
            const int t = 2 * wave + u2, ti = t >> 2, tj = t & 3;
            v2u w = (v2u){0u, 0u};
            if (tj <= ti) {
                f32x4 acc = (f32x4){0.f, 0.f, 0.f, 0.f};
                acc = mma_tile(Ki + tj * 16 * LQ, LQ, Qs + ti * 16 * LQ, LQ, 128, acc, lane);
                const int i = 16 * ti + r, j0 = 16 * tj + 4 * q;
                float pv[4];
#pragma unroll
                for (int e = 0; e < 4; ++e) { float x = acc[e];
                    if (TYPE == 1) x *= __expf(fminf(GS[i] - GS[j0 + e], 0.f));
                    pv[e] = (j0 + e <= i) ? x : 0.f; }
                w = (v2u){pk2(pv[0], pv[1]), pk2(pv[2], pv[3])};
            }
            *(LAS v2u*)(P + (16 * ti + r) * LT + 16 * tj + 4 * q) = w;
        }
        __syncthreads();
        {
            const int ti = wave >> 1, tv = wave & 1;
            f32x4 acc = (f32x4){0.f, 0.f, 0.f, 0.f};
            acc = mma_tile(VT + tv * 16 * LT, LT, P + ti * 16 * LT, LT, (ti < 2) ? 32 : 64, acc, lane);
            acc = mma_tile(ST + tv * 16 * LQ, LQ, Qd + ti * 16 * LQ, LQ, 128, acc, lane);
            const int i = 16 * ti + r, v0 = 16 * tv + 4 * q;
            if (TYPE == 1) { const f32x4 ox = *(const LAS f32x4*)(OX + i * 32 + v0); acc = acc + ox; }
            *(v2u*)(OG + (size_t)(row0 + i) * D + colbase + v0) = (v2u){pk2(acc[0], acc[1]), pk2(acc[2], acc[3])};
        }
#pragma unroll
        for (int u2 = 0; u2 < 2; ++u2) {
            const int ti = 2 * wave + u2, vt = ti >> 3, kt = ti & 7;
            const f32x4 dc = *(const LAS f32x4*)(DEC + 16 * kt + 4 * q);
            sacc[u2] = sacc[u2] * dc;
            sacc[u2] = mma_tile(KeT + kt * 16 * LT, LT, VT + vt * 16 * LT, LT, 64, sacc[u2], lane);
        }
        __syncthreads();
#pragma unroll
        for (int u2 = 0; u2 < 2; ++u2) {
            const int ti = 2 * wave + u2, vt = ti >> 3, kt = ti & 7;
            *(LAS v2u*)(ST + (16 * vt + r) * LQ + 16 * kt + 4 * q) = (v2u){pk2(sacc[u2][0], sacc[u2][1]), pk2(sacc[u2][2], sacc[u2][3])};
        }
        rc = rn;
    }
#pragma unroll
    for (int u2 = 0; u2 < 2; ++u2) {
        const int ti = 2 * wave + u2, vt = ti >> 3, kt = ti & 7;
        const int k0 = 16 * kt + 4 * q, v = 16 * vt + r;
        if (TYPE == 1) {
            *(f32x4*)(a.out + O_SP + ((size_t)(b * 8 + h) * 64 + s * 32 + v) * 128 + k0) = sacc[u2];
        } else {
            float* dp = a.out + (TYPE == 0 ? O_HP : O_GP) + (size_t)(b * H + h) * 128 * V + s * 32 + v;
#pragma unroll
            for (int e = 0; e < 4; ++e) dp[(size_t)(k0 + e) * V] = sacc[u2][e];
        }
    }
    __syncthreads();
}

constexpr int RECA = 36352, RECP = 9216;
constexpr size_t WS_PREA = WS_END;
constexpr size_t WS_PREP_V = WS_WFI, WS_PREP_S = WS_WFO;
constexpr size_t WS_NEED = WS_PREA + (size_t)1536 * RECA;

template <int TYPE>
__device__ __forceinline__ void pre_unit(const Args& a, int z, int b, int h, int n, int rec, LAS unsigned char* lds) {
    const int tid = threadIdx.x, lane = tid & 63, wave = __builtin_amdgcn_readfirstlane(tid >> 6), r = lane & 15, q = lane >> 4;
    LAS bf16* Qd = (LAS bf16*)(lds + CK_QD); LAS bf16* Qs = (LAS bf16*)(lds + CK_QS); LAS bf16* Ki = (LAS bf16*)(lds + CK_KI);
    LAS bf16* KeT = (LAS bf16*)(lds + CK_KET); LAS bf16* P = (LAS bf16*)(lds + CK_P);
    LAS float* SEG = (LAS float*)(lds + CK_SEG); LAS float* DEC = (LAS float*)(lds + CK_DEC);
    unsigned char* ws = a.ws;
    const bf16* PJ = (const bf16*)(ws + WS_PROJ); const float* LF = (const float*)(ws + WS_LF); const bf16* CV = (const bf16*)(ws + WS_XB);
    const int kl = tid & 127, seg = tid >> 7, tb = 16 * seg;
    constexpr int PP = (TYPE == 2) ? PG : PA;
    const int row0 = b * 2048 + n * 64;
    float lf[16]; unsigned rq[16], rk[16];
#pragma unroll
    for (int i = 0; i < 16; ++i) { const size_t R = (size_t)(row0 + tb + i);
        if (TYPE == 0) { lf[i] = LF[R * 512 + h * 128 + kl]; rq[i] = PJ[R * PP + h * 128 + kl]; }
        else if (TYPE == 2) { rq[i] = PJ[R * PP + h * 128 + kl]; rk[i] = PJ[R * PP + 512 + h * 128 + kl]; } }
    if (TYPE == 2) {
        const float* GK = (const float*)(ws + WS_GK);
        float wg[16];
#pragma unroll
        for (int r2 = 0; r2 < 16; ++r2) wg[r2] = a.in[z + 25][r2 * 512 + h * 128 + kl];
        const float bg = a.in[z + 26][h * 128 + kl];
#pragma unroll
        for (int i = 0; i < 16; ++i) { const size_t R = (size_t)(row0 + tb + i);
            const f32x4 g0 = *(const f32x4*)(GK + R * 16), g1 = *(const f32x4*)(GK + R * 16 + 4), g2 = *(const f32x4*)(GK + R * 16 + 8), g3 = *(const f32x4*)(GK + R * 16 + 12);
            float x = bg;
#pragma unroll
            for (int j = 0; j < 4; ++j) x += g0[j] * wg[j] + g1[j] * wg[4 + j] + g2[j] * wg[8 + j] + g3[j] * wg[12 + j];
            lf[i] = -softplus_f(-x) * (1.f / 16.f); }
    }
    if (TYPE == 1) {
        float rb[19], rcc[19];
#pragma unroll
        for (int i = 0; i < 19; ++i) { const int tt = n * 64 + tb - 3 + i;
            if (tt >= 0) { const size_t R2 = (size_t)(b * 2048 + tt); rb[i] = bf2f(PJ[R2 * PA + 2560 + 512 + h * 128 + kl]); rcc[i] = bf2f(PJ[R2 * PA + 2560 + 768 + h * 128 + kl]); }
            else { rb[i] = 0.f; rcc[i] = 0.f; } }
        float cwB[4], cwC[4];
#pragma unroll
        for (int w = 0; w < 4; ++w) { cwB[w] = a.in[z + 18][w * 1024 + 512 + h * 128 + kl]; cwC[w] = a.in[z + 18][w * 1024 + 768 + h * 128 + kl]; }
        const float cbB = a.in[z + 19][512 + h * 128 + kl], cbC = a.in[z + 19][768 + h * 128 + kl];
#pragma unroll
        for (int i = 0; i < 16; i += 2) { float ab0 = cbB, ac0 = cbC, ab1 = cbB, ac1 = cbC;
#pragma unroll
            for (int w = 0; w < 4; ++w) { ab0 += rb[i + w] * cwB[w]; ac0 += rcc[i + w] * cwC[w]; ab1 += rb[i + 1 + w] * cwB[w]; ac1 += rcc[i + 1 + w] * cwC[w]; }
            const unsigned pb = pk2(silu_f(ab0), silu_f(ab1)), pc = pk2(silu_f(ac0), silu_f(ac1));
            rk[i] = pb & 0xffffu; rk[i + 1] = pb >> 16; rq[i] = pc & 0xffffu; rq[i + 1] = pc >> 16; }
        {
            const int xc = h * 256 + (tid & 255), t0x = 32 * (tid >> 8);
            bf16* CVw = (bf16*)(ws + WS_XB);
            float cwX[4];
#pragma unroll
            for (int w = 0; w < 4; ++w) cwX[w] = a.in[z + 18][w * 1024 + xc];
            const float cbX = a.in[z + 19][xc];
            float w3[3];
#pragma unroll
            for (int j = 0; j < 3; ++j) { const int tt = n * 64 + t0x - 3 + j; w3[j] = (tt >= 0) ? bf2f(PJ[(size_t)(b * 2048 + tt) * PA + 2560 + xc]) : 0.f; }
            for (int t8 = 0; t8 < 32; t8 += 8) {
                float nw[8];
#pragma unroll
                for (int j = 0; j < 8; ++j) nw[j] = bf2f(PJ[(size_t)(row0 + t0x + t8 + j) * PA + 2560 + xc]);
#pragma unroll
                for (int j = 0; j < 8; ++j) { const float ax = cbX + w3[0] * cwX[0] + w3[1] * cwX[1] + w3[2] * cwX[2] + nw[j] * cwX[3];
                    CVw[(size_t)(row0 + t0x + t8 + j) * 1024 + xc] = (bf16)(pk2(silu_f(ax), 0.f) & 0xffffu);
                    w3[0] = w3[1]; w3[1] = w3[2]; w3[2] = nw[j]; }
            }
        }
    }
    if (TYPE != 1) {
        float run = 0.f;
#pragma unroll
        for (int i = 0; i < 16; ++i) run += lf[i];
        SEG[seg * 128 + kl] = run;
        __syncthreads();
        const float s0 = SEG[kl], s1 = SEG[128 + kl], s2 = SEG[256 + kl], s3 = SEG[384 + kl];
        const float goff = (seg > 0 ? s0 : 0.f) + (seg > 1 ? s1 : 0.f) + (seg > 2 ? s2 : 0.f);
        const float glast = (s0 + s1) + (s2 + s3), eglast = __expf(glast);
        unsigned kew[8]; float grun = goff;
#pragma unroll
        for (int i = 0; i < 16; i += 2) {
            const float q0 = __uint_as_float(rq[i] << 16), q1 = __uint_as_float(rq[i + 1] << 16);
            float k0, k1;
            if (TYPE == 0) { k0 = 1.f - __expf(lf[i]); k1 = 1.f - __expf(lf[i + 1]); } else { k0 = __uint_as_float(rk[i] << 16); k1 = __uint_as_float(rk[i + 1] << 16); }
            grun += lf[i]; const float g0 = grun; grun += lf[i + 1]; const float g1 = grun;
            const float e0 = __expf(g0), e1 = __expf(g1), i0 = __builtin_amdgcn_rcpf(e0), i1 = __builtin_amdgcn_rcpf(e1);
            const int t = tb + i;
            const unsigned kk = pk2(k0 * i0, k1 * i1), qq = pk2(q0 * e0, q1 * e1);
            Ki[t * LQ + kl] = (bf16)(kk & 0xffffu); Ki[(t + 1) * LQ + kl] = (bf16)(kk >> 16);
            Qd[t * LQ + kl] = (bf16)(qq & 0xffffu); Qd[(t + 1) * LQ + kl] = (bf16)(qq >> 16);
            kew[i >> 1] = pk2(k0 * (eglast * i0), k1 * (eglast * i1));
        }
        *(LAS v4u*)(KeT + kl * LT + tb) = (v4u){kew[0], kew[1], kew[2], kew[3]};
        *(LAS v4u*)(KeT + kl * LT + tb + 8) = (v4u){kew[4], kew[5], kew[6], kew[7]};
        if (seg == 0) DEC[kl] = eglast;
    } else {
        unsigned kew[8];
#pragma unroll
        for (int i = 0; i < 16; i += 2) { const int t = tb + i;
            Qs[t * LQ + kl] = (bf16)rq[i]; Qs[(t + 1) * LQ + kl] = (bf16)rq[i + 1];
            Ki[t * LQ + kl] = (bf16)rk[i]; Ki[(t + 1) * LQ + kl] = (bf16)rk[i + 1];
            kew[i >> 1] = rk[i] | (rk[i + 1] << 16); }
        *(LAS v4u*)(KeT + kl * LT + tb) = (v4u){kew[0], kew[1], kew[2], kew[3]};
        *(LAS v4u*)(KeT + kl * LT + tb + 8) = (v4u){kew[4], kew[5], kew[6], kew[7]};
    }
    __syncthreads();
    {
        LAS bf16* Qx = (TYPE == 1) ? Qs : Qd;
#pragma unroll
        for (int u2 = 0; u2 < 2; ++u2) {
            const int t = 2 * wave + u2, ti = t >> 2, tj = t & 3;
            v2u w = (v2u){0u, 0u};
            if (tj <= ti) {
                f32x4 acc = (f32x4){0.f, 0.f, 0.f, 0.f};
                acc = mma_tile(Ki + tj * 16 * LQ, LQ, Qx + ti * 16 * LQ, LQ, 128, acc, lane);
                const int i = 16 * ti + r, j0 = 16 * tj + 4 * q;
                float pv[4];
#pragma unroll
                for (int e = 0; e < 4; ++e) pv[e] = (TYPE == 1 || j0 + e <= i) ? acc[e] : 0.f;
                w = (v2u){pk2(pv[0], pv[1]), pk2(pv[2], pv[3])};
            }
            *(LAS v2u*)(P + (16 * ti + r) * LT + 16 * tj + 4 * q) = w;
        }
    }
    __syncthreads();
    {
        unsigned char* ra = ws + WS_PREA + (size_t)rec * RECA;
        unsigned char* rp = ws + ((TYPE == 1) ? WS_PREP_S : WS_PREP_V) + (size_t)((TYPE == 1) ? rec - 1024 : rec) * RECP;
        const LAS unsigned char* s0 = lds + ((TYPE == 1) ? CK_QS : CK_QD);
        for (int p = tid; p < 1088; p += 512) *(v4u*)(ra + 16 * p) = *(const LAS v4u*)(s0 + 16 * p);
        for (int p = tid; p < 1152; p += 512) *(v4u*)(ra + 17408 + 16 * p) = *(const LAS v4u*)(lds + CK_KET + 16 * p);
        if (TYPE != 1 && tid < 32) *(v4u*)(ra + 35840 + 16 * tid) = *(const LAS v4u*)(lds + CK_DEC + 16 * tid);
        for (int p = tid; p < 576; p += 512) *(v4u*)(rp + 16 * p) = *(const LAS v4u*)(lds + CK_P + 16 * p);
    }
    __syncthreads();
}

constexpr int S2_QD = 0, S2_KET = 17408, S2_DEC = 35840, S2_P = 36352, S2_VT = 45568, S2_ST = 50176, S2_VT2 = 58880, S2_OX = 63488, S2_GS = 71680, S2_EG = 72192, S2_DTV = 72704, S2_GL = 73216;
template <int TYPE>
__device__ __forceinline__ void seq2_unit(const Args& a, int z, int b, int h, int s, LAS unsigned char* lds) {
    constexpr int V = (TYPE == 0) ? 128 : (TYPE == 1) ? 64 : 256;
    constexpr int H = (TYPE == 1) ? 8 : 4;
    const int tid = threadIdx.x, lane = tid & 63, wave = __builtin_amdgcn_readfirstlane(tid >> 6), r = lane & 15, q = lane >> 4;
    LAS bf16* Qd = (LAS bf16*)(lds + S2_QD); LAS bf16* KeT = (LAS bf16*)(lds + S2_KET); LAS float* DEC = (LAS float*)(lds + S2_DEC);
    LAS bf16* P = (LAS bf16*)(lds + S2_P); LAS bf16* VT = (LAS bf16*)(lds + S2_VT); LAS bf16* ST = (LAS bf16*)(lds + S2_ST); LAS bf16* VT2 = (LAS bf16*)(lds + S2_VT2);
    LAS float* OX = (LAS float*)(lds + S2_OX); LAS float* GS = (LAS float*)(lds + S2_GS); LAS float* EG = (LAS float*)(lds + S2_EG); LAS float* DTV = (LAS float*)(lds + S2_DTV);
    LAS float* GL = (LAS float*)(lds + S2_GL);
    unsigned char* ws = a.ws;
    const bf16* PJ = (const bf16*)(ws + WS_PROJ); const float* DT = (const float*)(ws + WS_DT); const bf16* CV = (const bf16*)(ws + WS_XB);
    bf16* OG = (bf16*)(ws + WS_OG);
    const int vl = tid & 31, tq = tid >> 5;
    constexpr int PP = (TYPE == 2) ? PG : PA;
    float a_h = 0.f, d_h = 0.f;
    if (TYPE == 1) { a_h = -__expf(a.in[z + 21][h]); d_h = a.in[z + 22][h]; }
    const int rec0 = (TYPE == 1) ? 1024 + (b * 2 + (h >> 2)) * 32 : (b * 4 + h) * 32;
    const unsigned char* ra0 = ws + WS_PREA + (size_t)rec0 * RECA;
    const unsigned char* rp0 = ws + ((TYPE == 1) ? WS_PREP_S + (size_t)(rec0 - 1024) * RECP : WS_PREP_V + (size_t)rec0 * RECP);
    constexpr int NA = (TYPE == 1) ? 2240 : 2272;
    struct Pre { v4u a[5]; v4u p[2]; unsigned v[4]; float dt; };
    auto load_pre = [&](Pre& w, int n_) {
        const unsigned char* ra = ra0 + (size_t)n_ * RECA; const unsigned char* rp = rp0 + (size_t)n_ * RECP;
#pragma unroll
        for (int j = 0; j < 5; ++j) { const int p = tid + 512 * j; if (p < NA) w.a[j] = *(const v4u*)(ra + 16 * p); }
        w.p[0] = *(const v4u*)(rp + 16 * tid); if (tid < 64) w.p[1] = *(const v4u*)(rp + 16 * (tid + 512));
        const int row0_ = b * 2048 + n_ * 64;
#pragma unroll
        for (int i = 0; i < 4; ++i) { const size_t R = (size_t)(row0_ + 4 * tq + i);
            w.v[i] = (TYPE == 1) ? CV[R * 1024 + h * 64 + s * 32 + vl] : PJ[R * PP + 1024 + h * V + s * 32 + vl]; }
        if (TYPE == 1) w.dt = (tid < 64) ? DT[(size_t)(row0_ + tid) * 8 + h] : 0.f;
    };
    f32x4 sacc[2] = {(f32x4){0.f, 0.f, 0.f, 0.f}, (f32x4){0.f, 0.f, 0.f, 0.f}};
    __syncthreads();
    for (int e = tid; e < 32 * LQ / 2; e += 512) ((LAS unsigned*)ST)[e] = 0u;
    const int colbase = (TYPE == 0) ? h * 128 + s * 32 : (TYPE == 1) ? 512 + h * 64 + s * 32 : h * 256 + s * 32;
    Pre rc, rn;
    load_pre(rc, 0);
    float dt1 = 0.f, dt2 = 0.f;
    auto scan_into = [&](float dtv, int buf) {
        float x = dtv * a_h;
#pragma unroll
        for (int o = 1; o < 64; o <<= 1) { const float y = __shfl_up(x, o); if (lane >= o) x += y; }
        GS[64 * buf + lane] = x; EG[64 * buf + lane] = __expf(x); DTV[64 * buf + lane] = dtv; if (lane == 63) GL[buf] = x;
    };
    if (TYPE == 1) {
        if (wave == 0) { scan_into(rc.dt, 0); dt1 = DT[(size_t)(b * 2048 + 64 + lane) * 8 + h]; }
        __syncthreads();
    }
    for (int n = 0; n < 32; ++n) {
        const int row0 = b * 2048 + n * 64;
        const int sb = n & 1;
        if (n + 1 < 32) load_pre(rn, n + 1);
        if (TYPE == 1 && wave == 0 && n + 2 < 32) dt2 = DT[(size_t)(b * 2048 + (n + 2) * 64 + lane) * 8 + h];
#pragma unroll
        for (int j = 0; j < 5; ++j) { const int p = tid + 512 * j; if (p < NA) *(LAS v4u*)(lds + 16 * p) = rc.a[j]; }
        if (TYPE != 1) {
            *(LAS v4u*)(lds + S2_P + 16 * tid) = rc.p[0]; if (tid < 64) *(LAS v4u*)(lds + S2_P + 16 * (tid + 512)) = rc.p[1];
            *(LAS v2u*)(VT + vl * LT + 4 * tq) = (v2u){rc.v[0] | (rc.v[1] << 16), rc.v[2] | (rc.v[3] << 16)};
        } else {
            const LAS float* GSb = GS + 64 * sb; const LAS float* DTVb = DTV + 64 * sb;
            const float glast = GL[sb];
#pragma unroll
            for (int jj = 0; jj < 2; ++jj) {
                const int p = tid + 512 * jj;
                if (jj == 0 || tid < 64) {
                    const int i = p / 9, c8 = p - 9 * i; v4u c = rc.p[jj];
                    if (c8 < 8) {
                        const int j0 = 8 * c8; const unsigned cw[4] = {c.x, c.y, c.z, c.w}; unsigned o[4];
                        const float gi = GSb[i];
#pragma unroll
                        for (int e = 0; e < 4; ++e) { const int j = j0 + 2 * e;
                            const float x0 = (j <= i) ? __uint_as_float(cw[e] << 16) * __expf(gi - GSb[j]) : 0.f;
                            const float x1 = (j + 1 <= i) ? __uint_as_float(cw[e] & 0xffff0000u) * __expf(gi - GSb[j + 1]) : 0.f;
                            o[e] = pk2(x0, x1); }
                        c = (v4u){o[0], o[1], o[2], o[3]};
                    }
                    *(LAS v4u*)(lds + S2_P + 16 * p) = c;
                }
            }
            {
                float v1[4], v2[4];
#pragma unroll
                for (int i = 0; i < 4; ++i) { const int t = 4 * tq + i; const float x = __uint_as_float(rc.v[i] << 16); OX[t * 32 + vl] = d_h * x; v1[i] = x * DTVb[t]; v2[i] = v1[i] * __expf(glast - GSb[t]); }
                *(LAS v2u*)(VT + vl * LT + 4 * tq) = (v2u){pk2(v1[0], v1[1]), pk2(v1[2], v1[3])};
                *(LAS v2u*)(VT2 + vl * LT + 4 * tq) = (v2u){pk2(v2[0], v2[1]), pk2(v2[2], v2[3])};
            }
        }
        __syncthreads();
        if (TYPE == 1 && wave == 0 && n + 1 < 32) scan_into(dt1, sb ^ 1);
        {
            const int ti = wave >> 1, tv = wave & 1;
            f32x4 acc = (f32x4){0.f, 0.f, 0.f, 0.f}, acc2 = (f32x4){0.f, 0.f, 0.f, 0.f};
            acc = mma_tile(VT + tv * 16 * LT, LT, P + ti * 16 * LT, LT, (ti < 2) ? 32 : 64, acc, lane);
            acc2 = mma_tile(ST + tv * 16 * LQ, LQ, Qd + ti * 16 * LQ, LQ, 128, acc2, lane);
            const int i = 16 * ti + r, v0 = 16 * tv + 4 * q;
            if (TYPE == 1) { const f32x4 ox = *(const LAS f32x4*)(OX + i * 32 + v0); acc = acc + acc2 * EG[64 * sb + i] + ox; } else acc = acc + acc2;
            *(v2u*)(OG + (size_t)(row0 + i) * D + colbase + v0) = (v2u){pk2(acc[0], acc[1]), pk2(acc[2], acc[3])};
        }
#pragma unroll
        for (int u2 = 0; u2 < 2; ++u2) {
            const int ti = 2 * wave + u2, vt = ti >> 3, kt = ti & 7;
            if (TYPE == 1) { const float dc = __expf(GL[sb]); sacc[u2] = sacc[u2] * dc; }
            else { const f32x4 dc = *(const LAS f32x4*)(DEC + 16 * kt + 4 * q); sacc[u2] = sacc[u2] * dc; }
            sacc[u2] = mma_tile(KeT + kt * 16 * LT, LT, ((TYPE == 1) ? VT2 : VT) + vt * 16 * LT, LT, 64, sacc[u2], lane);
        }
        __syncthreads();
#pragma unroll
        for (int u2 = 0; u2 < 2; ++u2) {
            const int ti = 2 * wave + u2, vt = ti >> 3, kt = ti & 7;
            *(LAS v2u*)(ST + (16 * vt + r) * LQ + 16 * kt + 4 * q) = (v2u){pk2(sacc[u2][0], sacc[u2][1]), pk2(sacc[u2][2], sacc[u2][3])};
        }
        rc = rn; dt1 = dt2;
    }
#pragma unroll
    for (int u2 = 0; u2 < 2; ++u2) {
        const int ti = 2 * wave + u2, vt = ti >> 3, kt = ti & 7;
        const int k0 = 16 * kt + 4 * q, v = 16 * vt + r;
        if (TYPE == 1) {
            *(f32x4*)(a.out + O_SP + ((size_t)(b * 8 + h) * 64 + s * 32 + v) * 128 + k0) = sacc[u2];
        } else {
            float* dp = a.out + (TYPE == 0 ? O_HP : O_GP) + (size_t)(b * H + h) * 128 * V + s * 32 + v;
#pragma unroll
            for (int e = 0; e < 4; ++e) dp[(size_t)(k0 + e) * V] = sacc[u2][e];
        }
    }
    __syncthreads();
}

template <int TYPE>
__device__ __forceinline__ void samp_unit(const Args& a, int z, int sx, int h, int s, LAS float* W, int lane) {
    constexpr int V = (TYPE == 0) ? 128 : (TYPE == 1) ? 64 : 256;
    constexpr int H = (TYPE == 1) ? 8 : 4;
    const int v = lane & 31, kh = lane >> 5;
    const int row0 = TP + sx * 4;
    unsigned char* ws = a.ws;
    const bf16* PJ = (const bf16*)(ws + WS_PROJ);
    const float* LF = (const float*)(ws + WS_LF); const float* DT = (const float*)(ws + WS_DT); const float* GK = (const float*)(ws + WS_GK);
    bf16* OG = (bf16*)(ws + WS_OG);
    LAS float* Wq = W; LAS float* Wk = W + 512; LAS float* Wf = W + 1024;
    float S[64];
    if (TYPE == 1) {
        const float* sp = a.in[z + 3] + ((size_t)(sx * 8 + h) * 64 + s * 32 + v) * 128 + 64 * kh;
#pragma unroll
        for (int j = 0; j < 16; ++j) { const f32x4 x = *(const f32x4*)(sp + 4 * j); S[4 * j] = x[0]; S[4 * j + 1] = x[1]; S[4 * j + 2] = x[2]; S[4 * j + 3] = x[3]; }
    } else {
        const float* sp = a.in[z + (TYPE == 0 ? 2 : 5)] + (size_t)(sx * H + h) * 128 * V + (size_t)(64 * kh) * V + s * 32 + v;
#pragma unroll
        for (int i = 0; i < 64; ++i) S[i] = sp[(size_t)i * V];
    }
    float vt[4], xsk[4] = {0.f, 0.f, 0.f, 0.f};
    if (TYPE == 0) {
#pragma unroll
        for (int t = 0; t < 4; ++t) { const size_t R = (size_t)(row0 + t);
#pragma unroll
            for (int c = 0; c < 2; ++c) { const int kk = lane + 64 * c; const float f = __expf(LF[R * 512 + h * 128 + kk]);
                Wq[t * 128 + kk] = bf2f(PJ[R * PA + h * 128 + kk]); Wk[t * 128 + kk] = 1.f - f; Wf[t * 128 + kk] = f; }
            vt[t] = bf2f(PJ[R * PA + 1024 + h * 128 + s * 32 + v]); }
    } else if (TYPE == 2) {
#pragma unroll
        for (int c = 0; c < 2; ++c) { const int kk = lane + 64 * c;
            float wg[16];
#pragma unroll
            for (int r = 0; r < 16; ++r) wg[r] = a.in[z + 25][r * 512 + h * 128 + kk];
            const float bg = a.in[z + 26][h * 128 + kk];
#pragma unroll
            for (int t = 0; t < 4; ++t) { const size_t R = (size_t)(row0 + t); float x = bg;
#pragma unroll
                for (int r = 0; r < 16; ++r) x += GK[R * 16 + r] * wg[r];
                Wf[t * 128 + kk] = __expf(-softplus_f(-x) * (1.f / 16.f));
                Wq[t * 128 + kk] = bf2f(PJ[R * PG + h * 128 + kk]); Wk[t * 128 + kk] = bf2f(PJ[R * PG + 512 + h * 128 + kk]); } }
#pragma unroll
        for (int t = 0; t < 4; ++t) vt[t] = bf2f(PJ[(size_t)(row0 + t) * PG + 1024 + h * 256 + s * 32 + v]);
    } else {
        const int g = h >> 2;
        const float* cst = a.in[z + 4] + (size_t)sx * 3 * 1024;
        const float a_h = -__expf(a.in[z + 21][h]), d_h = a.in[z + 22][h];
        float dtv[4];
#pragma unroll
        for (int t = 0; t < 4; ++t) dtv[t] = DT[(size_t)(row0 + t) * 8 + h];
#pragma unroll
        for (int c = 0; c < 2; ++c) { const int kk = lane + 64 * c;
#pragma unroll
            for (int bc = 0; bc < 2; ++bc) { const int ch = (bc ? 768 : 512) + g * 128 + kk;
                float raw[7];
#pragma unroll
                for (int j = 0; j < 7; ++j) raw[j] = (j < 3) ? cst[j * 1024 + ch] : bf2f(PJ[(size_t)(row0 + j - 3) * PA + 2560 + ch]);
                const float cb = a.in[z + 19][ch];
#pragma unroll
                for (int t = 0; t < 4; ++t) { float acc = cb;
#pragma unroll
                    for (int w = 0; w < 4; ++w) acc += raw[t + w] * a.in[z + 18][w * 1024 + ch];
                    (bc ? Wq : Wk)[t * 128 + kk] = silu_f(acc); } }
#pragma unroll
            for (int t = 0; t < 4; ++t) Wf[t * 128 + kk] = __expf(dtv[t] * a_h); }
        { const int ch = h * 64 + s * 32 + v; float raw[7];
#pragma unroll
            for (int j = 0; j < 7; ++j) raw[j] = (j < 3) ? cst[j * 1024 + ch] : bf2f(PJ[(size_t)(row0 + j - 3) * PA + 2560 + ch]);
            const float cb = a.in[z + 19][ch];
#pragma unroll
            for (int t = 0; t < 4; ++t) { float acc = cb;
#pragma unroll
                for (int w = 0; w < 4; ++w) acc += raw[t + w] * a.in[z + 18][w * 1024 + ch];
                const float x = silu_f(acc); vt[t] = x * dtv[t]; xsk[t] = d_h * x; } }
    }
    asm volatile("s_waitcnt lgkmcnt(0)" ::: "memory"); __builtin_amdgcn_wave_barrier();
    const int colbase = (TYPE == 0) ? h * 128 + s * 32 : (TYPE == 1) ? 512 + h * 64 + s * 32 : h * 256 + s * 32;
#pragma unroll
    for (int t = 0; t < 4; ++t) {
        float p = 0.f;
#pragma unroll
        for (int j = 0; j < 16; ++j) {
            const f32x4 q4 = *(const LAS f32x4*)(Wq + t * 128 + 64 * kh + 4 * j), k4 = *(const LAS f32x4*)(Wk + t * 128 + 64 * kh + 4 * j), f4 = *(const LAS f32x4*)(Wf + t * 128 + 64 * kh + 4 * j);
#pragma unroll
            for (int e = 0; e < 4; ++e) { S[4 * j + e] = f4[e] * S[4 * j + e] + k4[e] * vt[t]; p += q4[e] * S[4 * j + e]; }
        }
        p += __shfl_xor(p, 32);
        p += xsk[t];
        const float pn = __shfl_down(p, 1);
        if (lane < 32 && (lane & 1) == 0) *(unsigned*)(OG + (size_t)(row0 + t) * D + colbase + v) = pk2(p, pn);
    }
    asm volatile("s_waitcnt lgkmcnt(0)" ::: "memory"); __builtin_amdgcn_wave_barrier();
    if (TYPE == 1) {
        float* dp = a.out + O_SS + ((size_t)(sx * 8 + h) * 64 + s * 32 + v) * 128 + 64 * kh;
#pragma unroll
        for (int j = 0; j < 16; ++j) *(f32x4*)(dp + 4 * j) = (f32x4){S[4 * j], S[4 * j + 1], S[4 * j + 2], S[4 * j + 3]};
    } else {
        float* dp = a.out + (TYPE == 0 ? O_HS : O_GS) + (size_t)(sx * H + h) * 128 * V + (size_t)(64 * kh) * V + s * 32 + v;
#pragma unroll
        for (int i = 0; i < 64; ++i) dp[(size_t)i * V] = S[i];
    }
}

__device__ __forceinline__ void phase_ssd_conv(const Args& a, int z) {
    const int c = 2 * threadIdx.x;
    const bf16* PJ = (const bf16*)(a.ws + WS_PROJ); bf16* CV = (bf16*)(a.ws + WS_XB);
    float cw0[4], cw1[4];
#pragma unroll
    for (int w = 0; w < 4; ++w) { cw0[w] = a.in[z + 18][w * 1024 + c]; cw1[w] = a.in[z + 18][w * 1024 + c + 1]; }
    const float cb0 = a.in[z + 19][c], cb1 = a.in[z + 19][c + 1];
    for (int strip = blockIdx.x; strip < 256; strip += gridDim.x) {
        const int b = strip >> 5, t0 = (strip & 31) * 64;
        unsigned w3[3];
#pragma unroll
        for (int j = 0; j < 3; ++j) { const int t = t0 - 3 + j; w3[j] = (t >= 0) ? *(const unsigned*)(PJ + (size_t)(b * 2048 + t) * PA + 2560 + c) : 0u; }
        for (int tt = 0; tt < 64; tt += 8) {
            unsigned nw[8];
#pragma unroll
            for (int j = 0; j < 8; ++j) nw[j] = *(const unsigned*)(PJ + (size_t)(b * 2048 + t0 + tt + j) * PA + 2560 + c);
#pragma unroll
            for (int j = 0; j < 8; ++j) {
                const unsigned r0 = w3[0], r1 = w3[1], r2 = w3[2], r3 = nw[j];
                const float a0 = cb0 + __uint_as_float(r0 << 16) * cw0[0] + __uint_as_float(r1 << 16) * cw0[1] + __uint_as_float(r2 << 16) * cw0[2] + __uint_as_float(r3 << 16) * cw0[3];
                const float a1 = cb1 + __uint_as_float(r0 & 0xffff0000u) * cw1[0] + __uint_as_float(r1 & 0xffff0000u) * cw1[1] + __uint_as_float(r2 & 0xffff0000u) * cw1[2] + __uint_as_float(r3 & 0xffff0000u) * cw1[3];
                *(unsigned*)(CV + (size_t)(b * 2048 + t0 + tt + j) * 1024 + c) = pk2(silu_f(a0), silu_f(a1));
                w3[0] = r1; w3[1] = r2; w3[2] = r3;
            }
        }
    }
}

__device__ __forceinline__ void phase_gla_lf(const Args& a, int z) {
    const int c = threadIdx.x;
    float wg[16];
#pragma unroll
    for (int r = 0; r < 16; ++r) wg[r] = a.in[z + 25][r * 512 + c];
    const float bg = a.in[z + 26][c];
    const float* GK = (const float*)(a.ws + WS_GK); float* LF = (float*)(a.ws + WS_LF);
    for (int R = blockIdx.x; R < T; R += gridDim.x) {
        const f32x4 g0 = *(const f32x4*)(GK + (size_t)R * 16), g1 = *(const f32x4*)(GK + (size_t)R * 16 + 4), g2 = *(const f32x4*)(GK + (size_t)R * 16 + 8), g3 = *(const f32x4*)(GK + (size_t)R * 16 + 12);
        float x = bg;
#pragma unroll
        for (int j = 0; j < 4; ++j) x += g0[j] * wg[j] + g1[j] * wg[4 + j] + g2[j] * wg[8 + j] + g3[j] * wg[12 + j];
        LF[(size_t)R * 512 + c] = -softplus_f(-x) * (1.f / 16.f);
    }
}

template <int TYPE>
__device__ __forceinline__ void samp_unit_v(const Args& a, int z, int sx, int h, int s, LAS float* W, int lane) {
    constexpr int V = (TYPE == 0) ? 128 : 256;
    constexpr int PP = (TYPE == 0) ? PA : PG;
    const int v4 = lane & 7, kg = lane >> 3;
    const int row0 = TP + sx * 4;
    unsigned char* ws = a.ws;
    const bf16* PJ = (const bf16*)(ws + WS_PROJ);
    const float* LF = (const float*)(ws + WS_LF); const float* GK = (const float*)(ws + WS_GK);
    bf16* OG = (bf16*)(ws + WS_OG);
    LAS float* Wq = W; LAS float* Wk = W + 512; LAS float* Wf = W + 1024;
    f32x4 S[16];
    const float* sp = a.in[z + (TYPE == 0 ? 2 : 5)] + (size_t)(sx * 4 + h) * 128 * V + (size_t)(16 * kg) * V + s * 32 + 4 * v4;
#pragma unroll
    for (int i = 0; i < 16; ++i) S[i] = *(const f32x4*)(sp + (size_t)i * V);
    f32x4 vt[4];
    if (TYPE == 0) {
#pragma unroll
        for (int t = 0; t < 4; ++t) { const size_t R = (size_t)(row0 + t);
#pragma unroll
            for (int c = 0; c < 2; ++c) { const int kk = lane + 64 * c; const float f = __expf(LF[R * 512 + h * 128 + kk]);
                Wq[t * 128 + kk] = bf2f(PJ[R * PA + h * 128 + kk]); Wk[t * 128 + kk] = 1.f - f; Wf[t * 128 + kk] = f; } }
    } else {
#pragma unroll
        for (int c = 0; c < 2; ++c) { const int kk = lane + 64 * c;
            float wg[16];
#pragma unroll
            for (int r = 0; r < 16; ++r) wg[r] = a.in[z + 25][r * 512 + h * 128 + kk];
            const float bg = a.in[z + 26][h * 128 + kk];
#pragma unroll
            for (int t = 0; t < 4; ++t) { const size_t R = (size_t)(row0 + t); float x = bg;
#pragma unroll
                for (int r = 0; r < 16; ++r) x += GK[R * 16 + r] * wg[r];
                Wf[t * 128 + kk] = __expf(-softplus_f(-x) * (1.f / 16.f));
                Wq[t * 128 + kk] = bf2f(PJ[R * PG + h * 128 + kk]); Wk[t * 128 + kk] = bf2f(PJ[R * PG + 512 + h * 128 + kk]); } }
    }
#pragma unroll
    for (int t = 0; t < 4; ++t) { const v2u w = *(const v2u*)(PJ + (size_t)(row0 + t) * PP + 1024 + h * V + s * 32 + 4 * v4);
        vt[t] = (f32x4){__uint_as_float(w.x << 16), __uint_as_float(w.x & 0xffff0000u), __uint_as_float(w.y << 16), __uint_as_float(w.y & 0xffff0000u)}; }
    asm volatile("s_waitcnt lgkmcnt(0)" ::: "memory"); __builtin_amdgcn_wave_barrier();
    const int colbase = (TYPE == 0) ? h * 128 + s * 32 : h * 256 + s * 32;
#pragma unroll
    for (int t = 0; t < 4; ++t) {
        f32x4 p = (f32x4){0.f, 0.f, 0.f, 0.f};
#pragma unroll
        for (int j = 0; j < 4; ++j) {
            const f32x4 q4 = *(const LAS f32x4*)(Wq + t * 128 + 16 * kg + 4 * j), k4 = *(const LAS f32x4*)(Wk + t * 128 + 16 * kg + 4 * j), f4 = *(const LAS f32x4*)(Wf + t * 128 + 16 * kg + 4 * j);
#pragma unroll
            for (int e = 0; e < 4; ++e) { S[4 * j + e] = S[4 * j + e] * f4[e] + vt[t] * k4[e]; p = p + S[4 * j + e] * q4[e]; }
        }
#pragma unroll
        for (int e = 0; e < 4; ++e) { float x = p[e]; x += __shfl_xor(x, 8); x += __shfl_xor(x, 16); x += __shfl_xor(x, 32); p[e] = x; }
        if (lane < 8) *(v2u*)(OG + (size_t)(row0 + t) * D + colbase + 4 * v4) = (v2u){pk2(p[0], p[1]), pk2(p[2], p[3])};
    }
    asm volatile("s_waitcnt lgkmcnt(0)" ::: "memory"); __builtin_amdgcn_wave_barrier();
    float* dp = a.out + (TYPE == 0 ? O_HS : O_GS) + (size_t)(sx * 4 + h) * 128 * V + (size_t)(16 * kg) * V + s * 32 + 4 * v4;
#pragma unroll
    for (int i = 0; i < 16; ++i) *(f32x4*)(dp + (size_t)i * V) = S[i];
}

__device__ __forceinline__ void phase_mix_pre0(const Args& a, int z, LAS unsigned char* lds) {
    for (int u = blockIdx.x; u < 1536; u += gridDim.x) {
        if (u < 1024) pre_unit<0>(a, z, u >> 7, (u >> 5) & 3, u & 31, u, lds);
        else { const int v = u - 1024; pre_unit<1>(a, z, v >> 6, (v >> 5) & 1, v & 31, u, lds); }
    }
}
__device__ __forceinline__ void phase_mix_pre1(const Args& a, int z, LAS unsigned char* lds) {
    for (int u = blockIdx.x; u < 1024; u += gridDim.x) pre_unit<2>(a, z, u >> 7, (u >> 5) & 3, u & 31, u, lds);
}
__device__ __forceinline__ void phase_mix0(const Args& a, int z, LAS unsigned char* lds) {
    for (int u = blockIdx.x; u < 128; u += gridDim.x) seq2_unit<0>(a, z, u >> 4, (u >> 2) & 3, u & 3, lds);
    for (int u = blockIdx.x; u < 256; u += gridDim.x) if (u >= 128) { const int v = u - 128; seq2_unit<1>(a, z, v >> 4, (v >> 1) & 7, v & 1, lds); }
    const int lane = threadIdx.x & 63, wave = __builtin_amdgcn_readfirstlane(threadIdx.x >> 6);
    LAS float* W = (LAS float*)(lds + wave * 6144);
    const int gw = blockIdx.x * NWAVES + wave, NGW = gridDim.x * NWAVES;
    for (int v = gw; v < 2048; v += NGW) samp_unit_v<0>(a, z, v >> 4, (v >> 2) & 3, v & 3, W, lane);
    for (int v = gw; v < 2048; v += NGW) samp_unit<1>(a, z, v >> 4, (v >> 1) & 7, v & 1, W, lane);
}
__device__ __forceinline__ void phase_mix1(const Args& a, int z, LAS unsigned char* lds) {
    for (int u = blockIdx.x; u < 256; u += gridDim.x) seq2_unit<2>(a, z, u >> 5, (u >> 3) & 3, u & 7, lds);
    const int lane = threadIdx.x & 63, wave = __builtin_amdgcn_readfirstlane(threadIdx.x >> 6);
    LAS float* W = (LAS float*)(lds + wave * 6144);
    const int gw = blockIdx.x * NWAVES + wave, NGW = gridDim.x * NWAVES;
    for (int v = gw; v < 4096; v += NGW) samp_unit_v<2>(a, z, v >> 5, (v >> 3) & 3, v & 7, W, lane);
}

struct CapOrder {
    int c; unsigned* cnt;
    __device__ __forceinline__ bool next(int i, pg8::Unit& u) const {
        int ii = i;
        if (c >= 128 && c < 172) { if (i == 0) { const int s = c - 128; u.pm = 64 + s / 22; u.pn = s % 22; return true; } ii = i - 1; }
        const int cap = (c >= 248) ? 3 : ((c >= 128 && c < 172) ? 5 : 6);
        if (ii >= cap) return false;
        int idx;
        if (ii < 3) idx = ii * 256 + c; else if (ii < 5) idx = 768 + (ii - 3) * 248 + c; else idx = 1264 + (c < 128 ? c : c - 44);
        if (idx >= 1408) return false;
        const int xcd = idx & 7, off = idx >> 3, wgid = xcd * 176 + off;
        const int gid = wgid / 176, w2 = wgid - gid * 176;
        u.pm = gid * 8 + (w2 & 7); u.pn = w2 >> 3; return true;
    }
    __device__ __forceinline__ void a_ready(const pg8::Unit&) const {}
    __device__ __forceinline__ void done(const pg8::Unit& u) const {
        if (u.pm >= 64) { asm volatile("s_waitcnt vmcnt(0)" ::: "memory");
            if ((threadIdx.x & 63) == 0) __hip_atomic_fetch_add(cnt, 1u, __ATOMIC_RELAXED, __HIP_MEMORY_SCOPE_AGENT); }
    }
};
struct OneUnit {
    int pm, pn;
    __device__ __forceinline__ bool next(int i, pg8::Unit& u) const { if (i != 0) return false; u.pm = pm; u.pn = pn; return true; }
    __device__ __forceinline__ void a_ready(const pg8::Unit&) const {}
    __device__ __forceinline__ void done(const pg8::Unit&) const {}
};
__device__ __forceinline__ void wait_count(unsigned* cnt, unsigned need) {
    if (threadIdx.x == 0) { unsigned sp = 0; while (__hip_atomic_load(cnt, __ATOMIC_RELAXED, __HIP_MEMORY_SCOPE_AGENT) < need && ++sp < (1u << 22)) __builtin_amdgcn_s_sleep(2); }
    __builtin_amdgcn_fence(__ATOMIC_ACQUIRE, "agent"); asm volatile("s_waitcnt vmcnt(0)" ::: "memory");
    __syncthreads();
    __builtin_amdgcn_fence(__ATOMIC_ACQUIRE, "agent"); asm volatile("s_waitcnt vmcnt(0)" ::: "memory");
}

template <int LAYER>
__device__ __forceinline__ void post_row(const Args& a, int R, int lane, const float (&wn)[16]) {
    const bf16* PJ = (const bf16*)(a.ws + WS_PROJ); bf16* OG = (bf16*)(a.ws + WS_OG);
    const int c = 16 * lane;
    {
        const v4u o0 = *(const v4u*)(OG + (size_t)R * D + c), o1 = *(const v4u*)(OG + (size_t)R * D + c + 8);
        const bf16* gp = (LAYER == 0) ? PJ + (size_t)R * PA + 1536 + c : PJ + (size_t)R * PG + 2048 + c;
        const v4u g0 = *(const v4u*)gp, g1 = *(const v4u*)(gp + 8);
        float o[16], gt[16];
        const unsigned ow[8] = {o0.x, o0.y, o0.z, o0.w, o1.x, o1.y, o1.z, o1.w}, gw8[8] = {g0.x, g0.y, g0.z, g0.w, g1.x, g1.y, g1.z, g1.w};
#pragma unroll
        for (int j = 0; j < 8; ++j) { o[2 * j] = __uint_as_float(ow[j] << 16); o[2 * j + 1] = __uint_as_float(ow[j] & 0xffff0000u);
            gt[2 * j] = __uint_as_float(gw8[j] << 16); gt[2 * j + 1] = __uint_as_float(gw8[j] & 0xffff0000u); }
        const bool pre_gate = (LAYER == 0) && (lane >= 32);
        float ss = 0.f;
#pragma unroll
        for (int j = 0; j < 16; ++j) { if (pre_gate) o[j] *= gt[j]; ss += o[j] * o[j]; }
        ss += __shfl_xor(ss, 1); ss += __shfl_xor(ss, 2); ss += __shfl_xor(ss, 4);
        const float t8 = __shfl_xor(ss, 8);
        const bool wide = (LAYER == 1) || (lane >= 32);
        if (wide) ss += t8;
        const float rstd = rsqrtf(ss * (wide ? (1.f / 256.f) : (1.f / 128.f)) + EPS);
        unsigned r[8];
#pragma unroll
        for (int j = 0; j < 8; ++j) {
            float y0 = o[2 * j] * rstd * wn[2 * j], y1 = o[2 * j + 1] * rstd * wn[2 * j + 1];
            if (!pre_gate) { y0 *= gt[2 * j]; y1 *= gt[2 * j + 1]; }
            r[j] = pk2(y0, y1);
        }
        if (R >= TP) {
            unsigned long long* p8 = (unsigned long long*)(OG + (size_t)R * D + c);
#pragma unroll
            for (int j = 0; j < 4; ++j) __hip_atomic_store(p8 + j, (unsigned long long)r[2 * j] | ((unsigned long long)r[2 * j + 1] << 32), __ATOMIC_RELAXED, __HIP_MEMORY_SCOPE_AGENT);
        } else { *(v4u*)(OG + (size_t)R * D + c) = (v4u){r[0], r[1], r[2], r[3]}; *(v4u*)(OG + (size_t)R * D + c + 8) = (v4u){r[4], r[5], r[6], r[7]}; }
    }
}
template <int LAYER>
__device__ __forceinline__ void phase_post(const Args& a, int z, LAS unsigned char* lds, unsigned* cnt) {
    const int tid = threadIdx.x, lane = tid & 63, wave = tid >> 6;
    const int gw = blockIdx.x * NWAVES + wave, NGW = gridDim.x * NWAVES;
    const bf16* PJ = (const bf16*)(a.ws + WS_PROJ);
    const int c = 16 * lane;
    float wn[16];
    if (LAYER == 0) {
#pragma unroll
        for (int j = 0; j < 16; ++j) wn[j] = (lane < 32) ? a.in[z + 17][(c + j) & 127] : a.in[z + 23][c - 512 + j];
    } else {
#pragma unroll
        for (int j = 0; j < 16; ++j) wn[j] = a.in[z + 27][(c + j) & 255];
    }
    bool did = false;
    for (int R = TP + gw; R < T; R += NGW) { post_row<LAYER>(a, R, lane, wn); did = true; }
    if (did) { asm volatile("s_waitcnt vmcnt(0)" ::: "memory");
        if (lane == 0) __hip_atomic_fetch_add(cnt, 1u, __ATOMIC_RELAXED, __HIP_MEMORY_SCOPE_AGENT); }
    const int nsamp_waves = (T - TP) < NGW ? (T - TP) : NGW;
    if (blockIdx.x >= 248) {
        wait_count(cnt, (unsigned)nsamp_waves);
        pg8::Gemm g{(const bf16*)(a.ws + WS_OG), (const bf16*)(a.ws + (LAYER == 0 ? WS_WAO : WS_WGO)), T, D, D};
        OneUnit S{64 + ((int)blockIdx.x - 248) / 4, ((int)blockIdx.x - 248) % 4};
        Epi<1, 1> E{a.ws, a.out, a.out, a.out + (size_t)TP * D, a.in[16], a.in[20]};
        pg8::gemm_phase<Epi<1, 1>, OneUnit, true, true>(lds, g, S, E);
        return;
    }
    for (int R = gw; R < TP; R += 248 * NWAVES) post_row<LAYER>(a, R, lane, wn);
    prep_late(a, z, lds, LAYER, (int)blockIdx.x, 248);
    if (LAYER == 0) {
        const int gt_ = blockIdx.x * 512 + tid, NT = 248 * 512;
        for (int e = gt_; e < 136 * 3072; e += NT) {
            const int sq = e / 3072, r = (e / 1024) % 3, ch = e & 1023;
            const int row = (sq < 8) ? sq * 2048 + 2045 + r : TP + (sq - 8) * 4 + 1 + r;
            const float v = bf2f(PJ[(size_t)row * PA + 2560 + ch]);
            if (sq < 8) a.out[O_CP + e] = v; else a.out[O_CS + (e - 8 * 3072)] = v;
        }
    }
}

__device__ __forceinline__ void phase_final(const Args& a, int z) {
    const int tid = threadIdx.x, lane = tid & 63, wave = tid >> 6;
    const int gw = blockIdx.x * NWAVES + wave, NGW = gridDim.x * NWAVES;
    const float* SSQ = (const float*)(a.ws + WS_SSQ);
    f32x4 wn[4];
#pragma unroll
    for (int j = 0; j < 4; ++j) wn[j] = *((const f32x4*)a.in[z + (9)] + lane + 64 * j);
    for (int R = gw; R < T; R += 2 * NGW) {
        const int R2 = R + NGW; const bool two = R2 < T;
        f32x4* xr = (f32x4*)(a.out + (size_t)R * D) + lane; f32x4* xr2 = (f32x4*)(a.out + (size_t)(two ? R2 : R) * D) + lane;
        f32x4 v[4], v2[4];
#pragma unroll
        for (int j = 0; j < 4; ++j) { v[j] = xr[64 * j]; v2[j] = xr2[64 * j]; }
        float s = (lane < 16) ? SSQ[(size_t)R * 16 + lane] : 0.f, s2 = (lane < 16) ? SSQ[(size_t)(two ? R2 : R) * 16 + lane] : 0.f;
        s = wave_sum(s); s2 = wave_sum(s2);
        const float rstd = rsqrtf(s * (1.f / 1024.f) + EPS), rstd2 = rsqrtf(s2 * (1.f / 1024.f) + EPS);
#pragma unroll
        for (int j = 0; j < 4; ++j) xr[64 * j] = v[j] * rstd * wn[j];
        if (two) {
#pragma unroll
            for (int j = 0; j < 4; ++j) xr2[64 * j] = v2[j] * rstd2 * wn[j];
        }
    }
}


#define GAS __attribute__((address_space(1)))
typedef GAS unsigned gu32;
#define RLX_AGENT __ATOMIC_RELAXED, __HIP_MEMORY_SCOPE_AGENT
#define XB_TMO      128
#define XB_XCNT(j)  (256  + 64 * (j))
#define XB_XSUB(j)  (1280 + 64 * (j))
#define XB_XGEN(j)  (2304 + 64 * (j))
#define XB_TOP      3328
#define XB_TOPGEN   3392
#define XCD_BAR_WORDS 3456
#define XB_SPIN_CAP (1u << 18)

__device__ __forceinline__ unsigned xb_ld(unsigned* p)              { return __hip_atomic_load(p, __ATOMIC_RELAXED, __HIP_MEMORY_SCOPE_AGENT); }
__device__ __forceinline__ unsigned xb_add(unsigned* p, unsigned v) { return __hip_atomic_fetch_add(p, v, __ATOMIC_RELAXED, __HIP_MEMORY_SCOPE_AGENT); }
__device__ __forceinline__ unsigned xb_xcc_id() { return (unsigned)__builtin_amdgcn_s_getreg((3 << 11) | 20) & 0xFu; }
#define XB_SPIN(cond, bar) do { unsigned _sp = 0; while (cond) { __builtin_amdgcn_s_sleep(1); \
    if ((++_sp & 255u) == 0u) { if (xb_ld(&(bar)[XB_TMO])) break; if (_sp > XB_SPIN_CAP) { atomicAdd(&(bar)[XB_TMO], 1u); break; } } } } while (0)

struct XcdBarrier {
    unsigned* bar; unsigned x;
    volatile LAS unsigned* st;
};

__device__ __forceinline__ XcdBarrier xcd_barrier_post(unsigned* bar, volatile LAS unsigned* st) {
    XcdBarrier b; b.bar = bar; b.x = xb_xcc_id(); b.st = st;
    if (threadIdx.x == 0) (void)xb_add(&bar[XB_XCNT(b.x)], 1u);
    return b;
}
__device__ __forceinline__ void xcd_barrier_complete(unsigned* bar, unsigned x, unsigned& nloc, unsigned& nx) {
    const unsigned G = gridDim.x * gridDim.y * gridDim.z;
    unsigned sum, cnt, mine, sp = 0u;
    for (;;) {
        sum = 0u; cnt = 0u; mine = 0u;
#pragma unroll
        for (unsigned j = 0; j < 16; ++j) { const unsigned c = xb_ld(&bar[XB_XCNT(j)]); sum += c; cnt += (c > 0u) ? 1u : 0u; mine = (j == x) ? c : mine; }
        if (sum == G) break;
        __builtin_amdgcn_s_sleep(1);
        if ((++sp & 255u) == 0u) { if (xb_ld(&bar[XB_TMO])) break; if (sp > XB_SPIN_CAP) { atomicAdd(&bar[XB_TMO], 1u); break; } }
    }
    nloc = mine > 0u ? mine : 1u; nx = cnt > 0u ? cnt : 1u;
}

__device__ __forceinline__ void xcd_barrier(const XcdBarrier& b) {
    asm volatile("s_waitcnt vmcnt(0)" ::: "memory");
    __syncthreads();
    if (threadIdx.x == 0) {
        unsigned* bar = b.bar;
        __builtin_amdgcn_s_waitcnt(0);
        unsigned nloc = b.st[0], nx = b.st[1];
        if (nloc == 0u) { xcd_barrier_complete(bar, b.x, nloc, nx); b.st[0] = nloc; b.st[1] = nx; }
        const unsigned old = xb_add(&bar[XB_XSUB(b.x)], 1u);
        const unsigned gen = old / nloc;
        if (old + 1u == (gen + 1u) * nloc) {
            __builtin_amdgcn_fence(__ATOMIC_RELEASE, "agent");
            asm volatile("s_waitcnt vmcnt(0)" ::: "memory");
            const unsigned og = xb_add(&bar[XB_TOP], 1u);
            const unsigned tg = og / nx;
            if (og + 1u == (tg + 1u) * nx) xb_add(&bar[XB_TOPGEN], 1u);
            else XB_SPIN(xb_ld(&bar[XB_TOPGEN]) == tg, bar);
            __builtin_amdgcn_fence(__ATOMIC_ACQUIRE, "agent");
            xb_add(&bar[XB_XGEN(b.x)], 1u);
            asm volatile("s_waitcnt vmcnt(0)" ::: "memory");
        } else {
            XB_SPIN(xb_ld(&bar[XB_XGEN(b.x)]) == gen, bar);
            __builtin_amdgcn_fence(__ATOMIC_ACQUIRE, "agent");
            asm volatile("s_waitcnt vmcnt(0)" ::: "memory");
        }
    }
    __syncthreads();
}


__global__ void __launch_bounds__(NWAVES * 64, 2) fwd_megakernel(Args args) {
    extern __shared__ __attribute__((aligned(16))) unsigned char lds_raw[];
    LAS unsigned char* lds = (LAS unsigned char*)lds_raw;
    cg::grid_group grid = cg::this_grid();
    const int lo = args.ph_lo, hi = args.ph_hi;
    if (hi < 0) grid.sync();
    unsigned char* ws = args.ws;
    const int z = 0;
    for (int u = threadIdx.x; u < 64; u += NWAVES * 64) ((LAS unsigned*)(lds + 131072))[u] = 0u;
    __syncthreads();
    XcdBarrier bar; bar.bar = (unsigned*)(ws + WS_CTL) + 4096; bar.x = 0; bar.st = nullptr;
    if (hi - lo > 1) bar = xcd_barrier_post((unsigned*)(ws + WS_CTL) + 4096, (volatile LAS unsigned*)(lds + 131072 + 32));
#define IN_PH(k) (lo <= (k) && (k) < hi)
#define SEAM(k) do { if (IN_PH(k) && IN_PH((k) + 1)) xcd_barrier(bar); } while (0)
#define GEMM_PH(k, MODE, SUB, AOFF, BOFF, NN, KK, RP, RS) do { if (IN_PH(k)) { \
        pg8::Gemm g{(const bf16*)(ws + (AOFF)), (const bf16*)(ws + (BOFF)), T, (NN), (KK)}; \
        pg8::StaticOrder S; S.init(T, (NN), (int)gridDim.x, (int)blockIdx.x); \
        Epi<MODE, SUB> E{ws, args.out, (RP), (RS), args.in[16], args.in[20]}; \
        pg8::gemm_phase<Epi<MODE, SUB>, pg8::StaticOrder, true, true>(lds, g, S, E); } SEAM(k); } while (0)
#define GEMM_PHP(k, MODE, SUB, AOFF, BOFF, NN, KK, RP, RS) do { if (IN_PH(k)) { \
        pg8::Gemm g{(const bf16*)(ws + (AOFF)), (const bf16*)(ws + (BOFF)), TP, (NN), (KK)}; \
        pg8::StaticOrder S; S.init(TP, (NN), (int)gridDim.x, (int)blockIdx.x); \
        Epi<MODE, SUB> E{ws, args.out, (RP), (RS), args.in[16], args.in[20]}; \
        pg8::gemm_phase<Epi<MODE, SUB>, pg8::StaticOrder, true, true>(lds, g, S, E); } SEAM(k); } while (0)
#define FFN_IN_PH(k, FI, RP, RS) do { if (IN_PH(k)) { \
        unsigned* cnt = (unsigned*)(ws + WS_CTL) + 16384 + 64 * (FI); \
        { pg8::Gemm g{(const bf16*)(ws + WS_XB), (const bf16*)(ws + WS_WFI + (FI) * SZ_WFI), T, NFI, D}; \
          CapOrder S{(int)blockIdx.x, cnt}; Epi<0, 0> E{ws, args.out, XR, XRS, args.in[16], args.in[20]}; \
          pg8::gemm_phase<Epi<0, 0>, CapOrder, true, true>(lds, g, S, E); } \
        if (blockIdx.x >= 248) { wait_count(cnt, 44u * 8u); \
          pg8::Gemm g2{(const bf16*)(ws + WS_ACT), (const bf16*)(ws + WS_WFO + (FI) * SZ_WFO), T, D, DFF}; \
          OneUnit S2{64 + ((int)blockIdx.x - 248) / 4, ((int)blockIdx.x - 248) % 4}; Epi<1, 0> E2{ws, args.out, (RP), (RS), args.in[16], args.in[20]}; \
          pg8::gemm_phase<Epi<1, 0>, OneUnit, true, true>(lds, g2, S2, E2); } \
        } SEAM(k); } while (0)
#define FFN_OUT_PH(k, FO, RP, RS) do { if (IN_PH(k)) { \
        pg8::Gemm g{(const bf16*)(ws + WS_ACT), (const bf16*)(ws + WS_WFO + (FO) * SZ_WFO), TP, D, DFF}; \
        pg8::StaticOrder S; S.init(TP, D, (int)gridDim.x, (int)blockIdx.x); \
        Epi<1, 0> E{ws, args.out, (RP), (RS), args.in[16], args.in[20]}; \
        pg8::gemm_phase<Epi<1, 0>, pg8::StaticOrder, true, true>(lds, g, S, E); } SEAM(k); } while (0)
    float* const XR = args.out; float* const XRS = args.out + (size_t)TP * D;
    if (IN_PH(PH_PREP)) phase_prep(args, z, lds);
    SEAM(PH_PREP);
    FFN_IN_PH(PH_L0F1I, 0, args.in[0], args.in[1]);
    FFN_OUT_PH(PH_L0F1O, 0, args.in[0], args.in[1]);
    GEMM_PH(PH_ABI, 2, 0, WS_XB, WS_WAI, NAB_PAD, D, XR, XRS);
    if (IN_PH(PH_MIX0)) { phase_mix_pre0(args, z, lds); if (hi - lo > 1) xcd_barrier(bar); phase_mix0(args, z, lds); }
    SEAM(PH_MIX0);
    if (IN_PH(PH_POST0)) phase_post<0>(args, z, lds, (unsigned*)(ws + WS_CTL) + 16384 + 64 * 8);
    SEAM(PH_POST0);
    GEMM_PHP(PH_ABO, 1, 1, WS_OG, WS_WAO, D, D, XR, XRS);
    FFN_IN_PH(PH_L0F2I, 1, XR, XRS);
    FFN_OUT_PH(PH_L0F2O, 1, XR, XRS);
    FFN_IN_PH(PH_L1F1I, 2, XR, XRS);
    FFN_OUT_PH(PH_L1F1O, 2, XR, XRS);
    GEMM_PH(PH_GLI, 2, 1, WS_XB, WS_WGI, NGL_PAD, D, XR, XRS);
    if (IN_PH(PH_MIX1)) { phase_mix_pre1(args, z, lds); if (hi - lo > 1) xcd_barrier(bar); phase_mix1(args, z, lds); }
    SEAM(PH_MIX1);
    if (IN_PH(PH_POST1)) phase_post<1>(args, z, lds, (unsigned*)(ws + WS_CTL) + 16384 + 64 * 9);
    SEAM(PH_POST1);
    GEMM_PHP(PH_GLO, 1, 1, WS_OG, WS_WGO, D, D, XR, XRS);
    FFN_IN_PH(PH_L1F2I, 3, XR, XRS);
    if (IN_PH(PH_L1F2O)) {
        pg8::Gemm g{(const bf16*)(ws + WS_ACT), (const bf16*)(ws + WS_WFO + 3 * SZ_WFO), TP, D, DFF};
        pg8::StaticOrder S; S.init(TP, D, (int)gridDim.x, (int)blockIdx.x);
        Epi<1, 2> E{ws, args.out, XR, XRS, args.in[16], args.in[20]};
        pg8::gemm_phase<Epi<1, 2>, pg8::StaticOrder, true, true>(lds, g, S, E); }
    SEAM(PH_L1F2O);
    if (IN_PH(PH_FINAL)) phase_final(args, z);
}

#ifndef ONE_LAUNCH
#define ONE_LAUNCH 1
#endif
extern "C" void kernel_launch(void* const* d_in, const int* in_sizes, int n_in, void* d_out, int out_size, void* d_ws, size_t ws_size, hipStream_t stream) {
    static int grid = 0;
    if (grid == 0) {
        if (n_in != 29 || ws_size < WS_NEED) { fprintf(stderr, "kernel_launch: n_in %d ws %zu (need %zu)\n", n_in, ws_size, (size_t)WS_END); grid = -1; return; }
        int dev = 0, cus = 0, per_cu = 0;
        hipGetDevice(&dev); hipDeviceGetAttribute(&cus, hipDeviceAttributeMultiprocessorCount, dev);
        hipFuncSetAttribute((const void*)fwd_megakernel, hipFuncAttributeMaxDynamicSharedMemorySize, LDS_BYTES);
        if (hipOccupancyMaxActiveBlocksPerMultiprocessor(&per_cu, (const void*)fwd_megakernel, NWAVES * 64, LDS_BYTES) != hipSuccess || per_cu < 1) { fprintf(stderr, "occupancy query failed/0\n"); per_cu = 1; }
        (void)hipGetLastError();
        grid = cus;
        if (grid != 256) { fprintf(stderr, "kernel_launch: built for a 256-CU device, found %d\n", cus); grid = -1; return; }
    }
    if (grid < 0) return;
    Args a{};
    for (int i = 0; i < 29; ++i) a.in[i] = (const float*)d_in[i];
    a.out = (float*)d_out; a.ws = (unsigned char*)d_ws;
    if (hipMemsetAsync((char*)d_ws + WS_CTL, 0, 131072, stream) != hipSuccess) { fprintf(stderr, "memset failed\n"); return; }
#if ONE_LAUNCH
    a.ph_lo = 0; a.ph_hi = N_PH;
    void* kargs[] = {&a};
    hipError_t e = hipLaunchCooperativeKernel((const void*)fwd_megakernel, dim3(grid), dim3(NWAVES * 64), kargs, LDS_BYTES, stream);
    if (e != hipSuccess) fprintf(stderr, "cooperative launch failed: %s\n", hipGetErrorString(e));
#else
    for (int ph = 0; ph < N_PH; ++ph) { a.ph_lo = ph; a.ph_hi = ph + 1; hipLaunchKernelGGL(fwd_megakernel, dim3(grid), dim3(NWAVES * 64), LDS_BYTES, stream, a); }
#endif
}
```
